# Optimizing an MI355X kernel written in HIP

```python
import math
import jax, jax.numpy as jnp
from jax import lax
import numpy as np

D_MODEL = 1024
BATCH = 1
SEQ = 16384
DEPTH = 2
DEC_BATCH = 16
DEC_SEQ = 4096
PAST_LEN = 128

GRID_W = 64
HEAD_DIM = 64
RWKV_HEADS = 8
RWKV_DIM = RWKV_HEADS * HEAD_DIM
ATTN_HEADS = 8
KV_HEADS = 2
ATTN_GROUP = ATTN_HEADS // KV_HEADS
ATTN_DIM = ATTN_HEADS * HEAD_DIM
KV_DIM = KV_HEADS * HEAD_DIM
MIX_DIM = RWKV_DIM + ATTN_DIM
DECAY_LORA = 64
ICLR_LORA = 64
GATE_LORA = 128
N_DIR = 2
CONV_W = 3
D_FF = ((8 * D_MODEL // 3 + 255) // 256) * 256
IN_SPLITS = [3 * RWKV_DIM, ATTN_DIM, KV_DIM, KV_DIM, N_DIR * DECAY_LORA, N_DIR * ICLR_LORA, GATE_LORA]
IN_COLS = sum(IN_SPLITS)
BLOCK_Q = 128
ROPE_THETA = 10000.0
NORM_EPS = 1e-6
QK_EPS = 1e-6
GN_EPS = 64e-5
DECAY_SCALE = math.exp(-0.5)

kernel_name = "hymba_rwkv7_gqa_axialrope_encoder"


def _split_points(sizes):
    return [int(s) for s in np.cumsum(sizes)[:-1]]


def rms_norm(x, g, eps):
    xf = x.astype(jnp.float32)
    y = xf * lax.rsqrt(jnp.mean(xf * xf, axis=-1, keepdims=True) + eps)
    return (y * g.astype(jnp.float32)).astype(x.dtype)


def centred_conv(x, w):
    xp = jnp.pad(x, ((0, 0), (1, 1), (0, 0)))
    return w[0] * xp[:, :-2] + w[1] * xp[:, 1:-1] + w[2] * xp[:, 2:]


def rope_1d(x, pos):
    quarter = x.shape[-1] // 2
    freq = 1.0 / (ROPE_THETA ** (jnp.arange(quarter, dtype=jnp.float32) / quarter))
    ang = pos.astype(jnp.float32)[:, None] * freq[None, :]
    cos = jnp.cos(ang)[None, :, None, :]
    sin = jnp.sin(ang)[None, :, None, :]
    x1, x2 = x[..., :quarter], x[..., quarter:]
    return jnp.concatenate([x1 * cos - x2 * sin, x2 * cos + x1 * sin], axis=-1)


def axial_rope(x, row, col):
    half = HEAD_DIM // 2
    xf = x.astype(jnp.float32)
    out = jnp.concatenate([rope_1d(xf[..., :half], row), rope_1d(xf[..., half:], col)], axis=-1)
    return out.astype(x.dtype)


def block_attention(q, k, v):
    B, T = q.shape[0], q.shape[1]
    nblk = T // BLOCK_Q
    qb = q.reshape(B, nblk, BLOCK_Q, KV_HEADS, ATTN_GROUP, HEAD_DIM).transpose(1, 0, 2, 3, 4, 5)
    kf = k.astype(jnp.float32)
    vf = v.astype(jnp.float32)
    scale = HEAD_DIM ** -0.5

    def one_block(qblk):
        s = jnp.einsum('bqhgd,bshd->bhgqs', qblk.astype(jnp.float32), kf) * scale
        p = jax.nn.softmax(s, axis=-1)
        return jnp.einsum('bhgqs,bshd->bqhgd', p, vf)

    o = lax.map(one_block, qb)
    return o.transpose(1, 0, 2, 3, 4, 5).reshape(B, T, ATTN_DIM)


def rwkv7_scan(r, w, k, v, a, b, reverse):
    B, T, H, N = r.shape
    xs = tuple(jnp.moveaxis(z, 1, 0) for z in (r, w, k, v, a, b))

    def step(S, inp):
        rt, wt, kt, vt, at, bt = inp
        sa = jnp.einsum('bhvk,bhk->bhv', S, at)
        S = S * wt[:, :, None, :] + sa[..., :, None] * bt[..., None, :] + vt[..., :, None] * kt[..., None, :]
        y = jnp.einsum('bhvk,bhk->bhv', S, rt)
        return S, y

    S0 = jnp.zeros((B, H, N, N), jnp.float32)
    _, ys = lax.scan(step, S0, xs, reverse=reverse)
    return jnp.moveaxis(ys, 0, 1)


def hybrid_layer(x, c, ada_w, ada_b, norm_mix_g, norm_ffn_g, w_in, conv_w, decay_w0, decay_up,
                 iclr_a0, iclr_up, gate_up, k_k, k_a, r_k, ln_x_g, ln_x_b, q_norm_g, k_norm_g,
                 w_out, w_ffn_in, w_ffn_out):
    B, T, _ = x.shape
    rows = T // GRID_W
    row = jnp.repeat(jnp.arange(rows, dtype=jnp.int32), GRID_W, total_repeat_length=T)
    col = jnp.tile(jnp.arange(GRID_W, dtype=jnp.int32), rows)
    f32 = jnp.float32

    mod = (jax.nn.silu(c) @ ada_w + ada_b)[:, None, :]
    shift_m, scale_m, gate_m, shift_f, scale_f, gate_f = jnp.split(mod, 6, axis=-1)

    h = rms_norm(x, norm_mix_g, NORM_EPS) * (1.0 + scale_m) + shift_m
    proj = h @ w_in
    rkv, q, ka, va, xw, xa, xg = jnp.split(proj, _split_points(IN_SPLITS), axis=-1)

    r, kr, vr = jnp.split(centred_conv(rkv, conv_w), 3, axis=-1)
    xw = xw.reshape(B, T, N_DIR, DECAY_LORA)
    xa = xa.reshape(B, T, N_DIR, ICLR_LORA)
    decay_logit = decay_w0 + jnp.einsum('btdr,drc->btdc', jnp.tanh(xw), decay_up)
    w = jnp.exp(-DECAY_SCALE * jax.nn.sigmoid(decay_logit.astype(f32)))
    iclr = jax.nn.sigmoid((iclr_a0 + jnp.einsum('btdr,drc->btdc', xa, iclr_up)).astype(f32))
    g = (jax.nn.sigmoid(xg) @ gate_up).astype(f32)

    rf = r.astype(f32)
    kf = kr.astype(f32)
    vf = vr.astype(f32)
    kkh = (kf * k_k.astype(f32)).reshape(B, T, RWKV_HEADS, HEAD_DIM)
    kk = kkh * lax.rsqrt(jnp.sum(kkh * kkh, axis=-1, keepdims=True) + 1e-12)
    k_dir = kf[:, :, None, :] * (1.0 + (iclr - 1.0) * k_a.astype(f32))

    heads = lambda z: z.reshape(B, T, RWKV_HEADS, HEAD_DIM)
    rh, vh = heads(rf), heads(vf)
    y_fwd = rwkv7_scan(rh, heads(w[:, :, 0]), heads(k_dir[:, :, 0]), vh, -kk,
                       kk * heads(iclr[:, :, 0]), reverse=False)
    y_bwd = rwkv7_scan(rh, heads(w[:, :, 1]), heads(k_dir[:, :, 1]), vh, -kk,
                       kk * heads(iclr[:, :, 1]), reverse=True)
    y = y_fwd + y_bwd
    mu = jnp.mean(y, axis=-1, keepdims=True)
    var = jnp.mean(jnp.square(y - mu), axis=-1, keepdims=True)
    yn = ((y - mu) * lax.rsqrt(var + GN_EPS)).reshape(B, T, RWKV_DIM)
    yn = yn * ln_x_g.astype(f32) + ln_x_b.astype(f32)
    k_bonus = heads(0.5 * (k_dir[:, :, 0] + k_dir[:, :, 1]))
    bonus = jnp.sum(rh * k_bonus * r_k.astype(f32), axis=-1, keepdims=True) * vh
    rwkv_out = ((yn + bonus.reshape(B, T, RWKV_DIM)) * g).astype(x.dtype)

    qh = rms_norm(q.reshape(B, T, ATTN_HEADS, HEAD_DIM), q_norm_g, QK_EPS)
    kh = rms_norm(ka.reshape(B, T, KV_HEADS, HEAD_DIM), k_norm_g, QK_EPS)
    vh_a = va.reshape(B, T, KV_HEADS, HEAD_DIM)
    qh = axial_rope(qh, row, col)
    kh = axial_rope(kh, row, col)
    attn_out = block_attention(qh, kh, vh_a).astype(x.dtype)

    mix = jnp.concatenate([rwkv_out, attn_out], axis=-1) @ w_out
    x = x + gate_m * mix

    h2 = rms_norm(x, norm_ffn_g, NORM_EPS) * (1.0 + scale_f) + shift_f
    gt, up = jnp.split(h2 @ w_ffn_in, 2, axis=-1)
    x = x + gate_f * ((jax.nn.silu(gt) * up) @ w_ffn_out)
    return x


def setup_inputs(seed: int = 0) -> dict:
    key = jax.random.key(seed)
    ks = jax.random.split(key, 32)
    nrm = lambda i, shape: jax.random.normal(ks[i], shape, jnp.float32)
    centre = jnp.array([0.0, 1.0, 0.0], jnp.float32)[None, :, None]
    return {
        "x_prompt": nrm(0, (BATCH, SEQ, D_MODEL)),
        "x_sample": nrm(1, (DEC_BATCH, DEC_SEQ, D_MODEL)),
        "c_prompt": nrm(2, (BATCH, D_MODEL)),
        "c_sample": nrm(3, (DEC_BATCH, D_MODEL)),
        "ada_w": nrm(4, (DEPTH, D_MODEL, 6 * D_MODEL)) * (0.5 * D_MODEL ** -0.5),
        "ada_b": nrm(5, (DEPTH, 6 * D_MODEL)) * 0.02,
        "norm_mix_g": 1.0 + 0.02 * nrm(6, (DEPTH, D_MODEL)),
        "norm_ffn_g": 1.0 + 0.02 * nrm(7, (DEPTH, D_MODEL)),
        "w_in": nrm(8, (DEPTH, D_MODEL, IN_COLS)) * D_MODEL ** -0.5,
        "conv_w": centre + 0.2 * nrm(9, (DEPTH, CONV_W, 3 * RWKV_DIM)),
        "decay_w0": 0.5 * nrm(10, (DEPTH, N_DIR, RWKV_DIM)),
        "decay_up": nrm(11, (DEPTH, N_DIR, DECAY_LORA, RWKV_DIM)) * (0.5 * DECAY_LORA ** -0.5),
        "iclr_a0": 0.5 * nrm(12, (DEPTH, N_DIR, RWKV_DIM)),
        "iclr_up": nrm(13, (DEPTH, N_DIR, ICLR_LORA, RWKV_DIM)) * (0.5 * ICLR_LORA ** -0.5),
        "gate_up": nrm(14, (DEPTH, GATE_LORA, RWKV_DIM)) * GATE_LORA ** -0.5,
        "k_k": 0.85 + 0.1 * nrm(15, (DEPTH, RWKV_DIM)),
        "k_a": 1.0 + 0.1 * nrm(16, (DEPTH, RWKV_DIM)),
        "r_k": 0.1 * nrm(17, (DEPTH, RWKV_HEADS, HEAD_DIM)),
        "ln_x_g": 1.0 + 0.02 * nrm(18, (DEPTH, RWKV_DIM)),
        "ln_x_b": 0.02 * nrm(19, (DEPTH, RWKV_DIM)),
        "q_norm_g": 1.0 + 0.02 * nrm(20, (DEPTH, HEAD_DIM)),
        "k_norm_g": 1.0 + 0.02 * nrm(21, (DEPTH, HEAD_DIM)),
        "w_out": nrm(22, (DEPTH, MIX_DIM, D_MODEL)) * MIX_DIM ** -0.5,
        "w_ffn_in": nrm(23, (DEPTH, D_MODEL, 2 * D_FF)) * D_MODEL ** -0.5,
        "w_ffn_out": nrm(24, (DEPTH, D_FF, D_MODEL)) * D_FF ** -0.5,
    }


def reference(x_prompt, x_sample, c_prompt, c_sample, ada_w, ada_b, norm_mix_g, norm_ffn_g, w_in,
              conv_w, decay_w0, decay_up, iclr_a0, iclr_up, gate_up, k_k, k_a, r_k, ln_x_g, ln_x_b,
              q_norm_g, k_norm_g, w_out, w_ffn_in, w_ffn_out):
    def run_trunk(x, c):
        for l in range(DEPTH):
            x = hybrid_layer(x, c, ada_w[l], ada_b[l], norm_mix_g[l], norm_ffn_g[l], w_in[l],
                             conv_w[l], decay_w0[l], decay_up[l], iclr_a0[l], iclr_up[l],
                             gate_up[l], k_k[l], k_a[l], r_k[l], ln_x_g[l], ln_x_b[l],
                             q_norm_g[l], k_norm_g[l], w_out[l], w_ffn_in[l], w_ffn_out[l])
        return x

    y_prompt = run_trunk(x_prompt, c_prompt)
    y_sample = run_trunk(x_sample, c_sample)
    return (y_prompt, y_sample)
```

```cpp
#include <hip/hip_runtime.h>
#include <hip/hip_cooperative_groups.h>
#include <cstdio>
#include <cstdint>
namespace pg8 {
#define PG8_LAS __attribute__((address_space(3)))
typedef unsigned short bf16_t;
typedef short bf16x8 __attribute__((ext_vector_type(8)));
typedef float f32x4 __attribute__((ext_vector_type(4)));
typedef unsigned u32x4 __attribute__((ext_vector_type(4)));
constexpr int BM = 256, BK = 64, HALF = 128, HTB = HALF * BK * 2  , STAGE_BYTES = 8 * HTB, NXCD = 8, WGM = 8;

__host__ __device__ __forceinline__ int lds_byte(int r, int c) { const int st = (r >> 4) * 2 + (c >> 5), rr = r & 15, cc = c & 31, ob = rr * 64 + cc * 2; return st * 1024 + (ob ^ (((ob >> 9) & 1) << 5)); }
__host__ __device__ __forceinline__ void stage_rc(int b, int& R, int& C) { const int st = b / 1024, sb = b % 1024, swz = sb ^ (((sb >> 9) & 1) << 5); R = (st >> 1) * 16 + swz / 64; C = (st & 1) * 32 + (swz % 64) / 2; }
__host__ __device__ __forceinline__ int perm32(int rho) { const int n = rho >> 4, i = rho & 15; return 8 * (i >> 2) + 4 * n + (i & 3); }

struct Unit { int pm, pn; };
struct Gemm { const bf16_t* A; const bf16_t* Bt; int M, N, K; };

struct StaticOrder {
    int nM, nN, nwg, G, c;
    __host__ __device__ void init(int M, int N, int G_, int c_) { nM = M / BM; nN = N / BM; nwg = nM * nN; G = G_; c = c_; }
    __host__ __device__ bool next(int i, Unit& u) const {
        const int L = i * G + c; if (L >= nwg) return false;
        int wgid = (int)L; { const int q = nwg / NXCD, r = nwg % NXCD, xcd = wgid % NXCD, off = wgid / NXCD; wgid = (xcd < r ? xcd * (q + 1) : r * (q + 1) + (xcd - r) * q) + off; }
        const int nig = WGM * nN, gid = wgid / nig, fm = gid * WGM, gsz = (nM - fm) < WGM ? (nM - fm) : WGM;
        u.pm = fm + ((wgid % nig) % gsz); u.pn = (wgid % nig) / gsz; return true;
    }
    __device__ __forceinline__ void a_ready(const Unit&) const {}
    __device__ __forceinline__ void done(const Unit&) const {}
};

__device__ __forceinline__ unsigned cvt_pk_bf16(float lo, float hi) { unsigned r; asm volatile("v_cvt_pk_bf16_f32 %0, %1, %2" : "=v"(r) : "v"(lo), "v"(hi)); return r; }
struct EpiInProj {
    static constexpr bool PERM = true, AFTER_DRAIN = false;
    bf16_t* projR; bf16_t* mixin; bf16_t* kv;
    __device__ __forceinline__ void operator()(const f32x4 (&acc)[2][2][4][2], const Unit& u, int wr, int wc, int fr, int fq) const {
        const int pn = u.pn; bf16_t* base; int ldc, colt;
        if (pn < 6) { base = projR; ldc = 2048; colt = pn * 256; }
        else if (pn < 8) { base = mixin; ldc = 1024; colt = 512 + (pn - 6) * 256; }
        else if (pn == 8) { base = kv; ldc = 256; colt = 0; }
        else { base = projR; ldc = 2048; colt = 1536 + (pn - 9) * 256; }
        const int row0 = u.pm * BM + wr * 64 + fr, col0 = colt + wc * 32 + 8 * fq;
#pragma unroll
        for (int ai = 0; ai < 2; ++ai)
#pragma unroll
            for (int m = 0; m < 4; ++m) { bf16_t* rowp = base + (size_t)(row0 + ai * HALF + m * 16) * ldc + col0;
#pragma unroll
                for (int bj = 0; bj < 2; ++bj) { const f32x4 v0 = acc[ai][bj][m][0], v1 = acc[ai][bj][m][1];
                    u32x4 w; w.x = cvt_pk_bf16(v0[0], v0[1]); w.y = cvt_pk_bf16(v0[2], v0[3]); w.z = cvt_pk_bf16(v1[0], v1[1]); w.w = cvt_pk_bf16(v1[2], v1[3]);
                    *(u32x4*)(rowp + bj * HALF) = w; } }
    }
};
struct EpiResid {
    static constexpr bool PERM = false, AFTER_DRAIN = false;
    const float* xp; const float* xs; float* out; const float* gate;
    __device__ __forceinline__ void operator()(const f32x4 (&acc)[2][2][4][2], const Unit& u, int wr, int wc, int fr, int fq) const {
        const int seq = u.pm < 64 ? 0 : 1 + ((u.pm - 64) >> 4);
        const float* gp = gate + (size_t)seq * 12288;
        const int col0 = u.pn * BM + wc * 32 + 4 * fq;
        f32x4 gv[2][2];
#pragma unroll
        for (int bj = 0; bj < 2; ++bj)
#pragma unroll
            for (int n = 0; n < 2; ++n) gv[bj][n] = *(const f32x4*)(gp + col0 + bj * HALF + n * 16);

#ifdef EXP_XOUT
        const float* xb = out;
#else
        const float* xb = u.pm < 64 ? xp : xs - (size_t)16384 * 1024;
#endif

#pragma unroll
        for (int ai = 0; ai < 2; ++ai) {
            f32x4 bsv[4][2][2];
#pragma unroll
            for (int m = 0; m < 4; ++m) { const size_t off = (size_t)(u.pm * BM + ai * HALF + wr * 64 + m * 16 + fr) * 1024 + col0;
#pragma unroll
                for (int bj = 0; bj < 2; ++bj)
#pragma unroll
                    for (int n = 0; n < 2; ++n) bsv[m][bj][n] = *(const f32x4*)(xb + off + bj * HALF + n * 16); }
            asm volatile("" ::: "memory");
#pragma unroll
            for (int m = 0; m < 4; ++m) { const size_t off = (size_t)(u.pm * BM + ai * HALF + wr * 64 + m * 16 + fr) * 1024 + col0;
#pragma unroll
                for (int bj = 0; bj < 2; ++bj)
#pragma unroll
                    for (int n = 0; n < 2; ++n) *(f32x4*)(out + off + bj * HALF + n * 16) = bsv[m][bj][n] + gv[bj][n] * acc[ai][bj][m][n]; }
            asm volatile("" ::: "memory");
        }
    }
};
struct EpiSwiGLU {
    static constexpr bool PERM = true, AFTER_DRAIN = false;
    bf16_t* act;
    __device__ __forceinline__ void operator()(const f32x4 (&acc)[2][2][4][2], const Unit& u, int wr, int wc, int fr, int fq) const {
        const int row0 = u.pm * BM + wr * 64 + fr, col0 = u.pn * 128 + wc * 32 + 8 * fq;
#pragma unroll
        for (int ai = 0; ai < 2; ++ai)
#pragma unroll
            for (int m = 0; m < 4; ++m) { bf16_t* rowp = act + (size_t)(row0 + ai * HALF + m * 16) * 2816 + col0;
                float o[8];
#pragma unroll
                for (int n = 0; n < 2; ++n)
#pragma unroll
                    for (int i = 0; i < 4; ++i) { const float g = acc[ai][0][m][n][i], up = acc[ai][1][m][n][i];
                        o[n * 4 + i] = g * __builtin_amdgcn_rcpf(1.0f + __builtin_amdgcn_exp2f(-1.4426950408889634f * g)) * up; }
                u32x4 w; w.x = cvt_pk_bf16(o[0], o[1]); w.y = cvt_pk_bf16(o[2], o[3]); w.z = cvt_pk_bf16(o[4], o[5]); w.w = cvt_pk_bf16(o[6], o[7]);
                *(u32x4*)rowp = w; }
    }
};
template <class Epi, class Sched, bool ALIGN_EPI = false, bool SP2 = false>
__device__ __forceinline__ void gemm_phase(PG8_LAS unsigned char* lds, const Gemm g, const Sched& S, const Epi& E, int tid_in) {
    int tid_ = tid_in; asm volatile("" : "+v"(tid_)); const int tid = tid_, wid = __builtin_amdgcn_readfirstlane(tid >> 6), lane = tid & 63, wr = wid >> 2, wc = wid & 3, fr = lane & 15, fq = lane >> 4;
    const int K = g.K, nt = K / BK;
    unsigned voffA[2], voffB[2];
#pragma unroll
    for (int i = 0; i < 2; ++i) { int R, C; stage_rc(tid * 16 + i * 8192, R, C); const int Rb = Epi::PERM ? ((R & ~31) + perm32(R & 31)) : R;
        voffA[i] = (unsigned)(R * K + C) * 2u; voffB[i] = (unsigned)(Rb * K + C) * 2u; }
    const size_t kstep = (size_t)(BK * 2);
    const size_t hstep = (size_t)HALF * K * 2;
    const size_t tstep = 2 * hstep;
    const unsigned ldsw = (unsigned)wid * 1024u;
    const int aoff = lds_byte(wr * 64 + fr, fq * 8), boff = lds_byte(wc * 32 + fr, fq * 8);
#define PG8_SA(b, h) (((b) * 2 + (h)) * HTB)
#define PG8_SB(b, h) ((4 + (b) * 2 + (h)) * HTB)
#define PG8_STAGE(bufoff, gbase, voff) do { _Pragma("unroll") for (int _i = 0; _i < 2; ++_i) \
        __builtin_amdgcn_global_load_lds((const unsigned*)((const char*)(gbase) + (voff)[_i]), (PG8_LAS unsigned*)(lds + (bufoff) + ldsw + _i * 8192), 16, 0, 0); } while (0)
#define PG8_LDA(dst, b, h) do { _Pragma("unroll") for (int m = 0; m < 4; ++m) _Pragma("unroll") for (int k = 0; k < 2; ++k) dst[m][k] = *(const PG8_LAS bf16x8*)(lds + PG8_SA(b, h) + aoff + m * 2048 + k * 1024); } while (0)
#define PG8_LDB(dst, b, h) do { _Pragma("unroll") for (int n = 0; n < 2; ++n) _Pragma("unroll") for (int k = 0; k < 2; ++k) dst[n][k] = *(const PG8_LAS bf16x8*)(lds + PG8_SB(b, h) + boff + n * 2048 + k * 1024); } while (0)
#define PG8_MMA(ai, bj, At, Bt) do { __builtin_amdgcn_s_setprio(1); _Pragma("unroll") for (int m = 0; m < 4; ++m) _Pragma("unroll") for (int n = 0; n < 2; ++n) _Pragma("unroll") for (int k = 0; k < 2; ++k) \
        acc[ai][bj][m][n] = __builtin_amdgcn_mfma_f32_16x16x32_bf16(Bt[n][k], At[m][k], acc[ai][bj][m][n], 0, 0, 0); __builtin_amdgcn_s_setprio(0); } while (0)
#define PG8_WAIT_V(n) asm volatile("s_waitcnt vmcnt(" #n ")" ::: "memory")
#define PG8_WAIT_L(n) asm volatile("s_waitcnt lgkmcnt(" #n ")" ::: "memory")
#define PG8_BAR __builtin_amdgcn_s_barrier()
#define PG8_SCHED __builtin_amdgcn_sched_barrier(0)
    Unit cur, nxt; int ui = 0;
    if (!S.next(0, cur)) return;
    f32x4 acc[2][2][4][2];
#pragma unroll
    for (int a = 0; a < 2; ++a)
#pragma unroll
        for (int b = 0; b < 2; ++b)
#pragma unroll
            for (int m = 0; m < 4; ++m)
#pragma unroll
                for (int n = 0; n < 2; ++n) acc[a][b][m][n] = (f32x4){0.f, 0.f, 0.f, 0.f};
    bf16x8 At[4][2], B0[2][2], B1[2][2];
    const char* cA = (const char*)g.A + (size_t)cur.pm * tstep; const char* cB = (const char*)g.Bt + (size_t)cur.pn * tstep;
    S.a_ready(cur);
    if constexpr (SP2) {
        PG8_STAGE(PG8_SB(0, 0), cB, voffB); PG8_STAGE(PG8_SB(0, 1), cB + hstep, voffB); PG8_STAGE(PG8_SA(0, 0), cA, voffA); PG8_STAGE(PG8_SA(0, 1), cA + hstep, voffA);
        if (wr == 1) PG8_BAR;
        PG8_WAIT_V(2); PG8_BAR;
        PG8_STAGE(PG8_SB(1, 0), cB + kstep, voffB); PG8_STAGE(PG8_SA(1, 0), cA + kstep, voffA); PG8_STAGE(PG8_SB(1, 1), cB + hstep + kstep, voffB);
        PG8_WAIT_V(6); PG8_BAR;
    } else {
        PG8_STAGE(PG8_SB(0, 0), cB, voffB); PG8_STAGE(PG8_SA(0, 0), cA, voffA); PG8_STAGE(PG8_SB(0, 1), cB + hstep, voffB); PG8_STAGE(PG8_SA(0, 1), cA + hstep, voffA);
        if (wr == 1) PG8_BAR;
        PG8_WAIT_V(4); PG8_BAR;
        PG8_STAGE(PG8_SB(1, 0), cB + kstep, voffB); PG8_STAGE(PG8_SA(1, 0), cA + kstep, voffA); PG8_STAGE(PG8_SB(1, 1), cB + hstep + kstep, voffB);
        PG8_WAIT_V(6); PG8_BAR;
    }
    for (;;) {
        const bool has_next = S.next(ui + 1, nxt);
        const char* nA = has_next ? (const char*)g.A + (size_t)nxt.pm * tstep : cA; const char* nB = has_next ? (const char*)g.Bt + (size_t)nxt.pn * tstep : cB;
        for (int t = 0; t < nt; t += 2) {
            const bool last = (t == nt - 2);
            const char* a1 = cA + (size_t)(t + 1) * kstep;
            const char* a2 = last ? nA : cA + (size_t)(t + 2) * kstep; const char* b2 = last ? nB : cB + (size_t)(t + 2) * kstep;
            const char* a3 = a2 + kstep; const char* b3 = b2 + kstep;
            if (last && has_next) S.a_ready(nxt);
            if constexpr (SP2) {
            PG8_LDB(B0, 0, 0); PG8_LDB(B1, 0, 1); PG8_SCHED; PG8_LDA(At, 0, 0); PG8_STAGE(PG8_SA(1, 1), a1 + hstep, voffA);
            PG8_WAIT_V(8); PG8_WAIT_L(0); PG8_BAR; PG8_MMA(0, 0, At, B0); PG8_MMA(0, 1, At, B1); PG8_BAR; PG8_SCHED;
            PG8_LDA(At, 0, 1); PG8_STAGE(PG8_SB(0, 0), b2, voffB); PG8_STAGE(PG8_SB(0, 1), b2 + hstep, voffB); PG8_STAGE(PG8_SA(0, 0), a2, voffA);
            PG8_WAIT_V(8); PG8_WAIT_L(0); PG8_BAR; PG8_MMA(1, 0, At, B0); PG8_MMA(1, 1, At, B1); PG8_BAR; PG8_SCHED;
            PG8_LDB(B0, 1, 0); PG8_LDB(B1, 1, 1); PG8_SCHED; PG8_LDA(At, 1, 0); PG8_STAGE(PG8_SA(0, 1), a2 + hstep, voffA);
            PG8_WAIT_V(8); PG8_WAIT_L(0); PG8_BAR; PG8_MMA(0, 0, At, B0); PG8_MMA(0, 1, At, B1); PG8_BAR; PG8_SCHED;
            PG8_LDA(At, 1, 1); PG8_STAGE(PG8_SB(1, 0), b3, voffB); PG8_STAGE(PG8_SB(1, 1), b3 + hstep, voffB); PG8_STAGE(PG8_SA(1, 0), a3, voffA);
            PG8_WAIT_V(8); PG8_WAIT_L(0); PG8_BAR; PG8_MMA(1, 0, At, B0); PG8_MMA(1, 1, At, B1); PG8_BAR; PG8_SCHED;
            } else {
            PG8_LDB(B0, 0, 0); PG8_SCHED; PG8_LDA(At, 0, 0); PG8_STAGE(PG8_SA(1, 1), a1 + hstep, voffA);
            PG8_WAIT_L(8); PG8_BAR; PG8_WAIT_L(0); PG8_MMA(0, 0, At, B0); PG8_BAR; PG8_SCHED;
            PG8_LDB(B1, 0, 1); PG8_STAGE(PG8_SB(0, 0), b2, voffB);
            PG8_BAR; PG8_WAIT_L(0); PG8_MMA(0, 1, At, B1); PG8_BAR;
            PG8_LDA(At, 0, 1); PG8_STAGE(PG8_SA(0, 0), a2, voffA);
            PG8_BAR; PG8_WAIT_L(0); PG8_MMA(1, 0, At, B0); PG8_BAR; PG8_SCHED;
            PG8_STAGE(PG8_SB(0, 1), b2 + hstep, voffB);
            PG8_WAIT_V(6); PG8_BAR; PG8_MMA(1, 1, At, B1); PG8_BAR;
            PG8_LDB(B0, 1, 0); PG8_SCHED; PG8_LDA(At, 1, 0); PG8_STAGE(PG8_SA(0, 1), a2 + hstep, voffA);
            PG8_WAIT_L(8); PG8_BAR; PG8_WAIT_L(0); PG8_MMA(0, 0, At, B0); PG8_BAR; PG8_SCHED;
            PG8_LDB(B1, 1, 1); PG8_STAGE(PG8_SB(1, 0), b3, voffB);
            PG8_BAR; PG8_WAIT_L(0); PG8_MMA(0, 1, At, B1); PG8_BAR;
            PG8_LDA(At, 1, 1); PG8_STAGE(PG8_SA(1, 0), a3, voffA);
            PG8_BAR; PG8_WAIT_L(0); PG8_MMA(1, 0, At, B0); PG8_BAR; PG8_SCHED;
            PG8_STAGE(PG8_SB(1, 1), b3 + hstep, voffB);
            PG8_WAIT_V(6); PG8_BAR; PG8_MMA(1, 1, At, B1); PG8_BAR;
            }
        }
        if constexpr (ALIGN_EPI) { if (wr == 0) PG8_BAR; }
        if constexpr (!Epi::AFTER_DRAIN) { E(acc, cur, wr, wc, fr, fq); S.done(cur); }
        if (!has_next) break;
#pragma unroll
        for (int a = 0; a < 2; ++a)
#pragma unroll
            for (int b = 0; b < 2; ++b)
#pragma unroll
                for (int m = 0; m < 4; ++m)
#pragma unroll
                    for (int n = 0; n < 2; ++n) acc[a][b][m][n] = (f32x4){0.f, 0.f, 0.f, 0.f};
        cur = nxt; cA = nA; cB = nB; ++ui;
        if constexpr (ALIGN_EPI) { if (wr == 1) PG8_BAR; }
    }
    PG8_WAIT_V(0);
    if constexpr (!ALIGN_EPI) { if (wr == 0) PG8_BAR; }
    PG8_BAR;
    if constexpr (Epi::AFTER_DRAIN) { E.fused(acc, cur, wr, wc, fr, fq, lds, wid, lane); S.done(cur); }
#undef PG8_SA
#undef PG8_SB
#undef PG8_STAGE
#undef PG8_LDA
#undef PG8_LDB
#undef PG8_MMA
#undef PG8_WAIT_V
#undef PG8_WAIT_L
#undef PG8_BAR
#undef PG8_SCHED
}
}

#ifndef PG8_SP2
#define PG8_SP2 true
#endif
#ifndef PG8_ALIGN
#define PG8_ALIGN true
#endif
#include <hip/hip_bf16.h>
#include <cmath>
namespace attn_body {
using bf16=__hip_bfloat16;
using bf16x8=__attribute__((ext_vector_type(8)))short;
using s16x4=__attribute__((ext_vector_type(4)))short;
using f32x16=__attribute__((ext_vector_type(16)))float;
using u32x4=__attribute__((ext_vector_type(4)))unsigned;
constexpr int D=64,QP=1024,KVP=256;
constexpr int NW=8,QBLK=32,QB=QBLK*NW,KVBLK=64;
constexpr int ATTN_UNIT_ROWS=QB;
__device__ __forceinline__ int crow(int r,int hi){return (r&3)+8*(r>>2)+4*hi;}
#define SBAR() __builtin_amdgcn_sched_barrier(0)
__device__ __forceinline__ void cmask(f32x16&p0,f32x16&p1,int jb,int qrel,int hi){
  const float NEG=-INFINITY; int kb=64*jb+4*hi;
  #pragma unroll
  for(int r=0;r<16;++r){int kv=kb+(r&3)+8*(r>>2); if(kv>qrel)p0[r]=NEG; if(kv+32>qrel)p1[r]=NEG;}
}

constexpr int NSLOT=3, SLOTB=8192;
constexpr int LDS_K=0, LDS_V=NSLOT*SLOTB, LDS_WS=2*NSLOT*SLOTB, LDS_OST=LDS_WS+NW*64*4, LDS_BYTES=LDS_OST+NW*4096;
constexpr float C2=0.125f*1.4426950408889634f;
__device__ __forceinline__ void glds16(const void*gsrc,unsigned lds_dst){unsigned keep;
  asm volatile("s_mov_b32 %0, m0\n\ts_mov_b32 m0, %2\n\ts_nop 0\n\tglobal_load_lds_dwordx4 %1, off\n\ts_mov_b32 m0, %0":"=&s"(keep):"v"(gsrc),"s"(lds_dst):"memory");}
__device__ __forceinline__ float max3f(float a,float b,float c){float r;asm("v_max3_f32 %0, %1, %2, %3":"=v"(r):"v"(a),"v"(b),"v"(c));return r;}
__device__ __forceinline__ float max2f(float a,float b){float r;asm("v_max_f32_e32 %0, %1, %2":"=v"(r):"v"(a),"v"(b));return r;}
__device__ __forceinline__ float fadd_s(float a,float b){float r;asm("v_add_f32_e32 %0, %1, %2":"=v"(r):"v"(a),"v"(b));return r;}
__device__ __forceinline__ float fsub_s(float a,float b){float r;asm("v_sub_f32_e32 %0, %1, %2":"=v"(r):"v"(a),"v"(b));return r;}
typedef float f32x2_t __attribute__((ext_vector_type(2))); typedef __bf16 bf16x2_t __attribute__((ext_vector_type(2)));
__device__ __forceinline__ unsigned cvtpk_s(float lo,float hi){f32x2_t v={lo,hi};bf16x2_t b=__builtin_convertvector(v,bf16x2_t);return __builtin_bit_cast(unsigned,b);}
#define WAIT_BAR(N) asm volatile("s_waitcnt vmcnt(" #N ") lgkmcnt(0)\n\ts_barrier":::"memory")

__device__ __forceinline__ void qkt(f32x16&p0,f32x16&p1,const char*Kslot,const bf16x8*qr,const f32x16&negm,int r32,int hi){
  const char*kb=Kslot+hi*1024+r32*16;
  #pragma unroll
  for(int d0=0;d0<4;++d0){
    const bf16x8 b0=*reinterpret_cast<const bf16x8*>(kb+d0*2048);
    const bf16x8 b1=*reinterpret_cast<const bf16x8*>(kb+d0*2048+512);
    if(d0==0){p0=__builtin_amdgcn_mfma_f32_32x32x16_bf16(b0,qr[0],negm,0,0,0);p1=__builtin_amdgcn_mfma_f32_32x32x16_bf16(b1,qr[0],negm,0,0,0);}
    else{p0=__builtin_amdgcn_mfma_f32_32x32x16_bf16(b0,qr[d0],p0,0,0,0);p1=__builtin_amdgcn_mfma_f32_32x32x16_bf16(b1,qr[d0],p1,0,0,0);}}
}
typedef __attribute__((address_space(3))) const char* lds_cptr;
typedef short v4i16_t __attribute__((ext_vector_type(4)));
__device__ __forceinline__ void kload8(bf16x8*kf,lds_cptr kp){
  kf[0]=*(const __attribute__((address_space(3))) bf16x8*)(kp);      kf[1]=*(const __attribute__((address_space(3))) bf16x8*)(kp+512);
  kf[2]=*(const __attribute__((address_space(3))) bf16x8*)(kp+2048); kf[3]=*(const __attribute__((address_space(3))) bf16x8*)(kp+2560);
  kf[4]=*(const __attribute__((address_space(3))) bf16x8*)(kp+4096); kf[5]=*(const __attribute__((address_space(3))) bf16x8*)(kp+4608);
  kf[6]=*(const __attribute__((address_space(3))) bf16x8*)(kp+6144); kf[7]=*(const __attribute__((address_space(3))) bf16x8*)(kp+6656);
}
__device__ __forceinline__ void kload2(bf16x8*kf,lds_cptr kp,int j){ kf[2*j]=*(const __attribute__((address_space(3))) bf16x8*)(kp+j*2048); kf[2*j+1]=*(const __attribute__((address_space(3))) bf16x8*)(kp+j*2048+512); }
__device__ __forceinline__ s16x4 vtr(lds_cptr p){ return __builtin_bit_cast(s16x4,__builtin_amdgcn_ds_read_tr16_b64_v4i16((__attribute__((address_space(3))) v4i16_t*)p)); }
__device__ __forceinline__ float rowmax(const f32x16&p0,const f32x16&p1){
  float a=max3f(p0[0],p0[1],p1[0]),b=max3f(p0[2],p0[3],p1[1]);a=max3f(a,p1[2],p1[3]);
  #pragma unroll
  for(int r=4;r<16;r+=4){a=max3f(a,p0[r],p0[r+1]);b=max3f(b,p0[r+2],p0[r+3]);a=max3f(a,p1[r],p1[r+1]);b=max3f(b,p1[r+2],p1[r+3]);}
  const float m=max2f(a,b);
  auto rr=__builtin_amdgcn_permlane32_swap(__float_as_uint(m),__float_as_uint(m),false,false);
  return max2f(__uint_as_float(rr[0]),__uint_as_float(rr[1]));
}
__device__ __forceinline__ void pv(f32x16*o,int vb,bf16x8 pa0,bf16x8 pa1,bf16x8 pa2,bf16x8 pa3){
  #pragma unroll
  for(int d0=0;d0<2;++d0){s16x4 lo[4],hi[4];
    #pragma unroll
    for(int ks=0;ks<4;++ks){
      asm volatile("ds_read_b64_tr_b16 %0,%1 offset:%c2":"=&v"(lo[ks]):"v"(vb),"i"(d0*4096+ks*1024):"memory");
      asm volatile("ds_read_b64_tr_b16 %0,%1 offset:%c2":"=&v"(hi[ks]):"v"(vb),"i"(d0*4096+ks*1024+512):"memory");}
    asm volatile("s_waitcnt lgkmcnt(0)":::"memory");SBAR();
    #define PK(k) (bf16x8){lo[k][0],lo[k][1],lo[k][2],lo[k][3],hi[k][0],hi[k][1],hi[k][2],hi[k][3]}
    o[d0]=__builtin_amdgcn_mfma_f32_32x32x16_bf16(pa0,PK(0),o[d0],0,0,0);
    o[d0]=__builtin_amdgcn_mfma_f32_32x32x16_bf16(pa1,PK(1),o[d0],0,0,0);
    o[d0]=__builtin_amdgcn_mfma_f32_32x32x16_bf16(pa2,PK(2),o[d0],0,0,0);
    o[d0]=__builtin_amdgcn_mfma_f32_32x32x16_bf16(pa3,PK(3),o[d0],0,0,0);
    #undef PK
  }
}

#ifndef ATTN_STORE16
#define ATTN_STORE16(p,v) (*(u32x4*)(p)=(v))
#endif
template<int THRL> __device__ __forceinline__ void attn_unit(long rowbase,int T,int h,int qb,const bf16*Q,const bf16*K,const bf16*V,bf16*O,char*shm,int tid_in){
  int tid_=tid_in; asm volatile("":"+v"(tid_)); const int tid=tid_,lane=tid&63,r32=lane&31,hi=lane>>5; const int wid=__builtin_amdgcn_readfirstlane(tid>>6);
  const int q0=qb*QB;
  const bf16*Qw=Q+(rowbase+q0+wid*QBLK)*QP+h*D;
  const bf16*Kh=K+rowbase*KVP+(h>>2)*D,*Vh=V+rowbase*KVP+(h>>2)*D;
  const unsigned lds0=(unsigned)(uintptr_t)shm;
  float*wsf=(float*)(shm+LDS_WS)+wid*64;
  const bf16*ksrc=Kh+(long)lane*KVP+wid*8;
  const bf16*vsrc=Vh+(long)(16*(wid&3)+(lane>>2))*KVP+(wid>>2)*32+(lane&3)*8;
  const unsigned kdst=lds0+LDS_K+wid*1024, vdst=lds0+LDS_V+wid*1024;
  #define DMA_K(t,slot) glds16(ksrc+(long)(t)*KVBLK*KVP,(unsigned)__builtin_amdgcn_readfirstlane(kdst+(slot)))
  #define DMA_V(t,slot) glds16(vsrc+(long)(t)*KVBLK*KVP,(unsigned)__builtin_amdgcn_readfirstlane(vdst+(slot)))
  const int vb0=(int)(lds0+LDS_V)+((lane>>4)&1)*32+(lane&3)*8+(4*hi+((lane&15)>>2))*64;
  const char*Kbase=shm+LDS_K; bf16x8 kf[8];
  const lds_cptr shm3=(lds_cptr)shm; const lds_cptr kp0=shm3+LDS_K+hi*1024+r32*16; const lds_cptr vp0=shm3+LDS_V+((lane>>4)&1)*32+(lane&3)*8+(4*hi+((lane&15)>>2))*64;
  const int NT=T/KVBLK;
  DMA_K(0,0);DMA_V(0,0);DMA_K(1,SLOTB);
  bf16x8 qr[4];
  #pragma unroll
  for(int d0=0;d0<4;++d0)qr[d0]=*reinterpret_cast<const bf16x8*>(&Qw[(long)r32*QP+d0*16+hi*8]);
  float mhat=0.f,l_reg=0.f;f32x16 o[2];o[0]=f32x16{};o[1]=f32x16{};f32x16 negm=f32x16{};asm volatile("":"+v"(negm));

  #define CMASK(P0,P1,t) do{}while(0)
  bool resc=false;
  #define START(P0,P1) do{ const float rm=rowmax(P0,P1); resc=false; \
    { const float dl=rm; mhat=fadd_s(mhat,dl); \
      _Pragma("unroll") for(int r=0;r<16;++r){P0[r]=fsub_s(P0[r],dl);P1[r]=fsub_s(P1[r],dl);} \
      _Pragma("unroll") for(int r=0;r<16;++r)negm[r]=-mhat; asm volatile("":"+v"(negm)); } \
    _Pragma("unroll") for(int r=0;r<16;++r)P0[r]=__builtin_amdgcn_exp2f(P0[r]); }while(0)
  #define RESC() do{ if(resc){ asm volatile("s_waitcnt lgkmcnt(0)":::"memory"); \
      _Pragma("unroll") for(int d_=0;d_<2;++d_) _Pragma("unroll") for(int r=0;r<16;++r)o[d_][r]*=wsf[crow(r,hi)]; } }while(0)
  f32x16 pA0,pA1,pB0,pB1;
  int sl_prev=0,sl_cur=0,sl_next=SLOTB;
  #define ROT() do{sl_prev=sl_cur;sl_cur=sl_next;sl_next=(sl_next==(NSLOT-1)*SLOTB)?0:sl_next+SLOTB;}while(0)
  DMA_K(2,2*SLOTB);
  WAIT_BAR(3);
  qkt(pA0,pA1,Kbase,qr,negm,r32,hi);asm volatile("s_nop 15\n\ts_nop 7":"+v"(pA0),"+v"(pA1));CMASK(pA0,pA1,0);
  START(pA0,pA1);
  _Pragma("unroll") for(int r=0;r<16;++r)pA1[r]=__builtin_amdgcn_exp2f(pA1[r]);
  WAIT_BAR(0);
  DMA_K(3,0);DMA_V(1,SLOTB);
  ROT();
  kload8(kf,kp0+sl_cur);
  WAIT_BAR(2);
  s16x4 vlo[8],vhi[8]; u32x4 pw0,pw1,pw2,pw3;
  #define PKW(P,B) cvtpk_s(P[B],P[B+1])
  #define PAF(k) __builtin_bit_cast(bf16x8,pw##k)
  #define VFR(i) (bf16x8){vlo[i][0],vlo[i][1],vlo[i][2],vlo[i][3],vhi[i][0],vhi[i][1],vhi[i][2],vhi[i][3]}
  #define PIN(x) asm volatile("":"+v"(x))
  #define MX3(a,b,c) __builtin_fmaxf(__builtin_fmaxf((a),(b)),(c))
  #define GAPA(MF,A0,A1,A2,A3,W0,W1,PW) do{ MF; sacc+=A0; sacc+=A1; sacc+=A2; sacc+=A3; PIN(sacc); W0; W1; PIN(PW); SBAR(); }while(0)
  #define EX(v) __builtin_amdgcn_exp2f(v)
  #define GAPB(MF,X,B) do{ MF; X[B]=EX(X[B]); X[B+1]=EX(X[B+1]); X[B+2]=EX(X[B+2]); X[B+3]=EX(X[B+3]); PIN(X); SBAR(); }while(0)
  #define VRD(i) do{ vlo[i]=vtr(vp_+(((i)>>2)*4096+((i)&3)*1024)); vhi[i]=vtr(vp_+(((i)>>2)*4096+((i)&3)*1024+512)); }while(0)
  #define KRD(G,j) do{ if(G){ kload2(kf,kp0+sl_next,j); SBAR(); } }while(0)
  #define STEP(C0,C1,P0,P1,t,GK,GV,GL) do{ SBAR(); \
    const lds_cptr vp_=vp0+sl_prev; \
    VRD(0); SBAR(); float sacc=(P0[0]+P0[1]); \
    GAPA(C0=__builtin_amdgcn_mfma_f32_32x32x16_bf16(kf[0],qr[0],negm,0,0,0), P0[2],P0[3],P0[4],P0[5],     pw0[0]=PKW(P0,0), pw0[1]=PKW(P0,2), pw0); \
    VRD(4); SBAR(); GAPA(C1=__builtin_amdgcn_mfma_f32_32x32x16_bf16(kf[1],qr[0],negm,0,0,0), P0[6],P0[7],P0[8],P0[9],     pw0[2]=PKW(P0,4), pw0[3]=PKW(P0,6), pw0); \
    VRD(1); SBAR(); GAPA(C0=__builtin_amdgcn_mfma_f32_32x32x16_bf16(kf[2],qr[1],C0,0,0,0),   P0[10],P0[11],P0[12],P0[13], pw1[0]=PKW(P0,8), pw1[1]=PKW(P0,10), pw1); \
    VRD(5); SBAR(); GAPA(C1=__builtin_amdgcn_mfma_f32_32x32x16_bf16(kf[3],qr[1],C1,0,0,0),   P0[14],P0[15],P1[0],P1[1],   pw1[2]=PKW(P0,12),pw1[3]=PKW(P0,14), pw1); \
    VRD(2); SBAR(); GAPA(C0=__builtin_amdgcn_mfma_f32_32x32x16_bf16(kf[4],qr[2],C0,0,0,0),   P1[2],P1[3],P1[4],P1[5],     pw2[0]=PKW(P1,0), pw2[1]=PKW(P1,2), pw2); \
    VRD(6); SBAR(); GAPA(C1=__builtin_amdgcn_mfma_f32_32x32x16_bf16(kf[5],qr[2],C1,0,0,0),   P1[6],P1[7],P1[8],P1[9],     pw2[2]=PKW(P1,4), pw2[3]=PKW(P1,6), pw2); \
    VRD(3); SBAR(); GAPA(C0=__builtin_amdgcn_mfma_f32_32x32x16_bf16(kf[6],qr[3],C0,0,0,0),   P1[10],P1[11],P1[12],P1[13], pw3[0]=PKW(P1,8), pw3[1]=PKW(P1,10), pw3); \
    VRD(7); SBAR(); GAPA(C1=__builtin_amdgcn_mfma_f32_32x32x16_bf16(kf[7],qr[3],C1,0,0,0),   P1[14],P1[15],0.f,0.f,       pw3[2]=PKW(P1,12),pw3[3]=PKW(P1,14), pw3); \
    l_reg+=sacc; \
    if(GK){DMA_K((t)+3,sl_cur);} if(GV){DMA_V((t)+1,sl_next);} \
    CMASK(C0,C1,t); \
    { float a=MX3(C0[0],C0[1],C1[0]),b=MX3(C0[2],C0[3],C1[1]); a=MX3(a,C1[2],C1[3]); \
      _Pragma("unroll") for(int r=4;r<16;r+=4){a=MX3(a,C0[r],C0[r+1]);b=MX3(b,C0[r+2],C0[r+3]);a=MX3(a,C1[r],C1[r+1]);b=MX3(b,C1[r+2],C1[r+3]);} \
      float rm=__builtin_fmaxf(a,b); { auto rr=__builtin_amdgcn_permlane32_swap(__float_as_uint(rm),__float_as_uint(rm),false,false); rm=__builtin_fmaxf(__uint_as_float(rr[0]),__uint_as_float(rr[1])); } \
      resc=false; \
      if(__builtin_expect(__any(rm>(float)THRL),0)){ const float dl=__builtin_fmaxf(rm,0.f); mhat+=dl; \
        _Pragma("unroll") for(int r=0;r<16;++r){C0[r]-=dl;C1[r]-=dl;} \
        _Pragma("unroll") for(int r=0;r<16;++r)negm[r]=-mhat; asm volatile("":"+v"(negm)); \
        const float f=__builtin_amdgcn_exp2f(-dl); l_reg*=f; if(hi==0)wsf[r32]=f; resc=true; } } \
    SBAR(); \
    GAPB(o[0]=__builtin_amdgcn_mfma_f32_32x32x16_bf16(PAF(0),VFR(0),o[0],0,0,0), C0,0); \
    GAPB(o[1]=__builtin_amdgcn_mfma_f32_32x32x16_bf16(PAF(0),VFR(4),o[1],0,0,0), C0,4); \
    KRD(GL,0); GAPB(o[0]=__builtin_amdgcn_mfma_f32_32x32x16_bf16(PAF(1),VFR(1),o[0],0,0,0), C0,8); \
    KRD(GL,1); GAPB(o[1]=__builtin_amdgcn_mfma_f32_32x32x16_bf16(PAF(1),VFR(5),o[1],0,0,0), C0,12); \
    KRD(GL,2); GAPB(o[0]=__builtin_amdgcn_mfma_f32_32x32x16_bf16(PAF(2),VFR(2),o[0],0,0,0), C1,0); \
    KRD(GL,3); GAPB(o[1]=__builtin_amdgcn_mfma_f32_32x32x16_bf16(PAF(2),VFR(6),o[1],0,0,0), C1,4); \
    GAPB(o[0]=__builtin_amdgcn_mfma_f32_32x32x16_bf16(PAF(3),VFR(3),o[0],0,0,0), C1,8); \
    GAPB(o[1]=__builtin_amdgcn_mfma_f32_32x32x16_bf16(PAF(3),VFR(7),o[1],0,0,0), C1,12); \
    }while(0)
  int t=1;
  #undef CMASK
  #define CMASK(P0,P1,t) do{}while(0)
  for(;t+5<NT;t+=2){
    STEP(pB0,pB1,pA0,pA1,t,true,true,true);     WAIT_BAR(2); RESC(); ROT();
    STEP(pA0,pA1,pB0,pB1,t+1,true,true,true);   WAIT_BAR(2); RESC(); ROT();
  }
  #undef CMASK
  #define CMASK(P0,P1,t) do{}while(0)
  #define ENDW(tt) do{ if((tt)+3<NT){WAIT_BAR(2);} else if((tt)+2<NT){WAIT_BAR(1);} else {WAIT_BAR(0);} }while(0)
  for(;t+1<NT;t+=2){
    STEP(pB0,pB1,pA0,pA1,t,(t+3<NT),(t+1<NT),(t+1<NT));       ENDW(t);   RESC(); ROT();
    STEP(pA0,pA1,pB0,pB1,t+1,(t+4<NT),(t+2<NT),(t+2<NT));     ENDW(t+1); RESC(); ROT();
  }
  STEP(pB0,pB1,pA0,pA1,NT-1,false,false,false); RESC();
  { float sacc=pB0[0]+pB0[1]; _Pragma("unroll") for(int r=2;r<16;++r)sacc+=pB0[r]; _Pragma("unroll") for(int r=0;r<16;++r)sacc+=pB1[r]; l_reg+=sacc;
    pw0=(u32x4){PKW(pB0,0),PKW(pB0,2),PKW(pB0,4),PKW(pB0,6)};pw1=(u32x4){PKW(pB0,8),PKW(pB0,10),PKW(pB0,12),PKW(pB0,14)};pw2=(u32x4){PKW(pB1,0),PKW(pB1,2),PKW(pB1,4),PKW(pB1,6)};pw3=(u32x4){PKW(pB1,8),PKW(pB1,10),PKW(pB1,12),PKW(pB1,14)};
    SBAR(); pv(o,vb0+sl_cur,PAF(0),PAF(1),PAF(2),PAF(3)); }
  #undef PKW
  #undef PAF
  #undef VFR
  #undef PIN
  #undef MX3
  #undef GAPA
  #undef GAPB
  #undef EX
  #undef VRD
  #undef KRD
  #undef STEP
  #undef ENDW
  {auto rr=__builtin_amdgcn_permlane32_swap(__float_as_uint(l_reg),__float_as_uint(l_reg),false,false);l_reg=__uint_as_float(rr[0])+__uint_as_float(rr[1]);}
  if(hi==0)wsf[32+r32]=l_reg;asm volatile("s_waitcnt lgkmcnt(0)":::"memory");
  float rli[16];
  #pragma unroll
  for(int r=0;r<16;++r)rli[r]=__builtin_amdgcn_rcpf(wsf[32+crow(r,hi)]);
  bf16*Ow=O+(rowbase+q0+wid*QBLK)*QP+h*D;
  { bf16*stg=(bf16*)(shm+LDS_OST)+wid*2048;
    #pragma unroll
    for(int r=0;r<16;++r){const int orow=crow(r,hi);
      #pragma unroll
      for(int d0=0;d0<2;++d0)stg[orow*64+d0*32+r32]=__float2bfloat16(o[d0][r]*rli[r]);}
    asm volatile("s_waitcnt lgkmcnt(0)":::"memory");
    #pragma unroll
    for(int i=0;i<4;++i){const int row=i*8+(lane>>3),ch=lane&7; const u32x4 v=*(const u32x4*)(stg+row*64+ch*8); ATTN_STORE16(Ow+(long)row*QP+ch*8,v);} }
  asm volatile("s_waitcnt lgkmcnt(0)\n\ts_barrier":::"memory");
  #undef DMA_K
  #undef DMA_V
  #undef CMASK
  #undef START
  #undef RESC
  #undef ROT
}
constexpr int ATTN_LDS_BYTES=LDS_BYTES;
#undef SBAR
#undef WAIT_BAR
}
namespace cg = cooperative_groups;
#define GAS __attribute__((address_space(1)))
#define LAS __attribute__((address_space(3)))
#define CAS __attribute__((address_space(4)))
typedef unsigned short bf16;
typedef unsigned v4u __attribute__((ext_vector_type(4)));
typedef unsigned v2u __attribute__((ext_vector_type(2)));
typedef float f32x4 __attribute__((ext_vector_type(4)));
typedef float f2 __attribute__((ext_vector_type(2)));
typedef short bf16x8 __attribute__((ext_vector_type(8)));
constexpr int NWAVES = 8;
constexpr int D = 1024, MP = 16384, MT = 81920, TSAMP = 4096, NSEQ = 17, DEPTH = 2;
constexpr int NINP = 2816, NINSRC = 2688, DFF = 2816, PRP = 2048, KVP = 256;
constexpr int NITEM_SCAN = 6144;
constexpr float NORM_EPS = 1e-6f, QK_EPS = 1e-6f, GN_EPS = 64e-5f, DECAY_SCALE = 0.6065306597126334f;
constexpr size_t MiB = 1u << 20;
constexpr size_t WS_MOD = 0;
constexpr size_t WS_CTL = 896 * 1024;
constexpr size_t WS_BON = 1 * MiB;
constexpr size_t WS_WSM = 7 * MiB;
constexpr size_t WS_WIN = 8 * MiB, WS_WOUT = 19 * MiB, WS_WFFI = 23 * MiB, WS_WFFO = 45 * MiB;
constexpr size_t WS_XN = 56 * MiB;
constexpr size_t WS_MIX = 216 * MiB;
constexpr size_t WS_PROJ = 376 * MiB;
constexpr size_t WS_KV = 696 * MiB;
constexpr size_t WS_P = 736 * MiB, WS_QS = 832 * MiB;
constexpr size_t WS_SLAB = 928 * MiB;
constexpr size_t WS_ACT = 376 * MiB;
constexpr size_t WS_END = 976 * MiB;
constexpr int LDS_BYTES = 163840;

__device__ __forceinline__ int bid_() { int v = (int)blockIdx.x; asm volatile("" : "+s"(v)); return v; }
__device__ __forceinline__ unsigned f2bf(float f) { unsigned u = __builtin_bit_cast(unsigned, f); return (u + 0x7fffu + ((u >> 16) & 1u)) >> 16; }
__device__ __forceinline__ unsigned pk2(float lo, float hi) { return f2bf(lo) | (f2bf(hi) << 16); }
__device__ __forceinline__ float bflo(unsigned u) { return __builtin_bit_cast(float, u << 16); }
__device__ __forceinline__ float bfhi(unsigned u) { return __builtin_bit_cast(float, u & 0xffff0000u); }
__device__ __forceinline__ f32x4 ld4bf(const bf16* p) { const v2u u = *(const v2u*)p; return (f32x4){bflo(u.x), bfhi(u.x), bflo(u.y), bfhi(u.y)}; }
__device__ __forceinline__ float sigmoidf_(float x) { return __builtin_amdgcn_rcpf(1.0f + __builtin_amdgcn_exp2f(-1.4426950408889634f * x)); }
__device__ __forceinline__ float tanhf_(float x) { return 1.0f - 2.0f * __builtin_amdgcn_rcpf(1.0f + __builtin_amdgcn_exp2f(2.8853900817779268f * x)); }
__device__ __forceinline__ float shx(float v, int o, int lane) { return __builtin_bit_cast(float, __builtin_amdgcn_ds_bpermute((lane ^ o) << 2, __builtin_bit_cast(int, v))); }
__device__ __forceinline__ float wave_sum(float v, int lane) {
#pragma unroll
    for (int o = 1; o < 64; o <<= 1) v += shx(v, o, lane);
    return v;
}
#define LDS_WAIT() asm volatile("s_waitcnt lgkmcnt(0)" ::: "memory")

struct Args { const float* in[25]; float* out; unsigned char* ws; };

__device__ __forceinline__ void p0_transpose_item(const float* W, int K, int N, bf16* WT, int k0, int src_n0, int dst_n0, bool zero, LAS float* scr, int lane) {
    if (!zero) {
#pragma unroll 8
        for (int i = 0; i < 32; ++i) { const int kk = 2 * i + (lane >> 5); scr[kk * 33 + (lane & 31)] = W[(size_t)(k0 + kk) * N + src_n0 + (lane & 31)]; }
    } else {
#pragma unroll 8
        for (int i = 0; i < 32; ++i) { const int kk = 2 * i + (lane >> 5); scr[kk * 33 + (lane & 31)] = 0.f; }
    }
    LDS_WAIT(); asm volatile("" ::: "memory");
    const int c = lane & 7;
#pragma unroll
    for (int j = 0; j < 4; ++j) { const int n = (lane >> 3) + 8 * j; const LAS float* s = scr + (8 * c) * 33 + n;
        v4u o; o.x = pk2(s[0 * 33], s[1 * 33]); o.y = pk2(s[2 * 33], s[3 * 33]); o.z = pk2(s[4 * 33], s[5 * 33]); o.w = pk2(s[6 * 33], s[7 * 33]);
        *(v4u*)(WT + (size_t)(dst_n0 + n) * K + k0 + 8 * c) = o; }
    LDS_WAIT(); asm volatile("" ::: "memory");
}
__device__ __forceinline__ void p0_prologue(const CAS Args* A, LAS unsigned char* lds, int wave, int lane, int G) {
    LAS float* scr = (LAS float*)(lds + wave * 16384);
    const int gw = bid_() * NWAVES + wave, NGW = G * NWAVES;
    constexpr int I_IN = 16 * 88, I_OUT = 16 * 32, I_FFI = 16 * 176, I_FFO = 44 * 32, I_LORA = 16 * 2, I_GATE = 2 * 16;
    constexpr int PER_L = I_IN + I_OUT + I_FFI + I_FFO + 2 * I_LORA + I_GATE;
    unsigned char* ws = A->ws;
    for (int it = gw; it < 2 * PER_L; it += NGW) {
        const int l = it / PER_L; int r = it % PER_L;
        if (r < I_IN) { const int kb = r / 88, nb = r % 88; const bool z = nb * 32 >= NINSRC;
            p0_transpose_item(A->in[8] + (size_t)l * D * NINSRC, D, NINSRC, (bf16*)(ws + WS_WIN) + (size_t)l * NINP * D, kb * 64, nb * 32, nb * 32, z, scr, lane); continue; } r -= I_IN;
        if (r < I_OUT) { const int kb = r / 32, nb = r % 32;
            p0_transpose_item(A->in[22] + (size_t)l * D * D, D, D, (bf16*)(ws + WS_WOUT) + (size_t)l * D * D, kb * 64, nb * 32, nb * 32, false, scr, lane); continue; } r -= I_OUT;
        if (r < I_FFI) { const int kb = r / 176, nb = r % 176; const int dn = nb * 32, pn = dn >> 8, rr = dn & 255; const int sn = rr < 128 ? pn * 128 + rr : DFF + pn * 128 + (rr - 128);
            p0_transpose_item(A->in[23] + (size_t)l * D * 2 * DFF, D, 2 * DFF, (bf16*)(ws + WS_WFFI) + (size_t)l * 2 * DFF * D, kb * 64, sn, dn, false, scr, lane); continue; } r -= I_FFI;
        if (r < I_FFO) { const int kb = r / 32, nb = r % 32;
            p0_transpose_item(A->in[24] + (size_t)l * DFF * D, DFF, D, (bf16*)(ws + WS_WFFO) + (size_t)l * D * DFF, kb * 64, nb * 32, nb * 32, false, scr, lane); continue; } r -= I_FFO;
        if (r < I_LORA) { const int d = r / 16, nb = r % 16;
            p0_transpose_item(A->in[11] + (size_t)(l * 2 + d) * 64 * 512, 64, 512, (bf16*)(ws + WS_WSM) + (size_t)(l * 2 + d) * 512 * 64, 0, nb * 32, nb * 32, false, scr, lane); continue; } r -= I_LORA;
        if (r < I_LORA) { const int d = r / 16, nb = r % 16;
            p0_transpose_item(A->in[13] + (size_t)(l * 2 + d) * 64 * 512, 64, 512, (bf16*)(ws + WS_WSM) + 131072 + (size_t)(l * 2 + d) * 512 * 64, 0, nb * 32, nb * 32, false, scr, lane); continue; } r -= I_LORA;
        { const int kb = r / 16, nb = r % 16;
            p0_transpose_item(A->in[14] + (size_t)l * 128 * 512, 128, 512, (bf16*)(ws + WS_WSM) + 262144 + (size_t)l * 512 * 128, kb * 64, nb * 32, nb * 32, false, scr, lane); }
    }
}
__device__ __forceinline__ void p0_mod(const CAS Args* A, LAS unsigned char* lds, int tid) {
    const int item = bid_(); if (item >= 192) return;
    LAS float* cs = (LAS float*)lds;
    LAS float* red = (LAS float*)(lds + 81920);
    for (int e = tid; e < NSEQ * 1024; e += 512) { const int s = e >> 10, k = e & 1023; const float c = s == 0 ? A->in[2][k] : A->in[3][(s - 1) * 1024 + k];
        cs[k * 20 + s] = c * sigmoidf_(c); }
    __syncthreads();
    const int l = item / 96, col0 = (item % 96) * 64, kq = tid >> 6, col = tid & 63;
    const float* w = A->in[4] + (size_t)l * 1024 * 6144 + col0 + col;
    float acc[NSEQ];
#pragma unroll
    for (int s = 0; s < NSEQ; ++s) acc[s] = 0.f;
#pragma unroll 4
    for (int k = kq * 128; k < kq * 128 + 128; ++k) { const float wv = w[(size_t)k * 6144];
        const LAS f32x4* c4 = (const LAS f32x4*)(cs + k * 20);
        const f32x4 c0 = c4[0], c1 = c4[1], c2 = c4[2], c3 = c4[3]; const float c16 = cs[k * 20 + 16];
#pragma unroll
        for (int i = 0; i < 4; ++i) { acc[i] += wv * c0[i]; acc[4 + i] += wv * c1[i]; acc[8 + i] += wv * c2[i]; acc[12 + i] += wv * c3[i]; }
        acc[16] += wv * c16; }
#pragma unroll
    for (int s = 0; s < NSEQ; ++s) red[(kq * NSEQ + s) * 64 + col] = acc[s];
    __syncthreads();
    float* mod = (float*)(A->ws + WS_MOD);
    for (int e = tid; e < NSEQ * 64; e += 512) { const int s = e >> 6, c = e & 63; float v = A->in[5][l * 6144 + col0 + c];
#pragma unroll
        for (int q = 0; q < 8; ++q) v += red[(q * NSEQ + s) * 64 + c];
        mod[(size_t)(s * 2 + l) * 6144 + col0 + c] = v; }
    __syncthreads();
}
__device__ __forceinline__ int seq_of(int m) { return m < MP ? 0 : 1 + ((m - MP) >> 12); }
__device__ __forceinline__ void norm_phase(const float* xp, const float* xs, const float* g, const float* modl  , bf16* XN, int wave, int lane, int G) {
    const int gw = bid_() * NWAVES + wave, NGW = G * NWAVES;
    f32x4 gv[4];
#pragma unroll
    for (int j = 0; j < 4; ++j) gv[j] = ((const f32x4*)g)[64 * j + lane];
    for (int m = gw; m < MT; m += NGW) {
        const float* xrow = m < MP ? xp + (size_t)m * D : xs + (size_t)(m - MP) * D;
        const f32x4* xr = (const f32x4*)xrow + lane;
        f32x4 v[4]; float s = 0.f;
#pragma unroll
        for (int j = 0; j < 4; ++j) { v[j] = xr[64 * j]; s += (v[j].x * v[j].x + v[j].y * v[j].y) + (v[j].z * v[j].z + v[j].w * v[j].w); }
        const float rstd = 1.0f / sqrtf(wave_sum(s, lane) * (1.f / D) + NORM_EPS);
        const float* mp = modl + (size_t)seq_of(m) * 12288;
        unsigned long long* o8 = (unsigned long long*)(XN + (size_t)m * D) + lane;
#pragma unroll
        for (int j = 0; j < 4; ++j) { const f32x4 sh = ((const f32x4*)mp)[64 * j + lane], sc = ((const f32x4*)(mp + 1024))[64 * j + lane];
            const f32x4 y = v[j] * rstd * gv[j] * (1.0f + sc) + sh;
            o8[64 * j] = (unsigned long long)pk2(y.x, y.y) | ((unsigned long long)pk2(y.z, y.w) << 32); }
    }
}
__device__ __forceinline__ void qk_prep_phase(bf16* mix, bf16* kv, const float* qg, const float* kg, int wave, int lane, int G) {
    const int gw = bid_() * NWAVES + wave, NGW = G * NWAVES;
    const int hsel = lane >> 5, li = lane & 31, half = li >> 4, i = li & 15, d1 = half * 32 + i, d2 = d1 + 16;
    const float freq = __builtin_amdgcn_exp2f(-(float)i * (13.287712379549449f / 16.0f));
    const float q1 = qg[d1], q2 = qg[d2], k1 = kg[d1], k2 = kg[d2];
    for (int m = gw; m < MT; m += NGW) {
        const int t = m < MP ? m : (m - MP) & (TSAMP - 1);
        const float pos = (float)(half ? (t & 63) : (t >> 6));
        float sn, cn; sincosf(pos * freq, &sn, &cn);
#pragma unroll
        for (int it = 0; it < 5; ++it) {
            const int hh = it * 2 + hsel;
            bf16* p = hh < 8 ? mix + (size_t)m * 1024 + 512 + hh * 64 : kv + (size_t)m * KVP + (hh - 8) * 64;
            const float x1 = bflo(p[d1]), x2 = bflo(p[d2]);
            float ss = x1 * x1 + x2 * x2;
#pragma unroll
            for (int o = 1; o < 32; o <<= 1) ss += shx(ss, o, lane);
            const float rstd = 1.0f / sqrtf(ss * (1.f / 64.f) + QK_EPS);
            const float y1 = x1 * rstd * (hh < 8 ? q1 : k1), y2 = x2 * rstd * (hh < 8 ? q2 : k2);
            float o1 = y1 * cn - y2 * sn, o2 = y2 * cn + y1 * sn;
            if (hh < 8) { o1 *= attn_body::C2; o2 *= attn_body::C2; }
            p[d1] = (bf16)f2bf(o1); p[d2] = (bf16)f2bf(o2);
        }
    }
}
struct ScanP { const bf16* proj; const float* conv_w; const float* w0; const float* a0; const float* k_k; const float* k_a; const float* r_k; const bf16* upw; const bf16* upa; };
__device__ __forceinline__ f32x4 conv4(const bf16* proj, const float* cw, int m, int col, bool hp, bool hn) {
    const bf16* p = proj + (size_t)m * PRP + col;
    const f32x4 c0 = *(const f32x4*)(cw + col), c1 = *(const f32x4*)(cw + 1536 + col), c2 = *(const f32x4*)(cw + 3072 + col);
    f32x4 r = c1 * ld4bf(p);
    if (hp) r += c0 * ld4bf(p - PRP);
    if (hn) r += c2 * ld4bf(p + PRP);
    return r;
}
template <int MODE>
__device__ __forceinline__ void scan_prologue(const ScanP& P, int m0, int seqbase, int T, int h, int d, float* slab, LAS float* lw, float* bon, int lane) {
    const int fr = lane & 15, fq = lane >> 4, m = m0 + fr, pos = m - seqbase; const bool hp = pos > 0, hn = pos < T - 1;
    float* srow = slab + fr * 384;
    f32x4 k4[4], kk4[4], r4[4]; float ss = 0.f;
    v2u pk_[4][3], pv_[4][3], pr_[4][3];
    const v2u zz = (v2u){0u, 0u};
#pragma unroll
    for (int n = 0; n < 4; ++n) { const bf16* p = P.proj + (size_t)m * PRP + h * 64 + 16 * n + 4 * fq;
        pk_[n][1] = *(const v2u*)(p + 512); pk_[n][0] = zz; pk_[n][2] = zz;
        if (hp) pk_[n][0] = *(const v2u*)(p + 512 - PRP);
        if (hn) pk_[n][2] = *(const v2u*)(p + 512 + PRP);
        if (MODE != 1) { pv_[n][1] = *(const v2u*)(p + 1024); pv_[n][0] = zz; pv_[n][2] = zz;
            if (hp) pv_[n][0] = *(const v2u*)(p + 1024 - PRP);
            if (hn) pv_[n][2] = *(const v2u*)(p + 1024 + PRP); }
        if (MODE == 2) { pr_[n][1] = *(const v2u*)(p); pr_[n][0] = zz; pr_[n][2] = zz;
            if (hp) pr_[n][0] = *(const v2u*)(p - PRP);
            if (hn) pr_[n][2] = *(const v2u*)(p + PRP); } }
    v4u xw_[2]; bf16x8 xa_[2];
#pragma unroll
    for (int ks = 0; ks < 2; ++ks) { xw_[ks] = *(const v4u*)(P.proj + (size_t)m * PRP + 1536 + d * 64 + ks * 32 + 8 * fq); xa_[ks] = *(const bf16x8*)(P.proj + (size_t)m * PRP + 1664 + d * 64 + ks * 32 + 8 * fq); }
    asm volatile("" ::: "memory");
#define CONV3_(arr, which) ({ const float* cw_ = P.conv_w + (which) * 512 + col; const f32x4 c0 = *(const f32x4*)cw_, c1 = *(const f32x4*)(cw_ + 1536), c2 = *(const f32x4*)(cw_ + 3072); \
        const v2u u0 = arr[n][0], u1 = arr[n][1], u2 = arr[n][2]; \
        c0 * (f32x4){bflo(u0.x), bfhi(u0.x), bflo(u0.y), bfhi(u0.y)} + c1 * (f32x4){bflo(u1.x), bfhi(u1.x), bflo(u1.y), bfhi(u1.y)} + c2 * (f32x4){bflo(u2.x), bfhi(u2.x), bflo(u2.y), bfhi(u2.y)}; })
#pragma unroll
    for (int n = 0; n < 4; ++n) { const int c = 16 * n + 4 * fq, col = h * 64 + c;
        k4[n] = CONV3_(pk_, 1);
        if (MODE != 1) { const f32x4 v4 = CONV3_(pv_, 2); *(f32x4*)(srow + 320 + c) = v4; LAS float* xsel = (fr == (d ? 15 : 0)) ? lw + 2048 + c : lw + 2304 + lane * 4; *(LAS f32x4*)(xsel + 192) = v4; }
        if (MODE == 2) { r4[n] = CONV3_(pr_, 0); *(LAS f32x4*)(lw + 1024 + fr * 64 + c) = r4[n]; }
        kk4[n] = k4[n] * *(const f32x4*)(P.k_k + col);
        ss += (kk4[n].x * kk4[n].x + kk4[n].y * kk4[n].y) + (kk4[n].z * kk4[n].z + kk4[n].w * kk4[n].w); }
#undef CONV3_
    ss += shx(ss, 16, lane); ss += shx(ss, 32, lane);
    const float rs = 1.0f / sqrtf(ss + 1e-12f);
    f32x4 Dw[4], Da[4];
#pragma unroll
    for (int n = 0; n < 4; ++n) { Dw[n] = (f32x4){0.f, 0.f, 0.f, 0.f}; Da[n] = (f32x4){0.f, 0.f, 0.f, 0.f}; }
#pragma unroll
    for (int ks = 0; ks < 2; ++ks) {
        const v4u xw = xw_[ks]; const bf16x8 xa = xa_[ks];
        v4u tw;
#pragma unroll
        for (int e = 0; e < 4; ++e) tw[e] = pk2(tanhf_(bflo(xw[e])), tanhf_(bfhi(xw[e])));
        const bf16x8 twv = __builtin_bit_cast(bf16x8, tw);
#pragma unroll
        for (int n = 0; n < 4; ++n) { const size_t wo = (size_t)(h * 64 + 16 * n + fr) * 64 + ks * 32 + 8 * fq;
            Dw[n] = __builtin_amdgcn_mfma_f32_16x16x32_bf16(*(const bf16x8*)(P.upw + wo), twv, Dw[n], 0, 0, 0);
            Da[n] = __builtin_amdgcn_mfma_f32_16x16x32_bf16(*(const bf16x8*)(P.upa + wo), xa, Da[n], 0, 0, 0); }
    }
    float bp = 0.f;
#pragma unroll
    for (int n = 0; n < 4; ++n) { const int c = 16 * n + 4 * fq, col = h * 64 + c;
        const f32x4 w0 = *(const f32x4*)(P.w0 + col), a0 = *(const f32x4*)(P.a0 + col), ka = *(const f32x4*)(P.k_a + col);
        f32x4 wv, bv, kd, av;
#pragma unroll
        for (int i = 0; i < 4; ++i) { const float ic = sigmoidf_(Da[n][i] + a0[i]);
            wv[i] = __builtin_amdgcn_exp2f(-DECAY_SCALE * 1.4426950408889634f * sigmoidf_(Dw[n][i] + w0[i]));
            const float kk = kk4[n][i] * rs; av[i] = -kk; bv[i] = kk * ic; kd[i] = k4[n][i] * (1.0f + (ic - 1.0f) * ka[i]); }
        *(LAS f32x4*)(lw + fr * 64 + c) = av; *(LAS f32x4*)(lw + 3072 + fr * 64 + c) = wv; *(LAS f32x4*)(lw + (MODE == 3 ? 1024 : 4096) + fr * 64 + c) = bv;
        if (MODE != 1) *(f32x4*)(srow + 192 + c) = kd;
        { LAS float* xsel = (fr == (d ? 15 : 0)) ? lw + 2048 + c : lw + 2304 + lane * 4;
          *(LAS f32x4*)(xsel) = wv; if (MODE != 3) *(LAS f32x4*)(xsel + 64) = bv; if (MODE != 1) *(LAS f32x4*)(xsel + 128) = kd; }
        if (MODE == 2) { const f32x4 rk = *(const f32x4*)(P.r_k + col); const f32x4 t = r4[n] * kd * rk; bp += (t.x + t.y) + (t.z + t.w); }
        asm volatile("" ::: "memory");
    }
    if (MODE == 2) { bp += shx(bp, 16, lane); bp += shx(bp, 32, lane); if (fq == 0) bon[(size_t)m * 8 + h] = 0.5f * bp; }
}
template <int MODE>
__device__ __forceinline__ void scan_item(const CAS Args* A, int l, int item, float* slab0, LAS float* ldsw, int lane) {
    unsigned char* ws = A->ws;
    const bool isP = item < 2048; const int it2 = isP ? item : item - 2048;
    const int d = it2 & 1, h = (it2 >> 1) & 7, chunk = it2 >> 4, m0c = isP ? chunk * 128 : MP + chunk * 256, nsub = isP ? 8 : 16;
    const int seqbase = isP ? 0 : MP + (chunk >> 4) * TSAMP, T = isP ? MP : TSAMP;
    ScanP P; P.proj = (const bf16*)(ws + WS_PROJ); P.conv_w = A->in[9] + (size_t)l * 3 * 1536; P.w0 = A->in[10] + (size_t)(l * 2 + d) * 512; P.a0 = A->in[12] + (size_t)(l * 2 + d) * 512;
    P.k_k = A->in[15] + l * 512; P.k_a = A->in[16] + l * 512; P.r_k = A->in[17] + l * 512;
    P.upw = (const bf16*)(ws + WS_WSM) + (size_t)(l * 2 + d) * 512 * 64; P.upa = (const bf16*)(ws + WS_WSM) + 131072 + (size_t)(l * 2 + d) * 512 * 64;
    float* bon = (float*)(ws + WS_BON) + (size_t)d * MT * 8;
    bf16* yb = (bf16*)(ws + WS_XN) + (size_t)d * MT * 512;
    f2 S[32], Pm[32];
    if (MODE == 3) {
#pragma unroll
        for (int i = 0; i < 32; ++i) Pm[i] = (f2){lane == 2 * i ? 1.f : 0.f, lane == 2 * i + 1 ? 1.f : 0.f}; }
    if (MODE == 2) { const f32x4* q = (const f32x4*)((const float*)(ws + WS_QS) + ((size_t)item * 64 + lane) * 64);
#pragma unroll
        for (int i = 0; i < 16; ++i) { const f32x4 v = q[i]; S[2 * i] = (f2){v.x, v.y}; S[2 * i + 1] = (f2){v.z, v.w}; } }
    else {
#pragma unroll
        for (int i = 0; i < 32; ++i) S[i] = MODE == 1 ? (f2){lane == 2 * i ? 1.f : 0.f, lane == 2 * i + 1 ? 1.f : 0.f} : (f2){0.f, 0.f}; }
#pragma nounroll
    for (int sc = 0; sc < nsub; ++sc) {
        const int sub = d ? nsub - 1 - sc : sc, t0 = m0c + sub * 16;
        float* slab = slab0;
        { int lane_l = lane; asm volatile("" : "+v"(lane_l)); scan_prologue<MODE>(P, t0, seqbase, T, h, d, slab, ldsw, bon, lane_l);
#ifdef DUP_PRO
          asm volatile("" : "+v"(lane_l)); scan_prologue<MODE>(P, t0, seqbase, T, h, d, slab, ldsw, bon, lane_l);
#endif
        }
        asm volatile("" ::: "memory");
#define RL2(x, j) (f2){__builtin_bit_cast(float, __builtin_amdgcn_readlane(__builtin_bit_cast(int, x), 2 * (j))), __builtin_bit_cast(float, __builtin_amdgcn_readlane(__builtin_bit_cast(int, x), 2 * (j) + 1))}
        const GAS float* sl = (const GAS float*)slab + lane;
        LDS_WAIT();
        float nw[1], nb[1], nk[1], nv[1];
        { const LAS float* xl = ldsw + 2048 + lane; nw[0] = 0.f; nb[0] = 0.f; nk[0] = 0.f; nv[0] = 0.f; if (MODE != 1) { nk[0] = xl[128]; nv[0] = xl[192]; } }
#pragma nounroll
        for (int st = 0; st < 16; ++st) {
            const int s = d ? 15 - st : st;
            const float cw = nw[0], cb = nb[0], ck = nk[0], vv = nv[0];
            if (st < 15) { const GAS float* p = sl + (d ? s - 1 : s + 1) * 384;  if (MODE != 1) { nk[0] = p[192]; nv[0] = p[320]; } }
            const LAS f32x4* ua = (const LAS f32x4*)(ldsw + s * 64); const LAS f32x4* ur = (const LAS f32x4*)(ldsw + 1024 + s * 64); const LAS f32x4* uw = (const LAS f32x4*)(ldsw + 3072 + s * 64); const LAS f32x4* ub = (const LAS f32x4*)(ldsw + (MODE == 3 ? 1024 : 4096) + s * 64);
            f2 sa2 = (f2){0.f, 0.f}, sb2 = (f2){0.f, 0.f}, pa2 = (f2){0.f, 0.f}, pb2 = (f2){0.f, 0.f};
#pragma unroll
            for (int j = 0; j < 16; ++j) { const f32x4 aq = ua[j]; const f2 a0 = (f2){aq.x, aq.y}, a1 = (f2){aq.z, aq.w}; sa2 = S[2 * j] * a0 + sa2; sb2 = S[2 * j + 1] * a1 + sb2;
                if (MODE == 3) { pa2 = Pm[2 * j] * a0 + pa2; pb2 = Pm[2 * j + 1] * a1 + pb2; } }
            const float sa = (sa2.x + sa2.y) + (sb2.x + sb2.y), pa = (pa2.x + pa2.y) + (pb2.x + pb2.y); const f2 pas = (f2){pa, pa};
            const f2 sas = (f2){sa, sa}, vvs = (f2){vv, vv};
            f2 y2 = (f2){0.f, 0.f}, y3 = (f2){0.f, 0.f};
#pragma unroll
            for (int g = 0; g < 8; ++g) {
                f2 bb[4], ww[4], kq[4];
#pragma unroll
                for (int q = 0; q < 4; ++q) { const int j = g * 4 + q; { const f32x4 wq = uw[j >> 1]; ww[q] = (j & 1) ? (f2){wq.z, wq.w} : (f2){wq.x, wq.y}; } if (MODE != 1) kq[q] = RL2(ck, j);
                    { const f32x4 bq = ub[j >> 1]; bb[q] = (j & 1) ? (f2){bq.z, bq.w} : (f2){bq.x, bq.y}; } }
                __builtin_amdgcn_sched_barrier(0);
#pragma unroll
                for (int q = 0; q < 4; ++q) { const int j = g * 4 + q;
                    f2 t = sas * bb[q];
                    if (MODE != 1) t = vvs * kq[q] + t;
                    S[j] = S[j] * ww[q] + t;
                    if (MODE == 3) Pm[j] = Pm[j] * ww[q] + pas * bb[q];
                    if (MODE == 2) { const f32x4 rq = ur[j >> 1]; if (j & 1) y3 = S[j] * (f2){rq.z, rq.w} + y3; else y2 = S[j] * (f2){rq.x, rq.y} + y2; } }
                __builtin_amdgcn_sched_barrier(0);
            }
            if (MODE == 2) yb[(size_t)(t0 + s) * 512 + h * 64 + lane] = (bf16)f2bf((y2.x + y2.y) + (y3.x + y3.y));
        }
#undef RL2
    }
    if (MODE != 2) { f32x4* q = (f32x4*)((float*)(ws + (MODE == 1 ? WS_P : WS_QS)) + ((size_t)item * 64 + lane) * 64);
#pragma unroll
        for (int i = 0; i < 16; ++i) q[i] = (f32x4){S[2 * i].x, S[2 * i].y, S[2 * i + 1].x, S[2 * i + 1].y}; }
    if (MODE == 3) { f32x4* q = (f32x4*)((float*)(ws + WS_P) + ((size_t)item * 64 + lane) * 64);
#pragma unroll
        for (int i = 0; i < 16; ++i) q[i] = (f32x4){Pm[2 * i].x, Pm[2 * i].y, Pm[2 * i + 1].x, Pm[2 * i + 1].y}; }
}
template <bool PASS_C>
__device__ __forceinline__ void scan_phase(const CAS Args* A, LAS unsigned char* lds, int l, int wave, int lane, int G) {
    const int gw = bid_() * NWAVES + wave, NGW = G * NWAVES;
    float* slab0 = (float*)(A->ws + WS_SLAB) + (size_t)gw * 6144;
    LAS float* ldsw = (LAS float*)(lds + wave * 20480);
    if (PASS_C) { for (int item = gw; item < NITEM_SCAN; item += NGW) scan_item<2>(A, l, item, slab0, ldsw, lane); }
    else { for (int item = gw; item < NITEM_SCAN; item += NGW) { int ll = lane; asm volatile("" : "+v"(ll)); scan_item<3>(A, l, item, slab0, ldsw, ll); } }
}
#ifdef EXP_SLOAD
typedef const CAS f2* cf2p_;
__device__ __forceinline__ void probe_sload(const CAS Args* A, int wave, int lane, int G) {
    const int gw = bid_() * NWAVES + wave;
    float* pslab = (float*)(A->ws + WS_SLAB) + (size_t)gw * 12288;
    f2 acc = (f2){0.f, 0.f}, acc2 = (f2){0.f, 0.f};
#pragma nounroll
    for (int rep = 0; rep < EXP_SLOAD; ++rep) {
        float* ps = pslab + (rep & 1) * 6144;
#pragma unroll 4
        for (int i = 0; i < 96; ++i) ps[i * 64 + lane] = (float)(i + rep) * 0.001f;
        unsigned long long sp = (unsigned long long)(uintptr_t)ps;
        sp = __builtin_amdgcn_readfirstlane((unsigned)sp) | ((unsigned long long)__builtin_amdgcn_readfirstlane((unsigned)(sp >> 32)) << 32);
        asm volatile("s_waitcnt vmcnt(0) lgkmcnt(0)" : "+s"(sp) : : "memory");
        cf2p_ u = (cf2p_)sp;
#pragma nounroll
        for (int i = 0; i < 3072; i += 32) {
#pragma unroll
            for (int j = 0; j < 32; j += 2) { acc = acc * u[i + j] + acc; acc2 = acc2 * u[i + j + 1] + acc2; }
        }
    }
    if (acc.x + acc2.y == 12345.678f) pslab[lane] = acc.y + acc2.x;
}
#endif
__device__ __forceinline__ void scanB_phase(const CAS Args* A, LAS unsigned char* lds, int wave, int lane, int G) {
    unsigned char* ws = A->ws;
    LAS float* ex = (LAS float*)lds;
    LAS float* pl = (LAS float*)(lds + 32768);
    const int tid = wave * 64 + lane;
    for (int chain = bid_(); chain < NSEQ * 16; chain += G) {
        const int d = chain & 1, h = (chain >> 1) & 7, seq = chain >> 4;
        const int nc = seq == 0 ? 128 : 16, ibase = seq == 0 ? 0 : 2048 + (seq - 1) * 256;
        f2 S[32]; f2 cur[4];
#pragma unroll
        for (int i = 0; i < 32; ++i) S[i] = (f2){0.f, 0.f};
#pragma unroll
        for (int i = 0; i < 4; ++i) cur[i] = (f2){0.f, 0.f};
        { const int c0 = d ? nc - 1 : 0; const size_t it0 = (size_t)ibase + (size_t)(c0 * 8 + h) * 2 + d;
          const f32x4* ps = (const f32x4*)((const float*)(ws + WS_P) + it0 * 4096); ((LAS f32x4*)pl)[tid] = ps[tid]; ((LAS f32x4*)pl)[tid + 512] = ps[tid + 512]; }
        __syncthreads();
        for (int ci = 0; ci < nc; ++ci) {
            const int c = d ? nc - 1 - ci : ci; const size_t item = (size_t)ibase + (size_t)(c * 8 + h) * 2 + d;
            LAS float* pc = pl + (ci & 1) * 4096; LAS float* pn = pl + ((ci + 1) & 1) * 4096;
            f32x4 pf0 = (f32x4){0.f, 0.f, 0.f, 0.f}, pf1 = pf0;
            if (ci + 1 < nc) { const int cn = d ? nc - 2 - ci : ci + 1; const size_t itn = (size_t)ibase + (size_t)(cn * 8 + h) * 2 + d;
                const f32x4* ps = (const f32x4*)((const float*)(ws + WS_P) + itn * 4096); pf0 = ps[tid]; pf1 = ps[tid + 512]; }
            float* qrow = (float*)(ws + WS_QS) + (item * 64 + lane) * 64 + wave * 8;
            const f32x4 q0 = *(const f32x4*)qrow, q1 = *(const f32x4*)(qrow + 4);
            *(f32x4*)qrow = (f32x4){cur[0].x, cur[0].y, cur[1].x, cur[1].y}; *(f32x4*)(qrow + 4) = (f32x4){cur[2].x, cur[2].y, cur[3].x, cur[3].y};
            f2 n0 = (f2){0.f, 0.f}, n1 = n0, n2 = n0, n3 = n0;
#pragma unroll
            for (int kp = 0; kp < 32; ++kp) {
                const f2 sx = (f2){S[kp].x, S[kp].x}, sy = (f2){S[kp].y, S[kp].y};
                const LAS f32x4* r0 = (const LAS f32x4*)(pc + (2 * kp) * 64 + wave * 8); const LAS f32x4* r1 = (const LAS f32x4*)(pc + (2 * kp + 1) * 64 + wave * 8);
                const f32x4 a0 = r0[0], a1 = r0[1], b0 = r1[0], b1 = r1[1];
                n0 = sx * (f2){a0.x, a0.y} + n0; n1 = sx * (f2){a0.z, a0.w} + n1; n2 = sx * (f2){a1.x, a1.y} + n2; n3 = sx * (f2){a1.z, a1.w} + n3;
                n0 = sy * (f2){b0.x, b0.y} + n0; n1 = sy * (f2){b0.z, b0.w} + n1; n2 = sy * (f2){b1.x, b1.y} + n2; n3 = sy * (f2){b1.z, b1.w} + n3; }
            n0 += (f2){q0.x, q0.y}; n1 += (f2){q0.z, q0.w}; n2 += (f2){q1.x, q1.y}; n3 += (f2){q1.z, q1.w};
            cur[0] = n0; cur[1] = n1; cur[2] = n2; cur[3] = n3;
            LAS float* er = ex + lane * 68 + wave * 8;
            *(LAS f32x4*)er = (f32x4){n0.x, n0.y, n1.x, n1.y}; *(LAS f32x4*)(er + 4) = (f32x4){n2.x, n2.y, n3.x, n3.y};
            ((LAS f32x4*)pn)[tid] = pf0; ((LAS f32x4*)pn)[tid + 512] = pf1;
            __syncthreads();
#pragma unroll
            for (int i = 0; i < 16; ++i) { const f32x4 v = *(const LAS f32x4*)(ex + lane * 68 + 4 * i); S[2 * i] = (f2){v.x, v.y}; S[2 * i + 1] = (f2){v.z, v.w}; }
            __syncthreads();
        }
    }
}
__device__ __forceinline__ void post_phase(const CAS Args* A, int l, int wave, int lane, int G) {
    unsigned char* ws = A->ws;
    const int gw = bid_() * NWAVES + wave, NGW = G * NWAVES;
    const bf16* proj = (const bf16*)(ws + WS_PROJ); const float* cw = A->in[9] + (size_t)l * 3 * 1536;
    const bf16* y0 = (const bf16*)(ws + WS_XN); const bf16* y1 = y0 + (size_t)MT * 512;
    const float* b0 = (const float*)(ws + WS_BON); const float* b1 = b0 + (size_t)MT * 8;
    const bf16* gt = (const bf16*)(ws + WS_WSM) + 262144 + (size_t)l * 512 * 128;
    const float* lng = A->in[18] + l * 512; const float* lnb = A->in[19] + l * 512;
    bf16* mix = (bf16*)(ws + WS_MIX);
    const int h = gw & 7;
    bf16x8 gfrag[4][4];
    { const int fr0 = lane & 15, fq0 = lane >> 4;
#pragma unroll
      for (int ks = 0; ks < 4; ++ks)
#pragma unroll
        for (int n = 0; n < 4; ++n) gfrag[n][ks] = *(const bf16x8*)(gt + (size_t)(h * 64 + 16 * n + fr0) * 128 + ks * 32 + 8 * fq0);
    }
    f32x4 cwv[4][3], lg4[4], lb4[4];
    { const int fq0 = lane >> 4;
#pragma unroll
      for (int n = 0; n < 4; ++n) { const int col = h * 64 + 16 * n + 4 * fq0;
          cwv[n][0] = *(const f32x4*)(cw + 1024 + col); cwv[n][1] = *(const f32x4*)(cw + 1536 + 1024 + col); cwv[n][2] = *(const f32x4*)(cw + 3072 + 1024 + col);
          lg4[n] = *(const f32x4*)(lng + col); lb4[n] = *(const f32x4*)(lnb + col); } }
    for (int item = gw; item < (MT / 16) * 8; item += NGW) {
        int lane_l = lane; asm volatile("" : "+v"(lane_l)); const int fr = lane_l & 15, fq = lane_l >> 4;
        const int m = (item >> 3) * 16 + fr;
        const int seqbase = m < MP ? 0 : MP + ((m - MP) >> 12) * TSAMP, T = m < MP ? MP : TSAMP, pos = m - seqbase; const bool hp = pos > 0, hn = pos < T - 1;
        f32x4 y4[4]; float s = 0.f;
#pragma unroll
        for (int n = 0; n < 4; ++n) { const size_t o = (size_t)m * 512 + h * 64 + 16 * n + 4 * fq; y4[n] = ld4bf(y0 + o) + ld4bf(y1 + o); s += (y4[n].x + y4[n].y) + (y4[n].z + y4[n].w); }
        s += shx(s, 16, lane); s += shx(s, 32, lane);
        const float mu = s * (1.f / 64.f); float q = 0.f;
#pragma unroll
        for (int n = 0; n < 4; ++n) { y4[n] = y4[n] - mu; q += (y4[n].x * y4[n].x + y4[n].y * y4[n].y) + (y4[n].z * y4[n].z + y4[n].w * y4[n].w); }
        q += shx(q, 16, lane); q += shx(q, 32, lane);
        const float rstd = 1.0f / sqrtf(q * (1.f / 64.f) + GN_EPS);
        const float bon = b0[(size_t)m * 8 + h] + b1[(size_t)m * 8 + h];
        f32x4 Dg[4];
#pragma unroll
        for (int n = 0; n < 4; ++n) Dg[n] = (f32x4){0.f, 0.f, 0.f, 0.f};
#pragma unroll
        for (int ks = 0; ks < 4; ++ks) {
            const v4u xg = *(const v4u*)(proj + (size_t)m * PRP + 1792 + ks * 32 + 8 * fq); v4u sg;
#pragma unroll
            for (int e = 0; e < 4; ++e) sg[e] = pk2(sigmoidf_(bflo(xg[e])), sigmoidf_(bfhi(xg[e])));
            const bf16x8 sgv = __builtin_bit_cast(bf16x8, sg);
#pragma unroll
            for (int n = 0; n < 4; ++n) Dg[n] = __builtin_amdgcn_mfma_f32_16x16x32_bf16(gfrag[n][ks], sgv, Dg[n], 0, 0, 0);
        }
#pragma unroll
        for (int n = 0; n < 4; ++n) { const int col = h * 64 + 16 * n + 4 * fq;
            const bf16* pv = proj + (size_t)m * PRP + 1024 + col;
            f32x4 v4 = cwv[n][1] * ld4bf(pv);
            if (hp) v4 += cwv[n][0] * ld4bf(pv - PRP);
            if (hn) v4 += cwv[n][2] * ld4bf(pv + PRP);
            const f32x4 o = ((y4[n] * rstd) * lg4[n] + lb4[n] + bon * v4) * Dg[n];
            v2u w; w.x = pk2(o.x, o.y); w.y = pk2(o.z, o.w);
            *(v2u*)(mix + (size_t)m * 1024 + col) = w; }
    }
}
__device__ __forceinline__ void attn_phase(const CAS Args* A, char* lds, int G, int tid) {
    using attn_body::bf16;
    bf16* Q = (bf16*)(A->ws + WS_MIX) + 512; const bf16* K = (const bf16*)(A->ws + WS_KV); const bf16* V = K + 128;
#ifdef DUP_ATTNP
    for (int u = blockIdx.x; u < 512; u += G) { const int h = u & 7, qb = u >> 3;
        attn_body::attn_unit<8>(0, MP, h, qb, Q, K, V, (bf16*)(A->ws + 976 * MiB), lds, tid); }
#endif
    for (int u = blockIdx.x; u < 512; u += G) { const int h = u & 7, qb = u >> 3;
        attn_body::attn_unit<8>(0, MP, h, qb, Q, K, V, Q, lds, tid); }
    for (int u = blockIdx.x; u < 2048; u += G) { const int h = u & 7, qb = (u >> 3) & 15, sq = u >> 7;
        attn_body::attn_unit<8>((long)MP + (long)sq * TSAMP, TSAMP, h, qb, Q, K, V, Q, lds, tid); }
}

#define XB_TMO      128
#define XB_XCNT(j)  (256  + 64 * (j))
#define XB_XSUB(j)  (1280 + 64 * (j))
#define XB_XGEN(j)  (2304 + 64 * (j))
#define XB_TOP      3328
#define XB_TOPGEN   3392
#define XCD_BAR_WORDS 3456
#define XB_SPIN_CAP (1u << 18)

__device__ __forceinline__ unsigned xb_ld(unsigned* p)              { return __hip_atomic_load(p, __ATOMIC_RELAXED, __HIP_MEMORY_SCOPE_AGENT); }
__device__ __forceinline__ unsigned xb_add(unsigned* p, unsigned v) { return __hip_atomic_fetch_add(p, v, __ATOMIC_RELAXED, __HIP_MEMORY_SCOPE_AGENT); }
__device__ __forceinline__ unsigned xb_xcc_id() { return (unsigned)__builtin_amdgcn_s_getreg((3 << 11) | 20) & 0xFu; }
#define XB_SPIN(cond, bar) do { unsigned _sp = 0; while (cond) { __builtin_amdgcn_s_sleep(1); \
    if ((++_sp & 255u) == 0u) { if (xb_ld(&(bar)[XB_TMO])) break; if (_sp > XB_SPIN_CAP) { atomicAdd(&(bar)[XB_TMO], 1u); break; } } } } while (0)

struct XcdBarrier {
    unsigned* bar; unsigned x;
    volatile LAS unsigned* st;
};

__device__ __forceinline__ XcdBarrier xcd_barrier_post(unsigned* bar, volatile LAS unsigned* st, bool leader) {
    XcdBarrier b; b.bar = bar; b.x = xb_xcc_id(); b.st = st;
    if (leader) (void)xb_add(&bar[XB_XCNT(b.x)], 1u);
    return b;
}
__device__ __forceinline__ void xcd_barrier_complete(unsigned* bar, unsigned x, unsigned& nloc, unsigned& nx) {
    const unsigned G = gridDim.x * gridDim.y * gridDim.z;
    unsigned sum, cnt, mine, sp = 0u;
    for (;;) {
        sum = 0u; cnt = 0u; mine = 0u;
#pragma unroll
        for (unsigned j = 0; j < 16; ++j) { const unsigned c = xb_ld(&bar[XB_XCNT(j)]); sum += c; cnt += (c > 0u) ? 1u : 0u; mine = (j == x) ? c : mine; }
        if (sum == G) break;
        __builtin_amdgcn_s_sleep(1);
        if ((++sp & 255u) == 0u) { if (xb_ld(&bar[XB_TMO])) break; if (sp > XB_SPIN_CAP) { atomicAdd(&bar[XB_TMO], 1u); break; } }
    }
    nloc = mine > 0u ? mine : 1u; nx = cnt > 0u ? cnt : 1u;
}

__device__ __forceinline__ void xcd_barrier(const XcdBarrier& b, bool leader) {
    asm volatile("s_waitcnt vmcnt(0)" ::: "memory");
    __syncthreads();
    if (leader) {
        unsigned* bar = b.bar;
        __builtin_amdgcn_s_waitcnt(0);
        unsigned nloc = b.st[0], nx = b.st[1];
        if (nloc == 0u) { xcd_barrier_complete(bar, b.x, nloc, nx); b.st[0] = nloc; b.st[1] = nx; }
        const unsigned old = xb_add(&bar[XB_XSUB(b.x)], 1u);
        const unsigned gen = old / nloc;
        if (old + 1u == (gen + 1u) * nloc) {
            __builtin_amdgcn_fence(__ATOMIC_RELEASE, "agent");
            asm volatile("s_waitcnt vmcnt(0)" ::: "memory");
            const unsigned og = xb_add(&bar[XB_TOP], 1u);
            const unsigned tg = og / nx;
            if (og + 1u == (tg + 1u) * nx) xb_add(&bar[XB_TOPGEN], 1u);
            else XB_SPIN(xb_ld(&bar[XB_TOPGEN]) == tg, bar);
            __builtin_amdgcn_fence(__ATOMIC_ACQUIRE, "agent");
            xb_add(&bar[XB_XGEN(b.x)], 1u);
            asm volatile("s_waitcnt vmcnt(0)" ::: "memory");
        } else {
            XB_SPIN(xb_ld(&bar[XB_XGEN(b.x)]) == gen, bar);
            __builtin_amdgcn_fence(__ATOMIC_ACQUIRE, "agent");
            asm volatile("s_waitcnt vmcnt(0)" ::: "memory");
        }
    }
    __syncthreads();
}

__device__ __forceinline__ void attn_phase_dyn(const CAS Args* A, char* lds, unsigned* ctr, int tid, bool leader) {
    using attn_body::bf16;
    bf16* Q = (bf16*)(A->ws + WS_MIX) + 512; const bf16* K = (const bf16*)(A->ws + WS_KV); const bf16* V = K + 128;
    const int h0 = (int)(xb_xcc_id() & 7u);
    volatile LAS unsigned* slot = (volatile LAS unsigned*)((LAS unsigned char*)lds + 154368 + 64);
#pragma nounroll
    for (int qi = 0; qi < 8; ++qi) {
        const int h = (h0 + qi) & 7;
        for (;;) {
            if (leader) *slot = atomicAdd(ctr + h * 64, 1u);
            __syncthreads();
            const int k = (int)__builtin_amdgcn_readfirstlane((int)*slot);
            __syncthreads();
            if (k >= 320) break;
            if (k < 64) attn_body::attn_unit<8>(0, MP, h, k, Q, K, V, Q, lds, tid);
            else { const int ks = k - 64; attn_body::attn_unit<8>((long)MP + (long)(ks >> 4) * TSAMP, TSAMP, h, ks & 15, Q, K, V, Q, lds, tid); }
        }
    }
}
#ifndef STOP_AFTER
#define STOP_AFTER 99
#endif
__device__ __forceinline__ int fresh(int v) { asm volatile("" : "+s"(v)); return v; }
__device__ __forceinline__ int freshv(int v) { asm volatile("" : "+v"(v)); return v; }
__device__ __forceinline__ const CAS Args* get_args() { unsigned long long v = (unsigned long long)(uintptr_t)__builtin_amdgcn_kernarg_segment_ptr(); asm volatile("" : "+s"(v)); return (const CAS Args*)v; }
__global__ void __launch_bounds__(NWAVES * 64, 2) hymba_fwd(Args args_unused) {
    extern __shared__ __attribute__((aligned(16))) unsigned char lds[];
    cg::grid_group grid = cg::this_grid();
    const int wave = __builtin_amdgcn_readfirstlane((int)threadIdx.x >> 6), G = gridDim.x;
#define LANE_() ({ int z_ = 0; asm volatile("" : "+s"(z_)); (int)__builtin_amdgcn_mbcnt_hi(~0u, __builtin_amdgcn_mbcnt_lo(~0u, (unsigned)z_)); })
#define lane LANE_()
#define tid (wave * 64 + LANE_())
    LAS unsigned char* l3 = (LAS unsigned char*)lds;
    volatile LAS unsigned* xmisc = (volatile LAS unsigned*)(l3 + 154368);
    if (wave == 0 && LANE_() == 0) { xmisc[0] = 0u; xmisc[1] = 0u; }
    __syncthreads();
    (void)xcd_barrier_post((unsigned*)(get_args()->ws + WS_CTL), xmisc, wave == 0 && LANE_() == 0);
#ifdef USE_CG_SYNC
#define GSYNC() do { grid.sync(); } while (0)
#else
#define GSYNC() do { XcdBarrier b_; b_.bar = (unsigned*)(get_args()->ws + WS_CTL); b_.x = xb_xcc_id(); b_.st = (volatile LAS unsigned*)((LAS unsigned char*)lds + 154368); xcd_barrier(b_, fresh(wave) == 0 && LANE_() == 0); } while (0)
#endif
#ifdef EXP_READOUT
    { const CAS Args* a = get_args(); if (blockIdx.x == 0 && tid == 0) { const float v = a->out[EXP_READOUT]; if (v == 123.456f) ((float*)(a->ws + WS_MOD))[0] = v; } }
#ifdef EXP_READALL
    { const CAS Args* a = get_args(); float acc = 0.f; for (size_t i = (size_t)blockIdx.x * 512 + tid; i < (size_t)MT * D; i += (size_t)gridDim.x * 512) acc += a->out[i]; if (acc == 123.456f) ((float*)(a->ws + WS_MOD))[1] = acc; }
#endif
#endif
    { const CAS Args* a = get_args(); p0_mod(a, l3, tid); p0_prologue(a, l3, wave, freshv(lane), fresh(G)); }
#ifdef DUP_P0
    __syncthreads(); { const CAS Args* a = get_args(); p0_mod(a, l3, tid); p0_prologue(a, l3, wave, freshv(lane), fresh(G)); }
#endif
    GSYNC(); if (STOP_AFTER == 0) return;
#pragma nounroll
    for (int l0 = 0; l0 < DEPTH; ++l0) {
        int l = l0; asm volatile("" : "+s"(l));
        { const CAS Args* a = get_args(); unsigned char* ws = a->ws; float* out = a->out;
          const float* xp = l == 0 ? a->in[0] : out; const float* xs = l == 0 ? a->in[1] : out + (size_t)MP * D;
          norm_phase(xp, xs, a->in[6] + l * D, (const float*)(ws + WS_MOD) + (size_t)l * 6144, (bf16*)(ws + WS_XN), wave, freshv(lane), fresh(G));
#ifdef DUP_NORM
          norm_phase(xp, xs, a->in[6] + l * D, (const float*)(ws + WS_MOD) + (size_t)l * 6144, (bf16*)(ws + WS_XN), wave, freshv(lane), fresh(G));
#endif
        }
        GSYNC(); if (STOP_AFTER == 1) return;
        { const CAS Args* a = get_args(); unsigned char* ws = a->ws;
          pg8::Gemm g{(const bf16*)(ws + WS_XN), (const bf16*)(ws + WS_WIN) + (size_t)l * NINP * D, MT, NINP, D}; pg8::StaticOrder S; S.init(MT, NINP, fresh(G), fresh((int)blockIdx.x));
          pg8::EpiInProj E{(bf16*)(ws + WS_PROJ), (bf16*)(ws + WS_MIX), (bf16*)(ws + WS_KV)};
          pg8::gemm_phase<pg8::EpiInProj, pg8::StaticOrder, PG8_ALIGN, PG8_SP2>(l3, g, S, E, tid);
#ifdef DUP_GEMM
          __syncthreads(); pg8::gemm_phase<pg8::EpiInProj, pg8::StaticOrder, PG8_ALIGN, PG8_SP2>(l3, g, S, E, tid);
#endif
        }
        GSYNC(); if (STOP_AFTER == 2) return;
        { const CAS Args* a = get_args(); unsigned char* ws = a->ws;
          qk_prep_phase((bf16*)(ws + WS_MIX), (bf16*)(ws + WS_KV), a->in[20] + l * 64, a->in[21] + l * 64, wave, freshv(lane), fresh(G)); }
#ifndef NO_SCANA
        scan_phase<false>(get_args(), l3, l, wave, freshv(lane), fresh(G));
#endif
#ifdef DUP_SCANA
        scan_phase<false>(get_args(), l3, l, wave, freshv(lane), fresh(G));
#endif
        GSYNC(); if (STOP_AFTER == 3) return;
#ifndef NO_SCANB
        scanB_phase(get_args(), l3, wave, freshv(lane), fresh(G));
#endif
        __syncthreads();
        { const CAS Args* a = get_args(); attn_phase_dyn(a, (char*)lds, (unsigned*)(a->ws + WS_CTL) + 4096 + l * 1024, tid, fresh(wave) == 0 && LANE_() == 0); }
        GSYNC(); if (STOP_AFTER == 4) return;

#ifdef EXP_SLOAD
        probe_sload(get_args(), wave, freshv(lane), fresh(G));
#endif
#ifndef NO_SCANC
        scan_phase<true>(get_args(), l3, l, wave, freshv(lane), fresh(G));
#endif
#ifdef DUP_SCANC
        scan_phase<true>(get_args(), l3, l, wave, freshv(lane), fresh(G));
#endif
        GSYNC(); if (STOP_AFTER == 5) return;
#ifndef NO_POST
        post_phase(get_args(), l, wave, freshv(lane), fresh(G));
#endif
#ifdef DUP_POST
        post_phase(get_args(), l, wave, freshv(lane), fresh(G));
#endif
        GSYNC(); if (STOP_AFTER == 6) return;
#ifndef NO_P7
        { const CAS Args* a = get_args(); unsigned char* ws = a->ws; float* out = a->out;
          const float* xp = l == 0 ? a->in[0] : out; const float* xs = l == 0 ? a->in[1] : out + (size_t)MP * D;
          pg8::Gemm g{(const bf16*)(ws + WS_MIX), (const bf16*)(ws + WS_WOUT) + (size_t)l * D * D, MT, D, D}; pg8::StaticOrder S; S.init(MT, D, fresh(G), fresh((int)blockIdx.x));
          pg8::EpiResid E{xp, xs, out, (const float*)(ws + WS_MOD) + (size_t)l * 6144 + 2048};
          pg8::gemm_phase<pg8::EpiResid, pg8::StaticOrder, PG8_ALIGN, PG8_SP2>(l3, g, S, E, tid); }
#endif
        GSYNC(); if (STOP_AFTER == 7) return;
        { const CAS Args* a = get_args(); unsigned char* ws = a->ws; float* out = a->out;
          norm_phase(out, out + (size_t)MP * D, a->in[7] + l * D, (const float*)(ws + WS_MOD) + (size_t)l * 6144 + 3072, (bf16*)(ws + WS_XN), wave, freshv(lane), fresh(G)); }
        GSYNC(); if (STOP_AFTER == 8) return;
        { const CAS Args* a = get_args(); unsigned char* ws = a->ws;
          pg8::Gemm g{(const bf16*)(ws + WS_XN), (const bf16*)(ws + WS_WFFI) + (size_t)l * 2 * DFF * D, MT, 2 * DFF, D}; pg8::StaticOrder S; S.init(MT, 2 * DFF, fresh(G), fresh((int)blockIdx.x));
          pg8::EpiSwiGLU E{(bf16*)(ws + WS_ACT)};
          pg8::gemm_phase<pg8::EpiSwiGLU, pg8::StaticOrder, PG8_ALIGN, PG8_SP2>(l3, g, S, E, tid);
#ifdef DUP_GEMM
          __syncthreads(); pg8::gemm_phase<pg8::EpiSwiGLU, pg8::StaticOrder, PG8_ALIGN, PG8_SP2>(l3, g, S, E, tid);
#endif
        }
        GSYNC(); if (STOP_AFTER == 9) return;
        { const CAS Args* a = get_args(); unsigned char* ws = a->ws; float* out = a->out;
          pg8::Gemm g{(const bf16*)(ws + WS_ACT), (const bf16*)(ws + WS_WFFO) + (size_t)l * D * DFF, MT, D, DFF}; pg8::StaticOrder S; S.init(MT, D, fresh(G), fresh((int)blockIdx.x));
          pg8::EpiResid E{out, out + (size_t)MP * D, out, (const float*)(ws + WS_MOD) + (size_t)l * 6144 + 5120};
          pg8::gemm_phase<pg8::EpiResid, pg8::StaticOrder, PG8_ALIGN, PG8_SP2>(l3, g, S, E, tid); }
        if (l0 + 1 < DEPTH) GSYNC();
    }
}

extern "C" void kernel_launch(void* const* d_in, const int* in_sizes, int n_in, void* d_out, int out_size, void* d_ws, size_t ws_size, hipStream_t stream) {
    static int grid = 0;
    if (grid == 0) {
        if (n_in != 25 || ws_size < WS_END) { fprintf(stderr, "kernel_launch: unexpected n_in %d / ws %zu\n", n_in, ws_size); grid = -1; return; }
        int dev = 0, cus = 0, per_cu = 0;
        hipGetDevice(&dev); hipDeviceGetAttribute(&cus, hipDeviceAttributeMultiprocessorCount, dev);
        if (hipFuncSetAttribute((const void*)hymba_fwd, hipFuncAttributeMaxDynamicSharedMemorySize, LDS_BYTES) != hipSuccess) { fprintf(stderr, "kernel_launch: hipFuncSetAttribute failed\n"); grid = -1; return; }
        if (hipOccupancyMaxActiveBlocksPerMultiprocessor(&per_cu, (const void*)hymba_fwd, NWAVES * 64, LDS_BYTES) != hipSuccess || per_cu < 1) { fprintf(stderr, "kernel_launch: occupancy query says %d\n", per_cu); per_cu = 1; }
        (void)hipGetLastError();
        grid = cus * 1;
    }
    if (grid < 0) return;
    if (hipMemsetAsync((char*)d_ws + WS_CTL, 0, 32768, stream) != hipSuccess) { fprintf(stderr, "kernel_launch: memset failed\n"); return; }
    Args a{};
    for (int i = 0; i < 25; ++i) a.in[i] = (const float*)d_in[i];
    a.out = (float*)d_out; a.ws = (unsigned char*)d_ws;
    void* kargs[] = {&a};
    hipError_t e = hipLaunchCooperativeKernel((const void*)hymba_fwd, dim3(grid), dim3(NWAVES * 64), kargs, LDS_BYTES, stream);
    if (e != hipSuccess) fprintf(stderr, "cooperative launch failed: %s (grid %d)\n", hipGetErrorString(e), grid);
}
```

```cpp
#include <hip/hip_runtime.h>
#include <hip/hip_cooperative_groups.h>
#include <cstdio>
#include <cstdint>
namespace pg8 {
#define PG8_LAS __attribute__((address_space(3)))
typedef unsigned short bf16_t;
typedef short bf16x8 __attribute__((ext_vector_type(8)));
typedef float f32x4 __attribute__((ext_vector_type(4)));
typedef unsigned u32x4 __attribute__((ext_vector_type(4)));
constexpr int BM = 256, BK = 64, HALF = 128, HTB = HALF * BK * 2  , STAGE_BYTES = 8 * HTB, NXCD = 8, WGM = 8;

__host__ __device__ __forceinline__ int lds_byte(int r, int c) { const int st = (r >> 4) * 2 + (c >> 5), rr = r & 15, cc = c & 31, ob = rr * 64 + cc * 2; return st * 1024 + (ob ^ (((ob >> 9) & 1) << 5)); }
__host__ __device__ __forceinline__ void stage_rc(int b, int& R, int& C) { const int st = b / 1024, sb = b % 1024, swz = sb ^ (((sb >> 9) & 1) << 5); R = (st >> 1) * 16 + swz / 64; C = (st & 1) * 32 + (swz % 64) / 2; }
__host__ __device__ __forceinline__ int perm32(int rho) { const int n = rho >> 4, i = rho & 15; return 8 * (i >> 2) + 4 * n + (i & 3); }

struct Unit { int pm, pn; };
struct Gemm { const bf16_t* A; const bf16_t* Bt; int M, N, K; };

struct StaticOrder {
    int nM, nN, nwg, G, c;
    __host__ __device__ void init(int M, int N, int G_, int c_) { nM = M / BM; nN = N / BM; nwg = nM * nN; G = G_; c = c_; }
    __host__ __device__ bool next(int i, Unit& u) const {
        const int L = i * G + c; if (L >= nwg) return false;
        int wgid = (int)L; { const int q = nwg / NXCD, r = nwg % NXCD, xcd = wgid % NXCD, off = wgid / NXCD; wgid = (xcd < r ? xcd * (q + 1) : r * (q + 1) + (xcd - r) * q) + off; }
        const int nig = WGM * nN, gid = wgid / nig, fm = gid * WGM, gsz = (nM - fm) < WGM ? (nM - fm) : WGM;
        u.pm = fm + ((wgid % nig) % gsz); u.pn = (wgid % nig) / gsz; return true;
    }
    __device__ __forceinline__ void a_ready(const Unit&) const {}
    __device__ __forceinline__ void done(const Unit&) const {}
};

__device__ __forceinline__ unsigned cvt_pk_bf16(float lo, float hi) { unsigned r; asm volatile("v_cvt_pk_bf16_f32 %0, %1, %2" : "=v"(r) : "v"(lo), "v"(hi)); return r; }
struct EpiInProj {
    static constexpr bool PERM = true, AFTER_DRAIN = false;
    bf16_t* projR; bf16_t* mixin; bf16_t* kv;
    __device__ __forceinline__ void operator()(const f32x4 (&acc)[2][2][4][2], const Unit& u, int wr, int wc, int fr, int fq) const {
        const int pn = u.pn; bf16_t* base; int ldc, colt;
        if (pn < 6) { base = projR; ldc = 2048; colt = pn * 256; }
        else if (pn < 8) { base = mixin; ldc = 1024; colt = 512 + (pn - 6) * 256; }
        else if (pn == 8) { base = kv; ldc = 256; colt = 0; }
        else { base = projR; ldc = 2048; colt = 1536 + (pn - 9) * 256; }
        const int row0 = u.pm * BM + wr * 64 + fr, col0 = colt + wc * 32 + 8 * fq;
#pragma unroll
        for (int ai = 0; ai < 2; ++ai)
#pragma unroll
            for (int m = 0; m < 4; ++m) { bf16_t* rowp = base + (size_t)(row0 + ai * HALF + m * 16) * ldc + col0;
#pragma unroll
                for (int bj = 0; bj < 2; ++bj) { const f32x4 v0 = acc[ai][bj][m][0], v1 = acc[ai][bj][m][1];
                    u32x4 w; w.x = cvt_pk_bf16(v0[0], v0[1]); w.y = cvt_pk_bf16(v0[2], v0[3]); w.z = cvt_pk_bf16(v1[0], v1[1]); w.w = cvt_pk_bf16(v1[2], v1[3]);
                    *(u32x4*)(rowp + bj * HALF) = w; } }
    }
};
struct EpiResid {
    static constexpr bool PERM = false, AFTER_DRAIN = false;
    const float* xp; const float* xs; float* out; const float* gate;
    __device__ __forceinline__ void operator()(const f32x4 (&acc)[2][2][4][2], const Unit& u, int wr, int wc, int fr, int fq) const {
        const int seq = u.pm < 64 ? 0 : 1 + ((u.pm - 64) >> 4);
        const float* gp = gate + (size_t)seq * 12288;
        const int col0 = u.pn * BM + wc * 32 + 4 * fq;
        f32x4 gv[2][2];
#pragma unroll
        for (int bj = 0; bj < 2; ++bj)
#pragma unroll
            for (int n = 0; n < 2; ++n) gv[bj][n] = *(const f32x4*)(gp + col0 + bj * HALF + n * 16);

#ifdef EXP_XOUT
        const float* xb = out;
#else
        const float* xb = u.pm < 64 ? xp : xs - (size_t)16384 * 1024;
#endif

#pragma unroll
        for (int ai = 0; ai < 2; ++ai) {
            f32x4 bsv[4][2][2];
#pragma unroll
            for (int m = 0; m < 4; ++m) { const size_t off = (size_t)(u.pm * BM + ai * HALF + wr * 64 + m * 16 + fr) * 1024 + col0;
#pragma unroll
                for (int bj = 0; bj < 2; ++bj)
#pragma unroll
                    for (int n = 0; n < 2; ++n) bsv[m][bj][n] = *(const f32x4*)(xb + off + bj * HALF + n * 16); }
            asm volatile("" ::: "memory");
#pragma unroll
            for (int m = 0; m < 4; ++m) { const size_t off = (size_t)(u.pm * BM + ai * HALF + wr * 64 + m * 16 + fr) * 1024 + col0;
#pragma unroll
                for (int bj = 0; bj < 2; ++bj)
#pragma unroll
                    for (int n = 0; n < 2; ++n) *(f32x4*)(out + off + bj * HALF + n * 16) = bsv[m][bj][n] + gv[bj][n] * acc[ai][bj][m][n]; }
            asm volatile("" ::: "memory");
        }
    }
};
struct EpiSwiGLU {
    static constexpr bool PERM = true, AFTER_DRAIN = false;
    bf16_t* act;
    __device__ __forceinline__ void operator()(const f32x4 (&acc)[2][2][4][2], const Unit& u, int wr, int wc, int fr, int fq) const {
        const int row0 = u.pm * BM + wr * 64 + fr, col0 = u.pn * 128 + wc * 32 + 8 * fq;
#pragma unroll
        for (int ai = 0; ai < 2; ++ai)
#pragma unroll
            for (int m = 0; m < 4; ++m) { bf16_t* rowp = act + (size_t)(row0 + ai * HALF + m * 16) * 2816 + col0;
                float o[8];
#pragma unroll
                for (int n = 0; n < 2; ++n)
#pragma unroll
                    for (int i = 0; i < 4; ++i) { const float g = acc[ai][0][m][n][i], up = acc[ai][1][m][n][i];
                        o[n * 4 + i] = g * __builtin_amdgcn_rcpf(1.0f + __builtin_amdgcn_exp2f(-1.4426950408889634f * g)) * up; }
                u32x4 w; w.x = cvt_pk_bf16(o[0], o[1]); w.y = cvt_pk_bf16(o[2], o[3]); w.z = cvt_pk_bf16(o[4], o[5]); w.w = cvt_pk_bf16(o[6], o[7]);
                *(u32x4*)rowp = w; }
    }
};
template <class Epi, class Sched, bool ALIGN_EPI = false, bool SP2 = false>
__device__ __forceinline__ void gemm_phase(PG8_LAS unsigned char* lds, const Gemm g, const Sched& S, const Epi& E, int tid_in) {
    int tid_ = tid_in; asm volatile("" : "+v"(tid_)); const int tid = tid_, wid = __builtin_amdgcn_readfirstlane(tid >> 6), lane = tid & 63, wr = wid >> 2, wc = wid & 3, fr = lane & 15, fq = lane >> 4;
    const int K = g.K, nt = K / BK;
    unsigned voffA[2], voffB[2];
#pragma unroll
    for (int i = 0; i < 2; ++i) { int R, C; stage_rc(tid * 16 + i * 8192, R, C); const int Rb = Epi::PERM ? ((R & ~31) + perm32(R & 31)) : R;
        voffA[i] = (unsigned)(R * K + C) * 2u; voffB[i] = (unsigned)(Rb * K + C) * 2u; }
    const size_t kstep = (size_t)(BK * 2);
    const size_t hstep = (size_t)HALF * K * 2;
    const size_t tstep = 2 * hstep;
    const unsigned ldsw = (unsigned)wid * 1024u;
    const int aoff = lds_byte(wr * 64 + fr, fq * 8), boff = lds_byte(wc * 32 + fr, fq * 8);
#define PG8_SA(b, h) (((b) * 2 + (h)) * HTB)
#define PG8_SB(b, h) ((4 + (b) * 2 + (h)) * HTB)
#define PG8_STAGE(bufoff, gbase, voff) do { _Pragma("unroll") for (int _i = 0; _i < 2; ++_i) \
        __builtin_amdgcn_global_load_lds((const unsigned*)((const char*)(gbase) + (voff)[_i]), (PG8_LAS unsigned*)(lds + (bufoff) + ldsw + _i * 8192), 16, 0, 0); } while (0)
#define PG8_LDA(dst, b, h) do { _Pragma("unroll") for (int m = 0; m < 4; ++m) _Pragma("unroll") for (int k = 0; k < 2; ++k) dst[m][k] = *(const PG8_LAS bf16x8*)(lds + PG8_SA(b, h) + aoff + m * 2048 + k * 1024); } while (0)
#define PG8_LDB(dst, b, h) do { _Pragma("unroll") for (int n = 0; n < 2; ++n) _Pragma("unroll") for (int k = 0; k < 2; ++k) dst[n][k] = *(const PG8_LAS bf16x8*)(lds + PG8_SB(b, h) + boff + n * 2048 + k * 1024); } while (0)
#define PG8_MMA(ai, bj, At, Bt) do { __builtin_amdgcn_s_setprio(1); _Pragma("unroll") for (int m = 0; m < 4; ++m) _Pragma("unroll") for (int n = 0; n < 2; ++n) _Pragma("unroll") for (int k = 0; k < 2; ++k) \
        acc[ai][bj][m][n] = __builtin_amdgcn_mfma_f32_16x16x32_bf16(Bt[n][k], At[m][k], acc[ai][bj][m][n], 0, 0, 0); __builtin_amdgcn_s_setprio(0); } while (0)
#define PG8_WAIT_V(n) asm volatile("s_waitcnt vmcnt(" #n ")" ::: "memory")
#define PG8_WAIT_L(n) asm volatile("s_waitcnt lgkmcnt(" #n ")" ::: "memory")
#define PG8_BAR __builtin_amdgcn_s_barrier()
#define PG8_SCHED __builtin_amdgcn_sched_barrier(0)
    Unit cur, nxt; int ui = 0;
    if (!S.next(0, cur)) return;
    f32x4 acc[2][2][4][2];
#pragma unroll
    for (int a = 0; a < 2; ++a)
#pragma unroll
        for (int b = 0; b < 2; ++b)
#pragma unroll
            for (int m = 0; m < 4; ++m)
#pragma unroll
                for (int n = 0; n < 2; ++n) acc[a][b][m][n] = (f32x4){0.f, 0.f, 0.f, 0.f};
    bf16x8 At[4][2], B0[2][2], B1[2][2];
    const char* cA = (const char*)g.A + (size_t)cur.pm * tstep; const char* cB = (const char*)g.Bt + (size_t)cur.pn * tstep;
    S.a_ready(cur);
    if constexpr (SP2) {
        PG8_STAGE(PG8_SB(0, 0), cB, voffB); PG8_STAGE(PG8_SB(0, 1), cB + hstep, voffB); PG8_STAGE(PG8_SA(0, 0), cA, voffA); PG8_STAGE(PG8_SA(0, 1), cA + hstep, voffA);
        if (wr == 1) PG8_BAR;
        PG8_WAIT_V(2); PG8_BAR;
        PG8_STAGE(PG8_SB(1, 0), cB + kstep, voffB); PG8_STAGE(PG8_SA(1, 0), cA + kstep, voffA); PG8_STAGE(PG8_SB(1, 1), cB + hstep + kstep, voffB);
        PG8_WAIT_V(6); PG8_BAR;
    } else {
        PG8_STAGE(PG8_SB(0, 0), cB, voffB); PG8_STAGE(PG8_SA(0, 0), cA, voffA); PG8_STAGE(PG8_SB(0, 1), cB + hstep, voffB); PG8_STAGE(PG8_SA(0, 1), cA + hstep, voffA);
        if (wr == 1) PG8_BAR;
        PG8_WAIT_V(4); PG8_BAR;
        PG8_STAGE(PG8_SB(1, 0), cB + kstep, voffB); PG8_STAGE(PG8_SA(1, 0), cA + kstep, voffA); PG8_STAGE(PG8_SB(1, 1), cB + hstep + kstep, voffB);
        PG8_WAIT_V(6); PG8_BAR;
    }
    for (;;) {
        const bool has_next = S.next(ui + 1, nxt);
        const char* nA = has_next ? (const char*)g.A + (size_t)nxt.pm * tstep : cA; const char* nB = has_next ? (const char*)g.Bt + (size_t)nxt.pn * tstep : cB;
        for (int t = 0; t < nt; t += 2) {
            const bool last = (t == nt - 2);
            const char* a1 = cA + (size_t)(t + 1) * kstep;
            const char* a2 = last ? nA : cA + (size_t)(t + 2) * kstep; const char* b2 = last ? nB : cB + (size_t)(t + 2) * kstep;
            const char* a3 = a2 + kstep; const char* b3 = b2 + kstep;
            if (last && has_next) S.a_ready(nxt);
            if constexpr (SP2) {
            PG8_LDB(B0, 0, 0); PG8_LDB(B1, 0, 1); PG8_SCHED; PG8_LDA(At, 0, 0); PG8_STAGE(PG8_SA(1, 1), a1 + hstep, voffA);
            PG8_WAIT_V(8); PG8_WAIT_L(0); PG8_BAR; PG8_MMA(0, 0, At, B0); PG8_MMA(0, 1, At, B1); PG8_BAR; PG8_SCHED;
            PG8_LDA(At, 0, 1); PG8_STAGE(PG8_SB(0, 0), b2, voffB); PG8_STAGE(PG8_SB(0, 1), b2 + hstep, voffB); PG8_STAGE(PG8_SA(0, 0), a2, voffA);
            PG8_WAIT_V(8); PG8_WAIT_L(0); PG8_BAR; PG8_MMA(1, 0, At, B0); PG8_MMA(1, 1, At, B1); PG8_BAR; PG8_SCHED;
            PG8_LDB(B0, 1, 0); PG8_LDB(B1, 1, 1); PG8_SCHED; PG8_LDA(At, 1, 0); PG8_STAGE(PG8_SA(0, 1), a2 + hstep, voffA);
            PG8_WAIT_V(8); PG8_WAIT_L(0); PG8_BAR; PG8_MMA(0, 0, At, B0); PG8_MMA(0, 1, At, B1); PG8_BAR; PG8_SCHED;
            PG8_LDA(At, 1, 1); PG8_STAGE(PG8_SB(1, 0), b3, voffB); PG8_STAGE(PG8_SB(1, 1), b3 + hstep, voffB); PG8_STAGE(PG8_SA(1, 0), a3, voffA);
            PG8_WAIT_V(8); PG8_WAIT_L(0); PG8_BAR; PG8_MMA(1, 0, At, B0); PG8_MMA(1, 1, At, B1); PG8_BAR; PG8_SCHED;
            } else {
            PG8_LDB(B0, 0, 0); PG8_SCHED; PG8_LDA(At, 0, 0); PG8_STAGE(PG8_SA(1, 1), a1 + hstep, voffA);
            PG8_WAIT_L(8); PG8_BAR; PG8_WAIT_L(0); PG8_MMA(0, 0, At, B0); PG8_BAR; PG8_SCHED;
            PG8_LDB(B1, 0, 1); PG8_STAGE(PG8_SB(0, 0), b2, voffB);
            PG8_BAR; PG8_WAIT_L(0); PG8_MMA(0, 1, At, B1); PG8_BAR;
            PG8_LDA(At, 0, 1); PG8_STAGE(PG8_SA(0, 0), a2, voffA);
            PG8_BAR; PG8_WAIT_L(0); PG8_MMA(1, 0, At, B0); PG8_BAR; PG8_SCHED;
            PG8_STAGE(PG8_SB(0, 1), b2 + hstep, voffB);
            PG8_WAIT_V(6); PG8_BAR; PG8_MMA(1, 1, At, B1); PG8_BAR;
            PG8_LDB(B0, 1, 0); PG8_SCHED; PG8_LDA(At, 1, 0); PG8_STAGE(PG8_SA(0, 1), a2 + hstep, voffA);
            PG8_WAIT_L(8); PG8_BAR; PG8_WAIT_L(0); PG8_MMA(0, 0, At, B0); PG8_BAR; PG8_SCHED;
            PG8_LDB(B1, 1, 1); PG8_STAGE(PG8_SB(1, 0), b3, voffB);
            PG8_BAR; PG8_WAIT_L(0); PG8_MMA(0, 1, At, B1); PG8_BAR;
            PG8_LDA(At, 1, 1); PG8_STAGE(PG8_SA(1, 0), a3, voffA);
            PG8_BAR; PG8_WAIT_L(0); PG8_MMA(1, 0, At, B0); PG8_BAR; PG8_SCHED;
            PG8_STAGE(PG8_SB(1, 1), b3 + hstep, voffB);
            PG8_WAIT_V(6); PG8_BAR; PG8_MMA(1, 1, At, B1); PG8_BAR;
            }
        }
        if constexpr (ALIGN_EPI) { if (wr == 0) PG8_BAR; }
        if constexpr (!Epi::AFTER_DRAIN) { E(acc, cur, wr, wc, fr, fq); S.done(cur); }
        if (!has_next) break;
#pragma unroll
        for (int a = 0; a < 2; ++a)
#pragma unroll
            for (int b = 0; b < 2; ++b)
#pragma unroll
                for (int m = 0; m < 4; ++m)
#pragma unroll
                    for (int n = 0; n < 2; ++n) acc[a][b][m][n] = (f32x4){0.f, 0.f, 0.f, 0.f};
        cur = nxt; cA = nA; cB = nB; ++ui;
        if constexpr (ALIGN_EPI) { if (wr == 1) PG8_BAR; }
    }
    PG8_WAIT_V(0);
    if constexpr (!ALIGN_EPI) { if (wr == 0) PG8_BAR; }
    PG8_BAR;
    if constexpr (Epi::AFTER_DRAIN) { E.fused(acc, cur, wr, wc, fr, fq, lds, wid, lane); S.done(cur); }
#undef PG8_SA
#undef PG8_SB
#undef PG8_STAGE
#undef PG8_LDA
#undef PG8_LDB
#undef PG8_MMA
#undef PG8_WAIT_V
#undef PG8_WAIT_L
#undef PG8_BAR
#undef PG8_SCHED
}
}

#ifndef PG8_SP2
#define PG8_SP2 true
#endif
#ifndef PG8_ALIGN
#define PG8_ALIGN true
#endif
#include <hip/hip_bf16.h>
#include <cmath>
namespace attn_body {
using bf16=__hip_bfloat16;
using bf16x8=__attribute__((ext_vector_type(8)))short;
using s16x4=__attribute__((ext_vector_type(4)))short;
using f32x16=__attribute__((ext_vector_type(16)))float;
using u32x4=__attribute__((ext_vector_type(4)))unsigned;
constexpr int D=64,QP=1024,KVP=256;
constexpr int NW=8,QBLK=32,QB=QBLK*NW,KVBLK=64;
constexpr int ATTN_UNIT_ROWS=QB;
__device__ __forceinline__ int crow(int r,int hi){return (r&3)+8*(r>>2)+4*hi;}
#define SBAR() __builtin_amdgcn_sched_barrier(0)
__device__ __forceinline__ void cmask(f32x16&p0,f32x16&p1,int jb,int qrel,int hi){
  const float NEG=-INFINITY; int kb=64*jb+4*hi;
  #pragma unroll
  for(int r=0;r<16;++r){int kv=kb+(r&3)+8*(r>>2); if(kv>qrel)p0[r]=NEG; if(kv+32>qrel)p1[r]=NEG;}
}

constexpr int NSLOT=3, SLOTB=8192;
constexpr int LDS_K=0, LDS_V=NSLOT*SLOTB, LDS_WS=2*NSLOT*SLOTB, LDS_OST=LDS_WS+NW*64*4, LDS_BYTES=LDS_OST+NW*4096;
constexpr float C2=0.125f*1.4426950408889634f;
__device__ __forceinline__ void glds16(const void*gsrc,unsigned lds_dst){unsigned keep;
  asm volatile("s_mov_b32 %0, m0\n\ts_mov_b32 m0, %2\n\ts_nop 0\n\tglobal_load_lds_dwordx4 %1, off\n\ts_mov_b32 m0, %0":"=&s"(keep):"v"(gsrc),"s"(lds_dst):"memory");}
__device__ __forceinline__ float max3f(float a,float b,float c){float r;asm("v_max3_f32 %0, %1, %2, %3":"=v"(r):"v"(a),"v"(b),"v"(c));return r;}
__device__ __forceinline__ float max2f(float a,float b){float r;asm("v_max_f32_e32 %0, %1, %2":"=v"(r):"v"(a),"v"(b));return r;}
__device__ __forceinline__ float fadd_s(float a,float b){float r;asm("v_add_f32_e32 %0, %1, %2":"=v"(r):"v"(a),"v"(b));return r;}
__device__ __forceinline__ float fsub_s(float a,float b){float r;asm("v_sub_f32_e32 %0, %1, %2":"=v"(r):"v"(a),"v"(b));return r;}
typedef float f32x2_t __attribute__((ext_vector_type(2))); typedef __bf16 bf16x2_t __attribute__((ext_vector_type(2)));
__device__ __forceinline__ unsigned cvtpk_s(float lo,float hi){f32x2_t v={lo,hi};bf16x2_t b=__builtin_convertvector(v,bf16x2_t);return __builtin_bit_cast(unsigned,b);}
#define WAIT_BAR(N) asm volatile("s_waitcnt vmcnt(" #N ") lgkmcnt(0)\n\ts_barrier":::"memory")

__device__ __forceinline__ void qkt(f32x16&p0,f32x16&p1,const char*Kslot,const bf16x8*qr,const f32x16&negm,int r32,int hi){
  const char*kb=Kslot+hi*1024+r32*16;
  #pragma unroll
  for(int d0=0;d0<4;++d0){
    const bf16x8 b0=*reinterpret_cast<const bf16x8*>(kb+d0*2048);
    const bf16x8 b1=*reinterpret_cast<const bf16x8*>(kb+d0*2048+512);
    if(d0==0){p0=__builtin_amdgcn_mfma_f32_32x32x16_bf16(b0,qr[0],negm,0,0,0);p1=__builtin_amdgcn_mfma_f32_32x32x16_bf16(b1,qr[0],negm,0,0,0);}
    else{p0=__builtin_amdgcn_mfma_f32_32x32x16_bf16(b0,qr[d0],p0,0,0,0);p1=__builtin_amdgcn_mfma_f32_32x32x16_bf16(b1,qr[d0],p1,0,0,0);}}
}
typedef __attribute__((address_space(3))) const char* lds_cptr;
typedef short v4i16_t __attribute__((ext_vector_type(4)));
__device__ __forceinline__ void kload8(bf16x8*kf,lds_cptr kp){
  kf[0]=*(const __attribute__((address_space(3))) bf16x8*)(kp);      kf[1]=*(const __attribute__((address_space(3))) bf16x8*)(kp+512);
  kf[2]=*(const __attribute__((address_space(3))) bf16x8*)(kp+2048); kf[3]=*(const __attribute__((address_space(3))) bf16x8*)(kp+2560);
  kf[4]=*(const __attribute__((address_space(3))) bf16x8*)(kp+4096); kf[5]=*(const __attribute__((address_space(3))) bf16x8*)(kp+4608);
  kf[6]=*(const __attribute__((address_space(3))) bf16x8*)(kp+6144); kf[7]=*(const __attribute__((address_space(3))) bf16x8*)(kp+6656);
}
__device__ __forceinline__ void kload2(bf16x8*kf,lds_cptr kp,int j){ kf[2*j]=*(const __attribute__((address_space(3))) bf16x8*)(kp+j*2048); kf[2*j+1]=*(const __attribute__((address_space(3))) bf16x8*)(kp+j*2048+512); }
__device__ __forceinline__ s16x4 vtr(lds_cptr p){ return __builtin_bit_cast(s16x4,__builtin_amdgcn_ds_read_tr16_b64_v4i16((__attribute__((address_space(3))) v4i16_t*)p)); }
__device__ __forceinline__ float rowmax(const f32x16&p0,const f32x16&p1){
  float a=max3f(p0[0],p0[1],p1[0]),b=max3f(p0[2],p0[3],p1[1]);a=max3f(a,p1[2],p1[3]);
  #pragma unroll
  for(int r=4;r<16;r+=4){a=max3f(a,p0[r],p0[r+1]);b=max3f(b,p0[r+2],p0[r+3]);a=max3f(a,p1[r],p1[r+1]);b=max3f(b,p1[r+2],p1[r+3]);}
  const float m=max2f(a,b);
  auto rr=__builtin_amdgcn_permlane32_swap(__float_as_uint(m),__float_as_uint(m),false,false);
  return max2f(__uint_as_float(rr[0]),__uint_as_float(rr[1]));
}
__device__ __forceinline__ void pv(f32x16*o,int vb,bf16x8 pa0,bf16x8 pa1,bf16x8 pa2,bf16x8 pa3){
  #pragma unroll
  for(int d0=0;d0<2;++d0){s16x4 lo[4],hi[4];
    #pragma unroll
    for(int ks=0;ks<4;++ks){
      asm volatile("ds_read_b64_tr_b16 %0,%1 offset:%c2":"=&v"(lo[ks]):"v"(vb),"i"(d0*4096+ks*1024):"memory");
      asm volatile("ds_read_b64_tr_b16 %0,%1 offset:%c2":"=&v"(hi[ks]):"v"(vb),"i"(d0*4096+ks*1024+512):"memory");}
    asm volatile("s_waitcnt lgkmcnt(0)":::"memory");SBAR();
    #define PK(k) (bf16x8){lo[k][0],lo[k][1],lo[k][2],lo[k][3],hi[k][0],hi[k][1],hi[k][2],hi[k][3]}
    o[d0]=__builtin_amdgcn_mfma_f32_32x32x16_bf16(pa0,PK(0),o[d0],0,0,0);
    o[d0]=__builtin_amdgcn_mfma_f32_32x32x16_bf16(pa1,PK(1),o[d0],0,0,0);
    o[d0]=__builtin_amdgcn_mfma_f32_32x32x16_bf16(pa2,PK(2),o[d0],0,0,0);
    o[d0]=__builtin_amdgcn_mfma_f32_32x32x16_bf16(pa3,PK(3),o[d0],0,0,0);
    #undef PK
  }
}

#ifndef ATTN_STORE16
#define ATTN_STORE16(p,v) (*(u32x4*)(p)=(v))
#endif
template<int THRL> __device__ __forceinline__ void attn_unit(long rowbase,int T,int h,int qb,const bf16*Q,const bf16*K,const bf16*V,bf16*O,char*shm,int tid_in){
  int tid_=tid_in; asm volatile("":"+v"(tid_)); const int tid=tid_,lane=tid&63,r32=lane&31,hi=lane>>5; const int wid=__builtin_amdgcn_readfirstlane(tid>>6);
  const int q0=qb*QB;
  const bf16*Qw=Q+(rowbase+q0+wid*QBLK)*QP+h*D;
  const bf16*Kh=K+rowbase*KVP+(h>>2)*D,*Vh=V+rowbase*KVP+(h>>2)*D;
  const unsigned lds0=(unsigned)(uintptr_t)shm;
  float*wsf=(float*)(shm+LDS_WS)+wid*64;
  const bf16*ksrc=Kh+(long)lane*KVP+wid*8;
  const bf16*vsrc=Vh+(long)(16*(wid&3)+(lane>>2))*KVP+(wid>>2)*32+(lane&3)*8;
  const unsigned kdst=lds0+LDS_K+wid*1024, vdst=lds0+LDS_V+wid*1024;
  #define DMA_K(t,slot) glds16(ksrc+(long)(t)*KVBLK*KVP,(unsigned)__builtin_amdgcn_readfirstlane(kdst+(slot)))
  #define DMA_V(t,slot) glds16(vsrc+(long)(t)*KVBLK*KVP,(unsigned)__builtin_amdgcn_readfirstlane(vdst+(slot)))
  const int vb0=(int)(lds0+LDS_V)+((lane>>4)&1)*32+(lane&3)*8+(4*hi+((lane&15)>>2))*64;
  const char*Kbase=shm+LDS_K; bf16x8 kf[8];
  const lds_cptr shm3=(lds_cptr)shm; const lds_cptr kp0=shm3+LDS_K+hi*1024+r32*16; const lds_cptr vp0=shm3+LDS_V+((lane>>4)&1)*32+(lane&3)*8+(4*hi+((lane&15)>>2))*64;
  const int NT=T/KVBLK;
  DMA_K(0,0);DMA_V(0,0);DMA_K(1,SLOTB);
  bf16x8 qr[4];
  #pragma unroll
  for(int d0=0;d0<4;++d0)qr[d0]=*reinterpret_cast<const bf16x8*>(&Qw[(long)r32*QP+d0*16+hi*8]);
  float mhat=0.f,l_reg=0.f;f32x16 o[2];o[0]=f32x16{};o[1]=f32x16{};f32x16 negm=f32x16{};asm volatile("":"+v"(negm));

  #define CMASK(P0,P1,t) do{}while(0)
  bool resc=false;
  #define START(P0,P1) do{ const float rm=rowmax(P0,P1); resc=false; \
    { const float dl=rm; mhat=fadd_s(mhat,dl); \
      _Pragma("unroll") for(int r=0;r<16;++r){P0[r]=fsub_s(P0[r],dl);P1[r]=fsub_s(P1[r],dl);} \
      _Pragma("unroll") for(int r=0;r<16;++r)negm[r]=-mhat; asm volatile("":"+v"(negm)); } \
    _Pragma("unroll") for(int r=0;r<16;++r)P0[r]=__builtin_amdgcn_exp2f(P0[r]); }while(0)
  #define RESC() do{ if(resc){ asm volatile("s_waitcnt lgkmcnt(0)":::"memory"); \
      _Pragma("unroll") for(int d_=0;d_<2;++d_) _Pragma("unroll") for(int r=0;r<16;++r)o[d_][r]*=wsf[crow(r,hi)]; } }while(0)
  f32x16 pA0,pA1,pB0,pB1;
  int sl_prev=0,sl_cur=0,sl_next=SLOTB;
  #define ROT() do{sl_prev=sl_cur;sl_cur=sl_next;sl_next=(sl_next==(NSLOT-1)*SLOTB)?0:sl_next+SLOTB;}while(0)
  DMA_K(2,2*SLOTB);
  WAIT_BAR(3);
  qkt(pA0,pA1,Kbase,qr,negm,r32,hi);asm volatile("s_nop 15\n\ts_nop 7":"+v"(pA0),"+v"(pA1));CMASK(pA0,pA1,0);
  START(pA0,pA1);
  _Pragma("unroll") for(int r=0;r<16;++r)pA1[r]=__builtin_amdgcn_exp2f(pA1[r]);
  WAIT_BAR(0);
  DMA_K(3,0);DMA_V(1,SLOTB);
  ROT();
  kload8(kf,kp0+sl_cur);
  WAIT_BAR(2);
  s16x4 vlo[8],vhi[8]; u32x4 pw0,pw1,pw2,pw3;
  #define PKW(P,B) cvtpk_s(P[B],P[B+1])
  #define PAF(k) __builtin_bit_cast(bf16x8,pw##k)
  #define VFR(i) (bf16x8){vlo[i][0],vlo[i][1],vlo[i][2],vlo[i][3],vhi[i][0],vhi[i][1],vhi[i][2],vhi[i][3]}
  #define PIN(x) asm volatile("":"+v"(x))
  #define MX3(a,b,c) __builtin_fmaxf(__builtin_fmaxf((a),(b)),(c))
  #define GAPA(MF,A0,A1,A2,A3,W0,W1,PW) do{ MF; sacc+=A0; sacc+=A1; sacc+=A2; sacc+=A3; PIN(sacc); W0; W1; PIN(PW); SBAR(); }while(0)
  #define EX(v) __builtin_amdgcn_exp2f(v)
  #define GAPB(MF,X,B) do{ MF; X[B]=EX(X[B]); X[B+1]=EX(X[B+1]); X[B+2]=EX(X[B+2]); X[B+3]=EX(X[B+3]); PIN(X); SBAR(); }while(0)
  #define VRD(i) do{ vlo[i]=vtr(vp_+(((i)>>2)*4096+((i)&3)*1024)); vhi[i]=vtr(vp_+(((i)>>2)*4096+((i)&3)*1024+512)); }while(0)
  #define KRD(G,j) do{ if(G){ kload2(kf,kp0+sl_next,j); SBAR(); } }while(0)
  #define STEP(C0,C1,P0,P1,t,GK,GV,GL) do{ SBAR(); \
    const lds_cptr vp_=vp0+sl_prev; \
    VRD(0); SBAR(); float sacc=(P0[0]+P0[1]); \
    GAPA(C0=__builtin_amdgcn_mfma_f32_32x32x16_bf16(kf[0],qr[0],negm,0,0,0), P0[2],P0[3],P0[4],P0[5],     pw0[0]=PKW(P0,0), pw0[1]=PKW(P0,2), pw0); \
    VRD(4); SBAR(); GAPA(C1=__builtin_amdgcn_mfma_f32_32x32x16_bf16(kf[1],qr[0],negm,0,0,0), P0[6],P0[7],P0[8],P0[9],     pw0[2]=PKW(P0,4), pw0[3]=PKW(P0,6), pw0); \
    VRD(1); SBAR(); GAPA(C0=__builtin_amdgcn_mfma_f32_32x32x16_bf16(kf[2],qr[1],C0,0,0,0),   P0[10],P0[11],P0[12],P0[13], pw1[0]=PKW(P0,8), pw1[1]=PKW(P0,10), pw1); \
    VRD(5); SBAR(); GAPA(C1=__builtin_amdgcn_mfma_f32_32x32x16_bf16(kf[3],qr[1],C1,0,0,0),   P0[14],P0[15],P1[0],P1[1],   pw1[2]=PKW(P0,12),pw1[3]=PKW(P0,14), pw1); \
    VRD(2); SBAR(); GAPA(C0=__builtin_amdgcn_mfma_f32_32x32x16_bf16(kf[4],qr[2],C0,0,0,0),   P1[2],P1[3],P1[4],P1[5],     pw2[0]=PKW(P1,0), pw2[1]=PKW(P1,2), pw2); \
    VRD(6); SBAR(); GAPA(C1=__builtin_amdgcn_mfma_f32_32x32x16_bf16(kf[5],qr[2],C1,0,0,0),   P1[6],P1[7],P1[8],P1[9],     pw2[2]=PKW(P1,4), pw2[3]=PKW(P1,6), pw2); \
    VRD(3); SBAR(); GAPA(C0=__builtin_amdgcn_mfma_f32_32x32x16_bf16(kf[6],qr[3],C0,0,0,0),   P1[10],P1[11],P1[12],P1[13], pw3[0]=PKW(P1,8), pw3[1]=PKW(P1,10), pw3); \
    VRD(7); SBAR(); GAPA(C1=__builtin_amdgcn_mfma_f32_32x32x16_bf16(kf[7],qr[3],C1,0,0,0),   P1[14],P1[15],0.f,0.f,       pw3[2]=PKW(P1,12),pw3[3]=PKW(P1,14), pw3); \
    l_reg+=sacc; \
    if(GK){DMA_K((t)+3,sl_cur);} if(GV){DMA_V((t)+1,sl_next);} \
    CMASK(C0,C1,t); \
    { float a=MX3(C0[0],C0[1],C1[0]),b=MX3(C0[2],C0[3],C1[1]); a=MX3(a,C1[2],C1[3]); \
      _Pragma("unroll") for(int r=4;r<16;r+=4){a=MX3(a,C0[r],C0[r+1]);b=MX3(b,C0[r+2],C0[r+3]);a=MX3(a,C1[r],C1[r+1]);b=MX3(b,C1[r+2],C1[r+3]);} \
      float rm=__builtin_fmaxf(a,b); { auto rr=__builtin_amdgcn_permlane32_swap(__float_as_uint(rm),__float_as_uint(rm),false,false); rm=__builtin_fmaxf(__uint_as_float(rr[0]),__uint_as_float(rr[1])); } \
      resc=false; \
      if(__builtin_expect(__any(rm>(float)THRL),0)){ const float dl=__builtin_fmaxf(rm,0.f); mhat+=dl; \
        _Pragma("unroll") for(int r=0;r<16;++r){C0[r]-=dl;C1[r]-=dl;} \
        _Pragma("unroll") for(int r=0;r<16;++r)negm[r]=-mhat; asm volatile("":"+v"(negm)); \
        const float f=__builtin_amdgcn_exp2f(-dl); l_reg*=f; if(hi==0)wsf[r32]=f; resc=true; } } \
    SBAR(); \
    GAPB(o[0]=__builtin_amdgcn_mfma_f32_32x32x16_bf16(PAF(0),VFR(0),o[0],0,0,0), C0,0); \
    GAPB(o[1]=__builtin_amdgcn_mfma_f32_32x32x16_bf16(PAF(0),VFR(4),o[1],0,0,0), C0,4); \
    KRD(GL,0); GAPB(o[0]=__builtin_amdgcn_mfma_f32_32x32x16_bf16(PAF(1),VFR(1),o[0],0,0,0), C0,8); \
    KRD(GL,1); GAPB(o[1]=__builtin_amdgcn_mfma_f32_32x32x16_bf16(PAF(1),VFR(5),o[1],0,0,0), C0,12); \
    KRD(GL,2); GAPB(o[0]=__builtin_amdgcn_mfma_f32_32x32x16_bf16(PAF(2),VFR(2),o[0],0,0,0), C1,0); \
    KRD(GL,3); GAPB(o[1]=__builtin_amdgcn_mfma_f32_32x32x16_bf16(PAF(2),VFR(6),o[1],0,0,0), C1,4); \
    GAPB(o[0]=__builtin_amdgcn_mfma_f32_32x32x16_bf16(PAF(3),VFR(3),o[0],0,0,0), C1,8); \
    GAPB(o[1]=__builtin_amdgcn_mfma_f32_32x32x16_bf16(PAF(3),VFR(7),o[1],0,0,0), C1,12); \
    }while(0)
  int t=1;
  #undef CMASK
  #define CMASK(P0,P1,t) do{}while(0)
  for(;t+5<NT;t+=2){
    STEP(pB0,pB1,pA0,pA1,t,true,true,true);     WAIT_BAR(2); RESC(); ROT();
    STEP(pA0,pA1,pB0,pB1,t+1,true,true,true);   WAIT_BAR(2); RESC(); ROT();
  }
  #undef CMASK
  #define CMASK(P0,P1,t) do{}while(0)
  #define ENDW(tt) do{ if((tt)+3<NT){WAIT_BAR(2);} else if((tt)+2<NT){WAIT_BAR(1);} else {WAIT_BAR(0);} }while(0)
  for(;t+1<NT;t+=2){
    STEP(pB0,pB1,pA0,pA1,t,(t+3<NT),(t+1<NT),(t+1<NT));       ENDW(t);   RESC(); ROT();
    STEP(pA0,pA1,pB0,pB1,t+1,(t+4<NT),(t+2<NT),(t+2<NT));     ENDW(t+1); RESC(); ROT();
  }
  STEP(pB0,pB1,pA0,pA1,NT-1,false,false,false); RESC();
  { float sacc=pB0[0]+pB0[1]; _Pragma("unroll") for(int r=2;r<16;++r)sacc+=pB0[r]; _Pragma("unroll") for(int r=0;r<16;++r)sacc+=pB1[r]; l_reg+=sacc;
    pw0=(u32x4){PKW(pB0,0),PKW(pB0,2),PKW(pB0,4),PKW(pB0,6)};pw1=(u32x4){PKW(pB0,8),PKW(pB0,10),PKW(pB0,12),PKW(pB0,14)};pw2=(u32x4){PKW(pB1,0),PKW(pB1,2),PKW(pB1,4),PKW(pB1,6)};pw3=(u32x4){PKW(pB1,8),PKW(pB1,10),PKW(pB1,12),PKW(pB1,14)};
    SBAR(); pv(o,vb0+sl_cur,PAF(0),PAF(1),PAF(2),PAF(3)); }
  #undef PKW
  #undef PAF
  #undef VFR
  #undef PIN
  #undef MX3
  #undef GAPA
  #undef GAPB
  #undef EX
  #undef VRD
  #undef KRD
  #undef STEP
  #undef ENDW
  {auto rr=__builtin_amdgcn_permlane32_swap(__float_as_uint(l_reg),__float_as_uint(l_reg),false,false);l_reg=__uint_as_float(rr[0])+__uint_as_float(rr[1]);}
  if(hi==0)wsf[32+r32]=l_reg;asm volatile("s_waitcnt lgkmcnt(0)":::"memory");
  float rli[16];
  #pragma unroll
  for(int r=0;r<16;++r)rli[r]=__builtin_amdgcn_rcpf(wsf[32+crow(r,hi)]);
  bf16*Ow=O+(rowbase+q0+wid*QBLK)*QP+h*D;
  { bf16*stg=(bf16*)(shm+LDS_OST)+wid*2048;
    #pragma unroll
    for(int r=0;r<16;++r){const int orow=crow(r,hi);
      #pragma unroll
      for(int d0=0;d0<2;++d0)stg[orow*64+d0*32+r32]=__float2bfloat16(o[d0][r]*rli[r]);}
    asm volatile("s_waitcnt lgkmcnt(0)":::"memory");
    #pragma unroll
    for(int i=0;i<4;++i){const int row=i*8+(lane>>3),ch=lane&7; const u32x4 v=*(const u32x4*)(stg+row*64+ch*8); ATTN_STORE16(Ow+(long)row*QP+ch*8,v);} }
  asm volatile("s_waitcnt lgkmcnt(0)\n\ts_barrier":::"memory");
  #undef DMA_K
  #undef DMA_V
  #undef CMASK
  #undef START
  #undef RESC
  #undef ROT
}
constexpr int ATTN_LDS_BYTES=LDS_BYTES;
#undef SBAR
#undef WAIT_BAR
}
namespace cg = cooperative_groups;
#define GAS __attribute__((address_space(1)))
#define LAS __attribute__((address_space(3)))
#define CAS __attribute__((address_space(4)))
typedef unsigned short bf16;
typedef unsigned v4u __attribute__((ext_vector_type(4)));
typedef unsigned v2u __attribute__((ext_vector_type(2)));
typedef float f32x4 __attribute__((ext_vector_type(4)));
typedef float f2 __attribute__((ext_vector_type(2)));
typedef short bf16x8 __attribute__((ext_vector_type(8)));
constexpr int NWAVES = 8;
constexpr int D = 1024, MP = 16384, MT = 81920, TSAMP = 4096, NSEQ = 17, DEPTH = 2;
constexpr int NINP = 2816, NINSRC = 2688, DFF = 2816, PRP = 2048, KVP = 256;
constexpr int NITEM_SCAN = 6144;
constexpr float NORM_EPS = 1e-6f, QK_EPS = 1e-6f, GN_EPS = 64e-5f, DECAY_SCALE = 0.6065306597126334f;
constexpr size_t MiB = 1u << 20;
constexpr size_t WS_MOD = 0;
constexpr size_t WS_CTL = 896 * 1024;
constexpr size_t WS_BON = 1 * MiB;
constexpr size_t WS_WSM = 7 * MiB;
constexpr size_t WS_WIN = 8 * MiB, WS_WOUT = 19 * MiB, WS_WFFI = 23 * MiB, WS_WFFO = 45 * MiB;
constexpr size_t WS_XN = 56 * MiB;
constexpr size_t WS_MIX = 216 * MiB;
constexpr size_t WS_PROJ = 376 * MiB;
constexpr size_t WS_KV = 696 * MiB;
constexpr size_t WS_P = 736 * MiB, WS_QS = 832 * MiB;
constexpr size_t WS_SLAB = 928 * MiB;
constexpr size_t WS_ACT = 376 * MiB;
constexpr size_t WS_END = 976 * MiB;
constexpr int LDS_BYTES = 163840;

__device__ __forceinline__ int bid_() { int v = (int)blockIdx.x; asm volatile("" : "+s"(v)); return v; }
__device__ __forceinline__ unsigned f2bf(float f) { unsigned u = __builtin_bit_cast(unsigned, f); return (u + 0x7fffu + ((u >> 16) & 1u)) >> 16; }
__device__ __forceinline__ unsigned pk2(float lo, float hi) { return f2bf(lo) | (f2bf(hi) << 16); }
__device__ __forceinline__ float bflo(unsigned u) { return __builtin_bit_cast(float, u << 16); }
__device__ __forceinline__ float bfhi(unsigned u) { return __builtin_bit_cast(float, u & 0xffff0000u); }
__device__ __forceinline__ f32x4 ld4bf(const bf16* p) { const v2u u = *(const v2u*)p; return (f32x4){bflo(u.x), bfhi(u.x), bflo(u.y), bfhi(u.y)}; }
__device__ __forceinline__ float sigmoidf_(float x) { return __builtin_amdgcn_rcpf(1.0f + __builtin_amdgcn_exp2f(-1.4426950408889634f * x)); }
__device__ __forceinline__ float tanhf_(float x) { return 1.0f - 2.0f * __builtin_amdgcn_rcpf(1.0f + __builtin_amdgcn_exp2f(2.8853900817779268f * x)); }
__device__ __forceinline__ float shx(float v, int o, int lane) { return __builtin_bit_cast(float, __builtin_amdgcn_ds_bpermute((lane ^ o) << 2, __builtin_bit_cast(int, v))); }
__device__ __forceinline__ float wave_sum(float v, int lane) {
#pragma unroll
    for (int o = 1; o < 64; o <<= 1) v += shx(v, o, lane);
    return v;
}
#define LDS_WAIT() asm volatile("s_waitcnt lgkmcnt(0)" ::: "memory")

struct Args { const float* in[25]; float* out; unsigned char* ws; };

__device__ __forceinline__ void p0_transpose_item(const float* W, int K, int N, bf16* WT, int k0, int src_n0, int dst_n0, bool zero, LAS float* scr, int lane) {
    if (!zero) {
#pragma unroll 8
        for (int i = 0; i < 32; ++i) { const int kk = 2 * i + (lane >> 5); scr[kk * 33 + (lane & 31)] = W[(size_t)(k0 + kk) * N + src_n0 + (lane & 31)]; }
    } else {
#pragma unroll 8
        for (int i = 0; i < 32; ++i) { const int kk = 2 * i + (lane >> 5); scr[kk * 33 + (lane & 31)] = 0.f; }
    }
    LDS_WAIT(); asm volatile("" ::: "memory");
    const int c = lane & 7;
#pragma unroll
    for (int j = 0; j < 4; ++j) { const int n = (lane >> 3) + 8 * j; const LAS float* s = scr + (8 * c) * 33 + n;
        v4u o; o.x = pk2(s[0 * 33], s[1 * 33]); o.y = pk2(s[2 * 33], s[3 * 33]); o.z = pk2(s[4 * 33], s[5 * 33]); o.w = pk2(s[6 * 33], s[7 * 33]);
        *(v4u*)(WT + (size_t)(dst_n0 + n) * K + k0 + 8 * c) = o; }
    LDS_WAIT(); asm volatile("" ::: "memory");
}
__device__ __forceinline__ void p0_prologue(const CAS Args* A, LAS unsigned char* lds, int wave, int lane, int G) {
    LAS float* scr = (LAS float*)(lds + wave * 16384);
    const int gw = bid_() * NWAVES + wave, NGW = G * NWAVES;
    constexpr int I_IN = 16 * 88, I_OUT = 16 * 32, I_FFI = 16 * 176, I_FFO = 44 * 32, I_LORA = 16 * 2, I_GATE = 2 * 16;
    constexpr int PER_L = I_IN + I_OUT + I_FFI + I_FFO + 2 * I_LORA + I_GATE;
    unsigned char* ws = A->ws;
    for (int it = gw; it < 2 * PER_L; it += NGW) {
        const int l = it / PER_L; int r = it % PER_L;
        if (r < I_IN) { const int kb = r / 88, nb = r % 88; const bool z = nb * 32 >= NINSRC;
            p0_transpose_item(A->in[8] + (size_t)l * D * NINSRC, D, NINSRC, (bf16*)(ws + WS_WIN) + (size_t)l * NINP * D, kb * 64, nb * 32, nb * 32, z, scr, lane); continue; } r -= I_IN;
        if (r < I_OUT) { const int kb = r / 32, nb = r % 32;
            p0_transpose_item(A->in[22] + (size_t)l * D * D, D, D, (bf16*)(ws + WS_WOUT) + (size_t)l * D * D, kb * 64, nb * 32, nb * 32, false, scr, lane); continue; } r -= I_OUT;
        if (r < I_FFI) { const int kb = r / 176, nb = r % 176; const int dn = nb * 32, pn = dn >> 8, rr = dn & 255; const int sn = rr < 128 ? pn * 128 + rr : DFF + pn * 128 + (rr - 128);
            p0_transpose_item(A->in[23] + (size_t)l * D * 2 * DFF, D, 2 * DFF, (bf16*)(ws + WS_WFFI) + (size_t)l * 2 * DFF * D, kb * 64, sn, dn, false, scr, lane); continue; } r -= I_FFI;
        if (r < I_FFO) { const int kb = r / 32, nb = r % 32;
            p0_transpose_item(A->in[24] + (size_t)l * DFF * D, DFF, D, (bf16*)(ws + WS_WFFO) + (size_t)l * D * DFF, kb * 64, nb * 32, nb * 32, false, scr, lane); continue; } r -= I_FFO;
        if (r < I_LORA) { const int d = r / 16, nb = r % 16;
            p0_transpose_item(A->in[11] + (size_t)(l * 2 + d) * 64 * 512, 64, 512, (bf16*)(ws + WS_WSM) + (size_t)(l * 2 + d) * 512 * 64, 0, nb * 32, nb * 32, false, scr, lane); continue; } r -= I_LORA;
        if (r < I_LORA) { const int d = r / 16, nb = r % 16;
            p0_transpose_item(A->in[13] + (size_t)(l * 2 + d) * 64 * 512, 64, 512, (bf16*)(ws + WS_WSM) + 131072 + (size_t)(l * 2 + d) * 512 * 64, 0, nb * 32, nb * 32, false, scr, lane); continue; } r -= I_LORA;
        { const int kb = r / 16, nb = r % 16;
            p0_transpose_item(A->in[14] + (size_t)l * 128 * 512, 128, 512, (bf16*)(ws + WS_WSM) + 262144 + (size_t)l * 512 * 128, kb * 64, nb * 32, nb * 32, false, scr, lane); }
    }
}
__device__ __forceinline__ void p0_mod(const CAS Args* A, LAS unsigned char* lds, int tid) {
    const int item = bid_(); if (item >= 192) return;
    LAS float* cs = (LAS float*)lds;
    LAS float* red = (LAS float*)(lds + 81920);
    for (int e = tid; e < NSEQ * 1024; e += 512) { const int s = e >> 10, k = e & 1023; const float c = s == 0 ? A->in[2][k] : A->in[3][(s - 1) * 1024 + k];
        cs[k * 20 + s] = c * sigmoidf_(c); }
    __syncthreads();
    const int l = item / 96, col0 = (item % 96) * 64, kq = tid >> 6, col = tid & 63;
    const float* w = A->in[4] + (size_t)l * 1024 * 6144 + col0 + col;
    float acc[NSEQ];
#pragma unroll
    for (int s = 0; s < NSEQ; ++s) acc[s] = 0.f;
#pragma unroll 4
    for (int k = kq * 128; k < kq * 128 + 128; ++k) { const float wv = w[(size_t)k * 6144];
        const LAS f32x4* c4 = (const LAS f32x4*)(cs + k * 20);
        const f32x4 c0 = c4[0], c1 = c4[1], c2 = c4[2], c3 = c4[3]; const float c16 = cs[k * 20 + 16];
#pragma unroll
        for (int i = 0; i < 4; ++i) { acc[i] += wv * c0[i]; acc[4 + i] += wv * c1[i]; acc[8 + i] += wv * c2[i]; acc[12 + i] += wv * c3[i]; }
        acc[16] += wv * c16; }
#pragma unroll
    for (int s = 0; s < NSEQ; ++s) red[(kq * NSEQ + s) * 64 + col] = acc[s];
    __syncthreads();
    float* mod = (float*)(A->ws + WS_MOD);
    for (int e = tid; e < NSEQ * 64; e += 512) { const int s = e >> 6, c = e & 63; float v = A->in[5][l * 6144 + col0 + c];
#pragma unroll
        for (int q = 0; q < 8; ++q) v += red[(q * NSEQ + s) * 64 + c];
        mod[(size_t)(s * 2 + l) * 6144 + col0 + c] = v; }
    __syncthreads();
}
__device__ __forceinline__ int seq_of(int m) { return m < MP ? 0 : 1 + ((m - MP) >> 12); }
__device__ __forceinline__ void norm_phase(const float* xp, const float* xs, const float* g, const float* modl  , bf16* XN, int wave, int lane, int G) {
    const int gw = bid_() * NWAVES + wave, NGW = G * NWAVES;
    f32x4 gv[4];
#pragma unroll
    for (int j = 0; j < 4; ++j) gv[j] = ((const f32x4*)g)[64 * j + lane];
    for (int m = gw; m < MT; m += NGW) {
        const float* xrow = m < MP ? xp + (size_t)m * D : xs + (size_t)(m - MP) * D;
        const f32x4* xr = (const f32x4*)xrow + lane;
        f32x4 v[4]; float s = 0.f;
#pragma unroll
        for (int j = 0; j < 4; ++j) { v[j] = xr[64 * j]; s += (v[j].x * v[j].x + v[j].y * v[j].y) + (v[j].z * v[j].z + v[j].w * v[j].w); }
        const float rstd = 1.0f / sqrtf(wave_sum(s, lane) * (1.f / D) + NORM_EPS);
        const float* mp = modl + (size_t)seq_of(m) * 12288;
        unsigned long long* o8 = (unsigned long long*)(XN + (size_t)m * D) + lane;
#pragma unroll
        for (int j = 0; j < 4; ++j) { const f32x4 sh = ((const f32x4*)mp)[64 * j + lane], sc = ((const f32x4*)(mp + 1024))[64 * j + lane];
            const f32x4 y = v[j] * rstd * gv[j] * (1.0f + sc) + sh;
            o8[64 * j] = (unsigned long long)pk2(y.x, y.y) | ((unsigned long long)pk2(y.z, y.w) << 32); }
    }
}
__device__ __forceinline__ void qk_prep_phase(bf16* mix, bf16* kv, const float* qg, const float* kg, int wave, int lane, int G) {
    const int gw = bid_() * NWAVES + wave, NGW = G * NWAVES;
    const int hsel = lane >> 5, li = lane & 31, half = li >> 4, i = li & 15, d1 = half * 32 + i, d2 = d1 + 16;
    const float freq = __builtin_amdgcn_exp2f(-(float)i * (13.287712379549449f / 16.0f));
    const float q1 = qg[d1], q2 = qg[d2], k1 = kg[d1], k2 = kg[d2];
    for (int m = gw; m < MT; m += NGW) {
        const int t = m < MP ? m : (m - MP) & (TSAMP - 1);
        const float pos = (float)(half ? (t & 63) : (t >> 6));
        float sn, cn; sincosf(pos * freq, &sn, &cn);
        bf16* pp[5]; float x1[5], x2[5];
#pragma unroll
        for (int it = 0; it < 5; ++it) { const int hh = it * 2 + hsel;
            pp[it] = hh < 8 ? mix + (size_t)m * 1024 + 512 + hh * 64 : kv + (size_t)m * KVP + (hh - 8) * 64;
            x1[it] = bflo(pp[it][d1]); x2[it] = bflo(pp[it][d2]); }
        asm volatile("" ::: "memory");
        unsigned short r1[5], r2[5];
#pragma unroll
        for (int it = 0; it < 5; ++it) { const int hh = it * 2 + hsel;
            float ss = x1[it] * x1[it] + x2[it] * x2[it];
#pragma unroll
            for (int o = 1; o < 32; o <<= 1) ss += shx(ss, o, lane);
            const float rstd = 1.0f / sqrtf(ss * (1.f / 64.f) + QK_EPS);
            const float y1 = x1[it] * rstd * (hh < 8 ? q1 : k1), y2 = x2[it] * rstd * (hh < 8 ? q2 : k2);
            float o1 = y1 * cn - y2 * sn, o2 = y2 * cn + y1 * sn;
            if (hh < 8) { o1 *= attn_body::C2; o2 *= attn_body::C2; }
            r1[it] = (unsigned short)f2bf(o1); r2[it] = (unsigned short)f2bf(o2); }
#pragma unroll
        for (int it = 0; it < 5; ++it) { pp[it][d1] = r1[it]; pp[it][d2] = r2[it]; }
    }
}
struct ScanP { const bf16* proj; const float* conv_w; const float* w0; const float* a0; const float* k_k; const float* k_a; const float* r_k; const bf16* upw; const bf16* upa; };
__device__ __forceinline__ f32x4 conv4(const bf16* proj, const float* cw, int m, int col, bool hp, bool hn) {
    const bf16* p = proj + (size_t)m * PRP + col;
    const f32x4 c0 = *(const f32x4*)(cw + col), c1 = *(const f32x4*)(cw + 1536 + col), c2 = *(const f32x4*)(cw + 3072 + col);
    f32x4 r = c1 * ld4bf(p);
    if (hp) r += c0 * ld4bf(p - PRP);
    if (hn) r += c2 * ld4bf(p + PRP);
    return r;
}
template <int MODE>
__device__ __forceinline__ void scan_prologue(const ScanP& P, int m0, int seqbase, int T, int h, int d, float* slab, LAS float* lw, float* bon, int lane) {
    const int fr = lane & 15, fq = lane >> 4, m = m0 + fr, pos = m - seqbase; const bool hp = pos > 0, hn = pos < T - 1;
    float* srow = slab + fr * 384;
    f32x4 k4[4], kk4[4], r4[4]; float ss = 0.f;
    v2u pk_[4][3], pv_[4][3], pr_[4][3];
    const v2u zz = (v2u){0u, 0u};
#pragma unroll
    for (int n = 0; n < 4; ++n) { const bf16* p = P.proj + (size_t)m * PRP + h * 64 + 16 * n + 4 * fq;
        pk_[n][1] = *(const v2u*)(p + 512); pk_[n][0] = zz; pk_[n][2] = zz;
        if (hp) pk_[n][0] = *(const v2u*)(p + 512 - PRP);
        if (hn) pk_[n][2] = *(const v2u*)(p + 512 + PRP);
        if (MODE != 1) { pv_[n][1] = *(const v2u*)(p + 1024); pv_[n][0] = zz; pv_[n][2] = zz;
            if (hp) pv_[n][0] = *(const v2u*)(p + 1024 - PRP);
            if (hn) pv_[n][2] = *(const v2u*)(p + 1024 + PRP); }
        if (MODE == 2) { pr_[n][1] = *(const v2u*)(p); pr_[n][0] = zz; pr_[n][2] = zz;
            if (hp) pr_[n][0] = *(const v2u*)(p - PRP);
            if (hn) pr_[n][2] = *(const v2u*)(p + PRP); } }
    v4u xw_[2]; bf16x8 xa_[2];
#pragma unroll
    for (int ks = 0; ks < 2; ++ks) { xw_[ks] = *(const v4u*)(P.proj + (size_t)m * PRP + 1536 + d * 64 + ks * 32 + 8 * fq); xa_[ks] = *(const bf16x8*)(P.proj + (size_t)m * PRP + 1664 + d * 64 + ks * 32 + 8 * fq); }
    asm volatile("" ::: "memory");
#define CONV3_(arr, which) ({ const float* cw_ = P.conv_w + (which) * 512 + col; const f32x4 c0 = *(const f32x4*)cw_, c1 = *(const f32x4*)(cw_ + 1536), c2 = *(const f32x4*)(cw_ + 3072); \
        const v2u u0 = arr[n][0], u1 = arr[n][1], u2 = arr[n][2]; \
        c0 * (f32x4){bflo(u0.x), bfhi(u0.x), bflo(u0.y), bfhi(u0.y)} + c1 * (f32x4){bflo(u1.x), bfhi(u1.x), bflo(u1.y), bfhi(u1.y)} + c2 * (f32x4){bflo(u2.x), bfhi(u2.x), bflo(u2.y), bfhi(u2.y)}; })
#pragma unroll
    for (int n = 0; n < 4; ++n) { const int c = 16 * n + 4 * fq, col = h * 64 + c;
        k4[n] = CONV3_(pk_, 1);
        if (MODE != 1) { const f32x4 v4 = CONV3_(pv_, 2); *(f32x4*)(srow + 320 + c) = v4; LAS float* xsel = (fr == (d ? 15 : 0)) ? lw + 2048 + c : lw + 2304 + lane * 4; *(LAS f32x4*)(xsel + 192) = v4; }
        if (MODE == 2) { r4[n] = CONV3_(pr_, 0); *(LAS f32x4*)(lw + 1024 + fr * 64 + c) = r4[n]; }
        kk4[n] = k4[n] * *(const f32x4*)(P.k_k + col);
        ss += (kk4[n].x * kk4[n].x + kk4[n].y * kk4[n].y) + (kk4[n].z * kk4[n].z + kk4[n].w * kk4[n].w); }
#undef CONV3_
    ss += shx(ss, 16, lane); ss += shx(ss, 32, lane);
    const float rs = 1.0f / sqrtf(ss + 1e-12f);
    f32x4 Dw[4], Da[4];
#pragma unroll
    for (int n = 0; n < 4; ++n) { Dw[n] = (f32x4){0.f, 0.f, 0.f, 0.f}; Da[n] = (f32x4){0.f, 0.f, 0.f, 0.f}; }
#pragma unroll
    for (int ks = 0; ks < 2; ++ks) {
        const v4u xw = xw_[ks]; const bf16x8 xa = xa_[ks];
        v4u tw;
#pragma unroll
        for (int e = 0; e < 4; ++e) tw[e] = pk2(tanhf_(bflo(xw[e])), tanhf_(bfhi(xw[e])));
        const bf16x8 twv = __builtin_bit_cast(bf16x8, tw);
#pragma unroll
        for (int n = 0; n < 4; ++n) { const size_t wo = (size_t)(h * 64 + 16 * n + fr) * 64 + ks * 32 + 8 * fq;
            Dw[n] = __builtin_amdgcn_mfma_f32_16x16x32_bf16(*(const bf16x8*)(P.upw + wo), twv, Dw[n], 0, 0, 0);
            Da[n] = __builtin_amdgcn_mfma_f32_16x16x32_bf16(*(const bf16x8*)(P.upa + wo), xa, Da[n], 0, 0, 0); }
    }
    float bp = 0.f;
#pragma unroll
    for (int n = 0; n < 4; ++n) { const int c = 16 * n + 4 * fq, col = h * 64 + c;
        const f32x4 w0 = *(const f32x4*)(P.w0 + col), a0 = *(const f32x4*)(P.a0 + col), ka = *(const f32x4*)(P.k_a + col);
        f32x4 wv, bv, kd, av;
#pragma unroll
        for (int i = 0; i < 4; ++i) { const float ic = sigmoidf_(Da[n][i] + a0[i]);
            wv[i] = __builtin_amdgcn_exp2f(-DECAY_SCALE * 1.4426950408889634f * sigmoidf_(Dw[n][i] + w0[i]));
            const float kk = kk4[n][i] * rs; av[i] = -kk; bv[i] = kk * ic; kd[i] = k4[n][i] * (1.0f + (ic - 1.0f) * ka[i]); }
        *(LAS f32x4*)(lw + fr * 64 + c) = av; *(LAS f32x4*)(lw + 3072 + fr * 64 + c) = wv; *(LAS f32x4*)(lw + (MODE == 3 ? 1024 : 4096) + fr * 64 + c) = bv;
        if (MODE != 1) *(f32x4*)(srow + 192 + c) = kd;
        { LAS float* xsel = (fr == (d ? 15 : 0)) ? lw + 2048 + c : lw + 2304 + lane * 4;
          *(LAS f32x4*)(xsel) = wv; if (MODE != 3) *(LAS f32x4*)(xsel + 64) = bv; if (MODE != 1) *(LAS f32x4*)(xsel + 128) = kd; }
        if (MODE == 2) { const f32x4 rk = *(const f32x4*)(P.r_k + col); const f32x4 t = r4[n] * kd * rk; bp += (t.x + t.y) + (t.z + t.w); }
        asm volatile("" ::: "memory");
    }
    if (MODE == 2) { bp += shx(bp, 16, lane); bp += shx(bp, 32, lane); if (fq == 0) bon[(size_t)m * 8 + h] = 0.5f * bp; }
}
template <int MODE>
__device__ __forceinline__ void scan_item(const CAS Args* A, int l, int item, float* slab0, LAS float* ldsw, int lane) {
    unsigned char* ws = A->ws;
    const bool isP = item < 2048; const int it2 = isP ? item : item - 2048;
    const int d = it2 & 1, h = (it2 >> 1) & 7, chunk = it2 >> 4, m0c = isP ? chunk * 128 : MP + chunk * 256, nsub = isP ? 8 : 16;
    const int seqbase = isP ? 0 : MP + (chunk >> 4) * TSAMP, T = isP ? MP : TSAMP;
    ScanP P; P.proj = (const bf16*)(ws + WS_PROJ); P.conv_w = A->in[9] + (size_t)l * 3 * 1536; P.w0 = A->in[10] + (size_t)(l * 2 + d) * 512; P.a0 = A->in[12] + (size_t)(l * 2 + d) * 512;
    P.k_k = A->in[15] + l * 512; P.k_a = A->in[16] + l * 512; P.r_k = A->in[17] + l * 512;
    P.upw = (const bf16*)(ws + WS_WSM) + (size_t)(l * 2 + d) * 512 * 64; P.upa = (const bf16*)(ws + WS_WSM) + 131072 + (size_t)(l * 2 + d) * 512 * 64;
    float* bon = (float*)(ws + WS_BON) + (size_t)d * MT * 8;
    bf16* yb = (bf16*)(ws + WS_XN) + (size_t)d * MT * 512;
    f2 S[32], Pm[32];
    if (MODE == 3) {
#pragma unroll
        for (int i = 0; i < 32; ++i) Pm[i] = (f2){lane == 2 * i ? 1.f : 0.f, lane == 2 * i + 1 ? 1.f : 0.f}; }
    if (MODE == 2) { const f32x4* q = (const f32x4*)((const float*)(ws + WS_QS) + ((size_t)item * 64 + lane) * 64);
#pragma unroll
        for (int i = 0; i < 16; ++i) { const f32x4 v = q[i]; S[2 * i] = (f2){v.x, v.y}; S[2 * i + 1] = (f2){v.z, v.w}; } }
    else {
#pragma unroll
        for (int i = 0; i < 32; ++i) S[i] = MODE == 1 ? (f2){lane == 2 * i ? 1.f : 0.f, lane == 2 * i + 1 ? 1.f : 0.f} : (f2){0.f, 0.f}; }
#pragma nounroll
    for (int sc = 0; sc < nsub; ++sc) {
        const int sub = d ? nsub - 1 - sc : sc, t0 = m0c + sub * 16;
        float* slab = slab0;
        { int lane_l = lane; asm volatile("" : "+v"(lane_l)); scan_prologue<MODE>(P, t0, seqbase, T, h, d, slab, ldsw, bon, lane_l);
#ifdef DUP_PRO
          asm volatile("" : "+v"(lane_l)); scan_prologue<MODE>(P, t0, seqbase, T, h, d, slab, ldsw, bon, lane_l);
#endif
        }
        asm volatile("" ::: "memory");
#define RL2(x, j) (f2){__builtin_bit_cast(float, __builtin_amdgcn_readlane(__builtin_bit_cast(int, x), 2 * (j))), __builtin_bit_cast(float, __builtin_amdgcn_readlane(__builtin_bit_cast(int, x), 2 * (j) + 1))}
        const GAS float* sl = (const GAS float*)slab + lane;
        LDS_WAIT();
        float nw[1], nb[1], nk[1], nv[1];
        { const LAS float* xl = ldsw + 2048 + lane; nw[0] = 0.f; nb[0] = 0.f; nk[0] = 0.f; nv[0] = 0.f; if (MODE != 1) { nk[0] = xl[128]; nv[0] = xl[192]; } }
#pragma nounroll
        for (int st = 0; st < 16; ++st) {
            const int s = d ? 15 - st : st;
            const float cw = nw[0], cb = nb[0], ck = nk[0], vv = nv[0];
            if (st < 15) { const GAS float* p = sl + (d ? s - 1 : s + 1) * 384;  if (MODE != 1) { nk[0] = p[192]; nv[0] = p[320]; } }
            const LAS f32x4* ua = (const LAS f32x4*)(ldsw + s * 64); const LAS f32x4* ur = (const LAS f32x4*)(ldsw + 1024 + s * 64); const LAS f32x4* uw = (const LAS f32x4*)(ldsw + 3072 + s * 64); const LAS f32x4* ub = (const LAS f32x4*)(ldsw + (MODE == 3 ? 1024 : 4096) + s * 64);
            f2 sa2 = (f2){0.f, 0.f}, sb2 = (f2){0.f, 0.f}, pa2 = (f2){0.f, 0.f}, pb2 = (f2){0.f, 0.f};
#pragma unroll
            for (int j = 0; j < 16; ++j) { const f32x4 aq = ua[j]; const f2 a0 = (f2){aq.x, aq.y}, a1 = (f2){aq.z, aq.w}; sa2 = S[2 * j] * a0 + sa2; sb2 = S[2 * j + 1] * a1 + sb2;
                if (MODE == 3) { pa2 = Pm[2 * j] * a0 + pa2; pb2 = Pm[2 * j + 1] * a1 + pb2; } }
            const float sa = (sa2.x + sa2.y) + (sb2.x + sb2.y), pa = (pa2.x + pa2.y) + (pb2.x + pb2.y); const f2 pas = (f2){pa, pa};
            const f2 sas = (f2){sa, sa}, vvs = (f2){vv, vv};
            f2 y2 = (f2){0.f, 0.f}, y3 = (f2){0.f, 0.f};
            f32x4 nwq[2], nbq[2], nrq[2];
            nwq[0] = uw[0]; nwq[1] = uw[1]; nbq[0] = ub[0]; nbq[1] = ub[1]; nrq[0] = (f32x4){0.f, 0.f, 0.f, 0.f}; nrq[1] = nrq[0];
            if (MODE == 2) { nrq[0] = ur[0]; nrq[1] = ur[1]; }
#pragma unroll
            for (int g = 0; g < 8; ++g) {
                const f32x4 cwq0 = nwq[0], cwq1 = nwq[1], cbq0 = nbq[0], cbq1 = nbq[1], crq0 = nrq[0], crq1 = nrq[1];
                if (g < 7) { nwq[0] = uw[2 * g + 2]; nwq[1] = uw[2 * g + 3]; nbq[0] = ub[2 * g + 2]; nbq[1] = ub[2 * g + 3];
                    if (MODE == 2) { nrq[0] = ur[2 * g + 2]; nrq[1] = ur[2 * g + 3]; } }
                f2 bb[4], ww[4], kq[4], rr[4];
                ww[0] = (f2){cwq0.x, cwq0.y}; ww[1] = (f2){cwq0.z, cwq0.w}; ww[2] = (f2){cwq1.x, cwq1.y}; ww[3] = (f2){cwq1.z, cwq1.w};
                bb[0] = (f2){cbq0.x, cbq0.y}; bb[1] = (f2){cbq0.z, cbq0.w}; bb[2] = (f2){cbq1.x, cbq1.y}; bb[3] = (f2){cbq1.z, cbq1.w};
                rr[0] = (f2){crq0.x, crq0.y}; rr[1] = (f2){crq0.z, crq0.w}; rr[2] = (f2){crq1.x, crq1.y}; rr[3] = (f2){crq1.z, crq1.w};
#pragma unroll
                for (int q = 0; q < 4; ++q) { const int j = g * 4 + q; if (MODE != 1) kq[q] = RL2(ck, j); }
                __builtin_amdgcn_sched_barrier(0);
#pragma unroll
                for (int q = 0; q < 4; ++q) { const int j = g * 4 + q;
                    f2 t = sas * bb[q];
                    if (MODE != 1) t = vvs * kq[q] + t;
                    S[j] = S[j] * ww[q] + t;
                    if (MODE == 3) Pm[j] = Pm[j] * ww[q] + pas * bb[q];
                    if (MODE == 2) { if (j & 1) y3 = S[j] * rr[q] + y3; else y2 = S[j] * rr[q] + y2; } }
                __builtin_amdgcn_sched_barrier(0);
            }
            if (MODE == 2) yb[(size_t)(t0 + s) * 512 + h * 64 + lane] = (bf16)f2bf((y2.x + y2.y) + (y3.x + y3.y));
        }
#undef RL2
    }
    if (MODE != 2) { f32x4* q = (f32x4*)((float*)(ws + (MODE == 1 ? WS_P : WS_QS)) + ((size_t)item * 64 + lane) * 64);
#pragma unroll
        for (int i = 0; i < 16; ++i) q[i] = (f32x4){S[2 * i].x, S[2 * i].y, S[2 * i + 1].x, S[2 * i + 1].y}; }
    if (MODE == 3) { f32x4* q = (f32x4*)((float*)(ws + WS_P) + ((size_t)item * 64 + lane) * 64);
#pragma unroll
        for (int i = 0; i < 16; ++i) q[i] = (f32x4){Pm[2 * i].x, Pm[2 * i].y, Pm[2 * i + 1].x, Pm[2 * i + 1].y}; }
}
template <bool PASS_C>
__device__ __forceinline__ void scan_phase(const CAS Args* A, LAS unsigned char* lds, int l, int wave, int lane, int G) {
    const int gw = bid_() * NWAVES + wave, NGW = G * NWAVES;
    float* slab0 = (float*)(A->ws + WS_SLAB) + (size_t)gw * 6144;
    LAS float* ldsw = (LAS float*)(lds + wave * 20480);
    if (PASS_C) { for (int item = gw; item < NITEM_SCAN; item += NGW) scan_item<2>(A, l, item, slab0, ldsw, lane); }
    else { for (int item = gw; item < NITEM_SCAN; item += NGW) { int ll = lane; asm volatile("" : "+v"(ll)); scan_item<3>(A, l, item, slab0, ldsw, ll); } }
}
#ifdef EXP_SLOAD
typedef const CAS f2* cf2p_;
__device__ __forceinline__ void probe_sload(const CAS Args* A, int wave, int lane, int G) {
    const int gw = bid_() * NWAVES + wave;
    float* pslab = (float*)(A->ws + WS_SLAB) + (size_t)gw * 12288;
    f2 acc = (f2){0.f, 0.f}, acc2 = (f2){0.f, 0.f};
#pragma nounroll
    for (int rep = 0; rep < EXP_SLOAD; ++rep) {
        float* ps = pslab + (rep & 1) * 6144;
#pragma unroll 4
        for (int i = 0; i < 96; ++i) ps[i * 64 + lane] = (float)(i + rep) * 0.001f;
        unsigned long long sp = (unsigned long long)(uintptr_t)ps;
        sp = __builtin_amdgcn_readfirstlane((unsigned)sp) | ((unsigned long long)__builtin_amdgcn_readfirstlane((unsigned)(sp >> 32)) << 32);
        asm volatile("s_waitcnt vmcnt(0) lgkmcnt(0)" : "+s"(sp) : : "memory");
        cf2p_ u = (cf2p_)sp;
#pragma nounroll
        for (int i = 0; i < 3072; i += 32) {
#pragma unroll
            for (int j = 0; j < 32; j += 2) { acc = acc * u[i + j] + acc; acc2 = acc2 * u[i + j + 1] + acc2; }
        }
    }
    if (acc.x + acc2.y == 12345.678f) pslab[lane] = acc.y + acc2.x;
}
#endif
__device__ __forceinline__ void scanB_phase(const CAS Args* A, LAS unsigned char* lds, int wave, int lane, int G) {
    unsigned char* ws = A->ws;
    LAS float* ex = (LAS float*)lds;
    LAS float* pl = (LAS float*)(lds + 32768);
    const int tid = wave * 64 + lane;
    for (int chain = bid_(); chain < NSEQ * 16; chain += G) {
        const int d = chain & 1, h = (chain >> 1) & 7, seq = chain >> 4;
        const int nc = seq == 0 ? 128 : 16, ibase = seq == 0 ? 0 : 2048 + (seq - 1) * 256;
        f2 S[32]; f2 cur[4];
#pragma unroll
        for (int i = 0; i < 32; ++i) S[i] = (f2){0.f, 0.f};
#pragma unroll
        for (int i = 0; i < 4; ++i) cur[i] = (f2){0.f, 0.f};
        { const int c0 = d ? nc - 1 : 0; const size_t it0 = (size_t)ibase + (size_t)(c0 * 8 + h) * 2 + d;
          const f32x4* ps = (const f32x4*)((const float*)(ws + WS_P) + it0 * 4096); ((LAS f32x4*)pl)[tid] = ps[tid]; ((LAS f32x4*)pl)[tid + 512] = ps[tid + 512]; }
        __syncthreads();
        for (int ci = 0; ci < nc; ++ci) {
            const int c = d ? nc - 1 - ci : ci; const size_t item = (size_t)ibase + (size_t)(c * 8 + h) * 2 + d;
            LAS float* pc = pl + (ci & 1) * 4096; LAS float* pn = pl + ((ci + 1) & 1) * 4096;
            f32x4 pf0 = (f32x4){0.f, 0.f, 0.f, 0.f}, pf1 = pf0;
            if (ci + 1 < nc) { const int cn = d ? nc - 2 - ci : ci + 1; const size_t itn = (size_t)ibase + (size_t)(cn * 8 + h) * 2 + d;
                const f32x4* ps = (const f32x4*)((const float*)(ws + WS_P) + itn * 4096); pf0 = ps[tid]; pf1 = ps[tid + 512]; }
            float* qrow = (float*)(ws + WS_QS) + (item * 64 + lane) * 64 + wave * 8;
            const f32x4 q0 = *(const f32x4*)qrow, q1 = *(const f32x4*)(qrow + 4);
            *(f32x4*)qrow = (f32x4){cur[0].x, cur[0].y, cur[1].x, cur[1].y}; *(f32x4*)(qrow + 4) = (f32x4){cur[2].x, cur[2].y, cur[3].x, cur[3].y};
            f2 n0 = (f2){0.f, 0.f}, n1 = n0, n2 = n0, n3 = n0;
#pragma unroll
            for (int kp = 0; kp < 32; ++kp) {
                const f2 sx = (f2){S[kp].x, S[kp].x}, sy = (f2){S[kp].y, S[kp].y};
                const LAS f32x4* r0 = (const LAS f32x4*)(pc + (2 * kp) * 64 + wave * 8); const LAS f32x4* r1 = (const LAS f32x4*)(pc + (2 * kp + 1) * 64 + wave * 8);
                const f32x4 a0 = r0[0], a1 = r0[1], b0 = r1[0], b1 = r1[1];
                n0 = sx * (f2){a0.x, a0.y} + n0; n1 = sx * (f2){a0.z, a0.w} + n1; n2 = sx * (f2){a1.x, a1.y} + n2; n3 = sx * (f2){a1.z, a1.w} + n3;
                n0 = sy * (f2){b0.x, b0.y} + n0; n1 = sy * (f2){b0.z, b0.w} + n1; n2 = sy * (f2){b1.x, b1.y} + n2; n3 = sy * (f2){b1.z, b1.w} + n3; }
            n0 += (f2){q0.x, q0.y}; n1 += (f2){q0.z, q0.w}; n2 += (f2){q1.x, q1.y}; n3 += (f2){q1.z, q1.w};
            cur[0] = n0; cur[1] = n1; cur[2] = n2; cur[3] = n3;
            LAS float* er = ex + lane * 68 + wave * 8;
            *(LAS f32x4*)er = (f32x4){n0.x, n0.y, n1.x, n1.y}; *(LAS f32x4*)(er + 4) = (f32x4){n2.x, n2.y, n3.x, n3.y};
            ((LAS f32x4*)pn)[tid] = pf0; ((LAS f32x4*)pn)[tid + 512] = pf1;
            __syncthreads();
#pragma unroll
            for (int i = 0; i < 16; ++i) { const f32x4 v = *(const LAS f32x4*)(ex + lane * 68 + 4 * i); S[2 * i] = (f2){v.x, v.y}; S[2 * i + 1] = (f2){v.z, v.w}; }
            __syncthreads();
        }
    }
}
__device__ __forceinline__ void post_phase(const CAS Args* A, int l, int wave, int lane, int G) {
    unsigned char* ws = A->ws;
    const int gw = bid_() * NWAVES + wave, NGW = G * NWAVES;
    const bf16* proj = (const bf16*)(ws + WS_PROJ); const float* cw = A->in[9] + (size_t)l * 3 * 1536;
    const bf16* y0 = (const bf16*)(ws + WS_XN); const bf16* y1 = y0 + (size_t)MT * 512;
    const float* b0 = (const float*)(ws + WS_BON); const float* b1 = b0 + (size_t)MT * 8;
    const bf16* gt = (const bf16*)(ws + WS_WSM) + 262144 + (size_t)l * 512 * 128;
    const float* lng = A->in[18] + l * 512; const float* lnb = A->in[19] + l * 512;
    bf16* mix = (bf16*)(ws + WS_MIX);
    const int h = gw & 7;
    bf16x8 gfrag[4][4];
    { const int fr0 = lane & 15, fq0 = lane >> 4;
#pragma unroll
      for (int ks = 0; ks < 4; ++ks)
#pragma unroll
        for (int n = 0; n < 4; ++n) gfrag[n][ks] = *(const bf16x8*)(gt + (size_t)(h * 64 + 16 * n + fr0) * 128 + ks * 32 + 8 * fq0);
    }
    f32x4 cwv[4][3], lg4[4], lb4[4];
    { const int fq0 = lane >> 4;
#pragma unroll
      for (int n = 0; n < 4; ++n) { const int col = h * 64 + 16 * n + 4 * fq0;
          cwv[n][0] = *(const f32x4*)(cw + 1024 + col); cwv[n][1] = *(const f32x4*)(cw + 1536 + 1024 + col); cwv[n][2] = *(const f32x4*)(cw + 3072 + 1024 + col);
          lg4[n] = *(const f32x4*)(lng + col); lb4[n] = *(const f32x4*)(lnb + col); } }
    for (int item = gw; item < (MT / 16) * 8; item += NGW) {
        int lane_l = lane; asm volatile("" : "+v"(lane_l)); const int fr = lane_l & 15, fq = lane_l >> 4;
        const int m = (item >> 3) * 16 + fr;
        const int seqbase = m < MP ? 0 : MP + ((m - MP) >> 12) * TSAMP, T = m < MP ? MP : TSAMP, pos = m - seqbase; const bool hp = pos > 0, hn = pos < T - 1;
        f32x4 y4[4]; float s = 0.f;
#pragma unroll
        for (int n = 0; n < 4; ++n) { const size_t o = (size_t)m * 512 + h * 64 + 16 * n + 4 * fq; y4[n] = ld4bf(y0 + o) + ld4bf(y1 + o); s += (y4[n].x + y4[n].y) + (y4[n].z + y4[n].w); }
        s += shx(s, 16, lane); s += shx(s, 32, lane);
        const float mu = s * (1.f / 64.f); float q = 0.f;
#pragma unroll
        for (int n = 0; n < 4; ++n) { y4[n] = y4[n] - mu; q += (y4[n].x * y4[n].x + y4[n].y * y4[n].y) + (y4[n].z * y4[n].z + y4[n].w * y4[n].w); }
        q += shx(q, 16, lane); q += shx(q, 32, lane);
        const float rstd = 1.0f / sqrtf(q * (1.f / 64.f) + GN_EPS);
        const float bon = b0[(size_t)m * 8 + h] + b1[(size_t)m * 8 + h];
        f32x4 Dg[4];
#pragma unroll
        for (int n = 0; n < 4; ++n) Dg[n] = (f32x4){0.f, 0.f, 0.f, 0.f};
#pragma unroll
        for (int ks = 0; ks < 4; ++ks) {
            const v4u xg = *(const v4u*)(proj + (size_t)m * PRP + 1792 + ks * 32 + 8 * fq); v4u sg;
#pragma unroll
            for (int e = 0; e < 4; ++e) sg[e] = pk2(sigmoidf_(bflo(xg[e])), sigmoidf_(bfhi(xg[e])));
            const bf16x8 sgv = __builtin_bit_cast(bf16x8, sg);
#pragma unroll
            for (int n = 0; n < 4; ++n) Dg[n] = __builtin_amdgcn_mfma_f32_16x16x32_bf16(gfrag[n][ks], sgv, Dg[n], 0, 0, 0);
        }
#pragma unroll
        for (int n = 0; n < 4; ++n) { const int col = h * 64 + 16 * n + 4 * fq;
            const bf16* pv = proj + (size_t)m * PRP + 1024 + col;
            f32x4 v4 = cwv[n][1] * ld4bf(pv);
            if (hp) v4 += cwv[n][0] * ld4bf(pv - PRP);
            if (hn) v4 += cwv[n][2] * ld4bf(pv + PRP);
            const f32x4 o = ((y4[n] * rstd) * lg4[n] + lb4[n] + bon * v4) * Dg[n];
            v2u w; w.x = pk2(o.x, o.y); w.y = pk2(o.z, o.w);
            *(v2u*)(mix + (size_t)m * 1024 + col) = w; }
    }
}
__device__ __forceinline__ void attn_phase(const CAS Args* A, char* lds, int G, int tid) {
    using attn_body::bf16;
    bf16* Q = (bf16*)(A->ws + WS_MIX) + 512; const bf16* K = (const bf16*)(A->ws + WS_KV); const bf16* V = K + 128;
#ifdef DUP_ATTNP
    for (int u = blockIdx.x; u < 512; u += G) { const int h = u & 7, qb = u >> 3;
        attn_body::attn_unit<8>(0, MP, h, qb, Q, K, V, (bf16*)(A->ws + 976 * MiB), lds, tid); }
#endif
    for (int u = blockIdx.x; u < 512; u += G) { const int h = u & 7, qb = u >> 3;
        attn_body::attn_unit<8>(0, MP, h, qb, Q, K, V, Q, lds, tid); }
    for (int u = blockIdx.x; u < 2048; u += G) { const int h = u & 7, qb = (u >> 3) & 15, sq = u >> 7;
        attn_body::attn_unit<8>((long)MP + (long)sq * TSAMP, TSAMP, h, qb, Q, K, V, Q, lds, tid); }
}

#define XB_TMO      128
#define XB_XCNT(j)  (256  + 64 * (j))
#define XB_XSUB(j)  (1280 + 64 * (j))
#define XB_XGEN(j)  (2304 + 64 * (j))
#define XB_TOP      3328
#define XB_TOPGEN   3392
#define XCD_BAR_WORDS 3456
#define XB_SPIN_CAP (1u << 18)

__device__ __forceinline__ unsigned xb_ld(unsigned* p)              { return __hip_atomic_load(p, __ATOMIC_RELAXED, __HIP_MEMORY_SCOPE_AGENT); }
__device__ __forceinline__ unsigned xb_add(unsigned* p, unsigned v) { return __hip_atomic_fetch_add(p, v, __ATOMIC_RELAXED, __HIP_MEMORY_SCOPE_AGENT); }
__device__ __forceinline__ unsigned xb_xcc_id() { return (unsigned)__builtin_amdgcn_s_getreg((3 << 11) | 20) & 0xFu; }
#define XB_SPIN(cond, bar) do { unsigned _sp = 0; while (cond) { __builtin_amdgcn_s_sleep(1); \
    if ((++_sp & 255u) == 0u) { if (xb_ld(&(bar)[XB_TMO])) break; if (_sp > XB_SPIN_CAP) { atomicAdd(&(bar)[XB_TMO], 1u); break; } } } } while (0)

struct XcdBarrier {
    unsigned* bar; unsigned x;
    volatile LAS unsigned* st;
};

__device__ __forceinline__ XcdBarrier xcd_barrier_post(unsigned* bar, volatile LAS unsigned* st, bool leader) {
    XcdBarrier b; b.bar = bar; b.x = xb_xcc_id(); b.st = st;
    if (leader) (void)xb_add(&bar[XB_XCNT(b.x)], 1u);
    return b;
}
__device__ __forceinline__ void xcd_barrier_complete(unsigned* bar, unsigned x, unsigned& nloc, unsigned& nx) {
    const unsigned G = gridDim.x * gridDim.y * gridDim.z;
    unsigned sum, cnt, mine, sp = 0u;
    for (;;) {
        sum = 0u; cnt = 0u; mine = 0u;
#pragma unroll
        for (unsigned j = 0; j < 16; ++j) { const unsigned c = xb_ld(&bar[XB_XCNT(j)]); sum += c; cnt += (c > 0u) ? 1u : 0u; mine = (j == x) ? c : mine; }
        if (sum == G) break;
        __builtin_amdgcn_s_sleep(1);
        if ((++sp & 255u) == 0u) { if (xb_ld(&bar[XB_TMO])) break; if (sp > XB_SPIN_CAP) { atomicAdd(&bar[XB_TMO], 1u); break; } }
    }
    nloc = mine > 0u ? mine : 1u; nx = cnt > 0u ? cnt : 1u;
}

__device__ __forceinline__ void xcd_barrier(const XcdBarrier& b, bool leader) {
    asm volatile("s_waitcnt vmcnt(0)" ::: "memory");
    __syncthreads();
    if (leader) {
        unsigned* bar = b.bar;
        __builtin_amdgcn_s_waitcnt(0);
        unsigned nloc = b.st[0], nx = b.st[1];
        if (nloc == 0u) { xcd_barrier_complete(bar, b.x, nloc, nx); b.st[0] = nloc; b.st[1] = nx; }
        const unsigned old = xb_add(&bar[XB_XSUB(b.x)], 1u);
        const unsigned gen = old / nloc;
        if (old + 1u == (gen + 1u) * nloc) {
            __builtin_amdgcn_fence(__ATOMIC_RELEASE, "agent");
            asm volatile("s_waitcnt vmcnt(0)" ::: "memory");
            const unsigned og = xb_add(&bar[XB_TOP], 1u);
            const unsigned tg = og / nx;
            if (og + 1u == (tg + 1u) * nx) xb_add(&bar[XB_TOPGEN], 1u);
            else XB_SPIN(xb_ld(&bar[XB_TOPGEN]) == tg, bar);
            __builtin_amdgcn_fence(__ATOMIC_ACQUIRE, "agent");
            xb_add(&bar[XB_XGEN(b.x)], 1u);
            asm volatile("s_waitcnt vmcnt(0)" ::: "memory");
        } else {
            XB_SPIN(xb_ld(&bar[XB_XGEN(b.x)]) == gen, bar);
            __builtin_amdgcn_fence(__ATOMIC_ACQUIRE, "agent");
            asm volatile("s_waitcnt vmcnt(0)" ::: "memory");
        }
    }
    __syncthreads();
}

__device__ __forceinline__ void attn_phase_dyn(const CAS Args* A, char* lds, unsigned* ctr, int tid, bool leader) {
    using attn_body::bf16;
    bf16* Q = (bf16*)(A->ws + WS_MIX) + 512; const bf16* K = (const bf16*)(A->ws + WS_KV); const bf16* V = K + 128;
    const int h0 = (int)(xb_xcc_id() & 7u);
    volatile LAS unsigned* slot = (volatile LAS unsigned*)((LAS unsigned char*)lds + 154368 + 64);
#pragma nounroll
    for (int qi = 0; qi < 8; ++qi) {
        const int h = (h0 + qi) & 7;
        for (;;) {
            if (leader) *slot = atomicAdd(ctr + h * 64, 1u);
            __syncthreads();
            const int k = (int)__builtin_amdgcn_readfirstlane((int)*slot);
            __syncthreads();
            if (k >= 320) break;
            if (k < 64) attn_body::attn_unit<8>(0, MP, h, k, Q, K, V, Q, lds, tid);
            else { const int ks = k - 64; attn_body::attn_unit<8>((long)MP + (long)(ks >> 4) * TSAMP, TSAMP, h, ks & 15, Q, K, V, Q, lds, tid); }
        }
    }
}
#ifndef STOP_AFTER
#define STOP_AFTER 99
#endif
__device__ __forceinline__ int fresh(int v) { asm volatile("" : "+s"(v)); return v; }
__device__ __forceinline__ int freshv(int v) { asm volatile("" : "+v"(v)); return v; }
__device__ __forceinline__ const CAS Args* get_args() { unsigned long long v = (unsigned long long)(uintptr_t)__builtin_amdgcn_kernarg_segment_ptr(); asm volatile("" : "+s"(v)); return (const CAS Args*)v; }
__global__ void __launch_bounds__(NWAVES * 64, 2) hymba_fwd(Args args_unused) {
    extern __shared__ __attribute__((aligned(16))) unsigned char lds[];
    cg::grid_group grid = cg::this_grid();
    const int wave = __builtin_amdgcn_readfirstlane((int)threadIdx.x >> 6), G = gridDim.x;
#define LANE_() ({ int z_ = 0; asm volatile("" : "+s"(z_)); (int)__builtin_amdgcn_mbcnt_hi(~0u, __builtin_amdgcn_mbcnt_lo(~0u, (unsigned)z_)); })
#define lane LANE_()
#define tid (wave * 64 + LANE_())
    LAS unsigned char* l3 = (LAS unsigned char*)lds;
    volatile LAS unsigned* xmisc = (volatile LAS unsigned*)(l3 + 154368);
    if (wave == 0 && LANE_() == 0) { xmisc[0] = 0u; xmisc[1] = 0u; }
    __syncthreads();
    (void)xcd_barrier_post((unsigned*)(get_args()->ws + WS_CTL), xmisc, wave == 0 && LANE_() == 0);
#ifdef USE_CG_SYNC
#define GSYNC() do { grid.sync(); } while (0)
#else
#define GSYNC() do { XcdBarrier b_; b_.bar = (unsigned*)(get_args()->ws + WS_CTL); b_.x = xb_xcc_id(); b_.st = (volatile LAS unsigned*)((LAS unsigned char*)lds + 154368); xcd_barrier(b_, fresh(wave) == 0 && LANE_() == 0); } while (0)
#endif
#ifdef EXP_READOUT
    { const CAS Args* a = get_args(); if (blockIdx.x == 0 && tid == 0) { const float v = a->out[EXP_READOUT]; if (v == 123.456f) ((float*)(a->ws + WS_MOD))[0] = v; } }
#ifdef EXP_READALL
    { const CAS Args* a = get_args(); float acc = 0.f; for (size_t i = (size_t)blockIdx.x * 512 + tid; i < (size_t)MT * D; i += (size_t)gridDim.x * 512) acc += a->out[i]; if (acc == 123.456f) ((float*)(a->ws + WS_MOD))[1] = acc; }
#endif
#endif
    { const CAS Args* a = get_args(); p0_mod(a, l3, tid); p0_prologue(a, l3, wave, freshv(lane), fresh(G)); }
#ifdef DUP_P0
    __syncthreads(); { const CAS Args* a = get_args(); p0_mod(a, l3, tid); p0_prologue(a, l3, wave, freshv(lane), fresh(G)); }
#endif
    GSYNC(); if (STOP_AFTER == 0) return;
#pragma nounroll
    for (int l0 = 0; l0 < DEPTH; ++l0) {
        int l = l0; asm volatile("" : "+s"(l));
        { const CAS Args* a = get_args(); unsigned char* ws = a->ws; float* out = a->out;
          const float* xp = l == 0 ? a->in[0] : out; const float* xs = l == 0 ? a->in[1] : out + (size_t)MP * D;
          norm_phase(xp, xs, a->in[6] + l * D, (const float*)(ws + WS_MOD) + (size_t)l * 6144, (bf16*)(ws + WS_XN), wave, freshv(lane), fresh(G));
#ifdef DUP_NORM
          norm_phase(xp, xs, a->in[6] + l * D, (const float*)(ws + WS_MOD) + (size_t)l * 6144, (bf16*)(ws + WS_XN), wave, freshv(lane), fresh(G));
#endif
        }
        GSYNC(); if (STOP_AFTER == 1) return;
        { const CAS Args* a = get_args(); unsigned char* ws = a->ws;
          pg8::Gemm g{(const bf16*)(ws + WS_XN), (const bf16*)(ws + WS_WIN) + (size_t)l * NINP * D, MT, NINP, D}; pg8::StaticOrder S; S.init(MT, NINP, fresh(G), fresh((int)blockIdx.x));
          pg8::EpiInProj E{(bf16*)(ws + WS_PROJ), (bf16*)(ws + WS_MIX), (bf16*)(ws + WS_KV)};
          pg8::gemm_phase<pg8::EpiInProj, pg8::StaticOrder, PG8_ALIGN, PG8_SP2>(l3, g, S, E, tid);
#ifdef DUP_GEMM
          __syncthreads(); pg8::gemm_phase<pg8::EpiInProj, pg8::StaticOrder, PG8_ALIGN, PG8_SP2>(l3, g, S, E, tid);
#endif
        }
        GSYNC(); if (STOP_AFTER == 2) return;
        { const CAS Args* a = get_args(); unsigned char* ws = a->ws;
          qk_prep_phase((bf16*)(ws + WS_MIX), (bf16*)(ws + WS_KV), a->in[20] + l * 64, a->in[21] + l * 64, wave, freshv(lane), fresh(G)); }
#ifndef NO_SCANA
        scan_phase<false>(get_args(), l3, l, wave, freshv(lane), fresh(G));
#endif
#ifdef DUP_SCANA
        scan_phase<false>(get_args(), l3, l, wave, freshv(lane), fresh(G));
#endif
        GSYNC(); if (STOP_AFTER == 3) return;
#ifndef NO_SCANB
        scanB_phase(get_args(), l3, wave, freshv(lane), fresh(G));
#endif
        __syncthreads();
        { const CAS Args* a = get_args(); attn_phase_dyn(a, (char*)lds, (unsigned*)(a->ws + WS_CTL) + 4096 + l * 1024, tid, fresh(wave) == 0 && LANE_() == 0); }
        GSYNC(); if (STOP_AFTER == 4) return;

#ifdef EXP_SLOAD
        probe_sload(get_args(), wave, freshv(lane), fresh(G));
#endif
#ifndef NO_SCANC
        scan_phase<true>(get_args(), l3, l, wave, freshv(lane), fresh(G));
#endif
#ifdef DUP_SCANC
        scan_phase<true>(get_args(), l3, l, wave, freshv(lane), fresh(G));
#endif
        GSYNC(); if (STOP_AFTER == 5) return;
#ifndef NO_POST
        post_phase(get_args(), l, wave, freshv(lane), fresh(G));
#endif
#ifdef DUP_POST
        post_phase(get_args(), l, wave, freshv(lane), fresh(G));
#endif
        GSYNC(); if (STOP_AFTER == 6) return;
#ifndef NO_P7
        { const CAS Args* a = get_args(); unsigned char* ws = a->ws; float* out = a->out;
          const float* xp = l == 0 ? a->in[0] : out; const float* xs = l == 0 ? a->in[1] : out + (size_t)MP * D;
          pg8::Gemm g{(const bf16*)(ws + WS_MIX), (const bf16*)(ws + WS_WOUT) + (size_t)l * D * D, MT, D, D}; pg8::StaticOrder S; S.init(MT, D, fresh(G), fresh((int)blockIdx.x));
          pg8::EpiResid E{xp, xs, out, (const float*)(ws + WS_MOD) + (size_t)l * 6144 + 2048};
          pg8::gemm_phase<pg8::EpiResid, pg8::StaticOrder, PG8_ALIGN, PG8_SP2>(l3, g, S, E, tid); }
#endif
        GSYNC(); if (STOP_AFTER == 7) return;
        { const CAS Args* a = get_args(); unsigned char* ws = a->ws; float* out = a->out;
          norm_phase(out, out + (size_t)MP * D, a->in[7] + l * D, (const float*)(ws + WS_MOD) + (size_t)l * 6144 + 3072, (bf16*)(ws + WS_XN), wave, freshv(lane), fresh(G)); }
        GSYNC(); if (STOP_AFTER == 8) return;
        { const CAS Args* a = get_args(); unsigned char* ws = a->ws;
          pg8::Gemm g{(const bf16*)(ws + WS_XN), (const bf16*)(ws + WS_WFFI) + (size_t)l * 2 * DFF * D, MT, 2 * DFF, D}; pg8::StaticOrder S; S.init(MT, 2 * DFF, fresh(G), fresh((int)blockIdx.x));
          pg8::EpiSwiGLU E{(bf16*)(ws + WS_ACT)};
          pg8::gemm_phase<pg8::EpiSwiGLU, pg8::StaticOrder, PG8_ALIGN, PG8_SP2>(l3, g, S, E, tid);
#ifdef DUP_GEMM
          __syncthreads(); pg8::gemm_phase<pg8::EpiSwiGLU, pg8::StaticOrder, PG8_ALIGN, PG8_SP2>(l3, g, S, E, tid);
#endif
        }
        GSYNC(); if (STOP_AFTER == 9) return;
        { const CAS Args* a = get_args(); unsigned char* ws = a->ws; float* out = a->out;
          pg8::Gemm g{(const bf16*)(ws + WS_ACT), (const bf16*)(ws + WS_WFFO) + (size_t)l * D * DFF, MT, D, DFF}; pg8::StaticOrder S; S.init(MT, D, fresh(G), fresh((int)blockIdx.x));
          pg8::EpiResid E{out, out + (size_t)MP * D, out, (const float*)(ws + WS_MOD) + (size_t)l * 6144 + 5120};
          pg8::gemm_phase<pg8::EpiResid, pg8::StaticOrder, PG8_ALIGN, PG8_SP2>(l3, g, S, E, tid); }
        if (l0 + 1 < DEPTH) GSYNC();
    }
}

extern "C" void kernel_launch(void* const* d_in, const int* in_sizes, int n_in, void* d_out, int out_size, void* d_ws, size_t ws_size, hipStream_t stream) {
    static int grid = 0;
    if (grid == 0) {
        if (n_in != 25 || ws_size < WS_END) { fprintf(stderr, "kernel_launch: unexpected n_in %d / ws %zu\n", n_in, ws_size); grid = -1; return; }
        int dev = 0, cus = 0, per_cu = 0;
        hipGetDevice(&dev); hipDeviceGetAttribute(&cus, hipDeviceAttributeMultiprocessorCount, dev);
        if (hipFuncSetAttribute((const void*)hymba_fwd, hipFuncAttributeMaxDynamicSharedMemorySize, LDS_BYTES) != hipSuccess) { fprintf(stderr, "kernel_launch: hipFuncSetAttribute failed\n"); grid = -1; return; }
        if (hipOccupancyMaxActiveBlocksPerMultiprocessor(&per_cu, (const void*)hymba_fwd, NWAVES * 64, LDS_BYTES) != hipSuccess || per_cu < 1) { fprintf(stderr, "kernel_launch: occupancy query says %d\n", per_cu); per_cu = 1; }
        (void)hipGetLastError();
        grid = cus * 1;
    }
    if (grid < 0) return;
    if (hipMemsetAsync((char*)d_ws + WS_CTL, 0, 32768, stream) != hipSuccess) { fprintf(stderr, "kernel_launch: memset failed\n"); return; }
    Args a{};
    for (int i = 0; i < 25; ++i) a.in[i] = (const float*)d_in[i];
    a.out = (float*)d_out; a.ws = (unsigned char*)d_ws;
    void* kargs[] = {&a};
    hipError_t e = hipLaunchCooperativeKernel((const void*)hymba_fwd, dim3(grid), dim3(NWAVES * 64), kargs, LDS_BYTES, stream);
    if (e != hipSuccess) fprintf(stderr, "cooperative launch failed: %s (grid %d)\n", hipGetErrorString(e), grid);
}
```

```cpp
#include <hip/hip_runtime.h>
#include <hip/hip_cooperative_groups.h>
#include <cstdio>
#include <cstdint>
namespace pg8 {
#define PG8_LAS __attribute__((address_space(3)))
typedef unsigned short bf16_t;
typedef short bf16x8 __attribute__((ext_vector_type(8)));
typedef float f32x4 __attribute__((ext_vector_type(4)));
typedef unsigned u32x4 __attribute__((ext_vector_type(4)));
constexpr int BM = 256, BK = 64, HALF = 128, HTB = HALF * BK * 2  , STAGE_BYTES = 8 * HTB, NXCD = 8, WGM = 8;

__host__ __device__ __forceinline__ int lds_byte(int r, int c) { const int st = (r >> 4) * 2 + (c >> 5), rr = r & 15, cc = c & 31, ob = rr * 64 + cc * 2; return st * 1024 + (ob ^ (((ob >> 9) & 1) << 5)); }
__host__ __device__ __forceinline__ void stage_rc(int b, int& R, int& C) { const int st = b / 1024, sb = b % 1024, swz = sb ^ (((sb >> 9) & 1) << 5); R = (st >> 1) * 16 + swz / 64; C = (st & 1) * 32 + (swz % 64) / 2; }
__host__ __device__ __forceinline__ int perm32(int rho) { const int n = rho >> 4, i = rho & 15; return 8 * (i >> 2) + 4 * n + (i & 3); }

struct Unit { int pm, pn; };
struct Gemm { const bf16_t* A; const bf16_t* Bt; int M, N, K; };

struct StaticOrder {
    int nM, nN, nwg, G, c;
    __host__ __device__ void init(int M, int N, int G_, int c_) { nM = M / BM; nN = N / BM; nwg = nM * nN; G = G_; c = c_; }
    __host__ __device__ bool next(int i, Unit& u) const {
        const int L = i * G + c; if (L >= nwg) return false;
        int wgid = (int)L; { const int q = nwg / NXCD, r = nwg % NXCD, xcd = wgid % NXCD, off = wgid / NXCD; wgid = (xcd < r ? xcd * (q + 1) : r * (q + 1) + (xcd - r) * q) + off; }
        const int nig = WGM * nN, gid = wgid / nig, fm = gid * WGM, gsz = (nM - fm) < WGM ? (nM - fm) : WGM;
        u.pm = fm + ((wgid % nig) % gsz); u.pn = (wgid % nig) / gsz; return true;
    }
    __device__ __forceinline__ void a_ready(const Unit&) const {}
    __device__ __forceinline__ void done(const Unit&) const {}
};

__device__ __forceinline__ unsigned cvt_pk_bf16(float lo, float hi) { unsigned r; asm volatile("v_cvt_pk_bf16_f32 %0, %1, %2" : "=v"(r) : "v"(lo), "v"(hi)); return r; }
struct EpiInProj {
    static constexpr bool PERM = true, AFTER_DRAIN = false;
    bf16_t* projR; bf16_t* mixin; bf16_t* kv;
    __device__ __forceinline__ void operator()(const f32x4 (&acc)[2][2][4][2], const Unit& u, int wr, int wc, int fr, int fq) const {
        const int pn = u.pn; bf16_t* base; int ldc, colt;
        if (pn < 6) { base = projR; ldc = 2048; colt = pn * 256; }
        else if (pn < 8) { base = mixin; ldc = 1024; colt = 512 + (pn - 6) * 256; }
        else if (pn == 8) { base = kv; ldc = 256; colt = 0; }
        else { base = projR; ldc = 2048; colt = 1536 + (pn - 9) * 256; }
        const int row0 = u.pm * BM + wr * 64 + fr, col0 = colt + wc * 32 + 8 * fq;
#pragma unroll
        for (int ai = 0; ai < 2; ++ai)
#pragma unroll
            for (int m = 0; m < 4; ++m) { bf16_t* rowp = base + (size_t)(row0 + ai * HALF + m * 16) * ldc + col0;
#pragma unroll
                for (int bj = 0; bj < 2; ++bj) { const f32x4 v0 = acc[ai][bj][m][0], v1 = acc[ai][bj][m][1];
                    u32x4 w; w.x = cvt_pk_bf16(v0[0], v0[1]); w.y = cvt_pk_bf16(v0[2], v0[3]); w.z = cvt_pk_bf16(v1[0], v1[1]); w.w = cvt_pk_bf16(v1[2], v1[3]);
                    *(u32x4*)(rowp + bj * HALF) = w; } }
    }
};
struct EpiResid {
    static constexpr bool PERM = false, AFTER_DRAIN = false;
    const float* xp; const float* xs; float* out; const float* gate;
    __device__ __forceinline__ void operator()(const f32x4 (&acc)[2][2][4][2], const Unit& u, int wr, int wc, int fr, int fq) const {
        const int seq = u.pm < 64 ? 0 : 1 + ((u.pm - 64) >> 4);
        const float* gp = gate + (size_t)seq * 12288;
        const int col0 = u.pn * BM + wc * 32 + 4 * fq;
        f32x4 gv[2][2];
#pragma unroll
        for (int bj = 0; bj < 2; ++bj)
#pragma unroll
            for (int n = 0; n < 2; ++n) gv[bj][n] = *(const f32x4*)(gp + col0 + bj * HALF + n * 16);

#ifdef EXP_XOUT
        const float* xb = out;
#else
        const float* xb = u.pm < 64 ? xp : xs - (size_t)16384 * 1024;
#endif

#pragma unroll
        for (int ai = 0; ai < 2; ++ai) {
            f32x4 bsv[4][2][2];
#pragma unroll
            for (int m = 0; m < 4; ++m) { const size_t off = (size_t)(u.pm * BM + ai * HALF + wr * 64 + m * 16 + fr) * 1024 + col0;
#pragma unroll
                for (int bj = 0; bj < 2; ++bj)
#pragma unroll
                    for (int n = 0; n < 2; ++n) bsv[m][bj][n] = *(const f32x4*)(xb + off + bj * HALF + n * 16); }
            asm volatile("" ::: "memory");
#pragma unroll
            for (int m = 0; m < 4; ++m) { const size_t off = (size_t)(u.pm * BM + ai * HALF + wr * 64 + m * 16 + fr) * 1024 + col0;
#pragma unroll
                for (int bj = 0; bj < 2; ++bj)
#pragma unroll
                    for (int n = 0; n < 2; ++n) *(f32x4*)(out + off + bj * HALF + n * 16) = bsv[m][bj][n] + gv[bj][n] * acc[ai][bj][m][n]; }
            asm volatile("" ::: "memory");
        }
    }
};
struct EpiSwiGLU {
    static constexpr bool PERM = true, AFTER_DRAIN = false;
    bf16_t* act;
    __device__ __forceinline__ void operator()(const f32x4 (&acc)[2][2][4][2], const Unit& u, int wr, int wc, int fr, int fq) const {
        const int row0 = u.pm * BM + wr * 64 + fr, col0 = u.pn * 128 + wc * 32 + 8 * fq;
#pragma unroll
        for (int ai = 0; ai < 2; ++ai)
#pragma unroll
            for (int m = 0; m < 4; ++m) { bf16_t* rowp = act + (size_t)(row0 + ai * HALF + m * 16) * 2816 + col0;
                float o[8];
#pragma unroll
                for (int n = 0; n < 2; ++n)
#pragma unroll
                    for (int i = 0; i < 4; ++i) { const float g = acc[ai][0][m][n][i], up = acc[ai][1][m][n][i];
                        o[n * 4 + i] = g * __builtin_amdgcn_rcpf(1.0f + __builtin_amdgcn_exp2f(-1.4426950408889634f * g)) * up; }
                u32x4 w; w.x = cvt_pk_bf16(o[0], o[1]); w.y = cvt_pk_bf16(o[2], o[3]); w.z = cvt_pk_bf16(o[4], o[5]); w.w = cvt_pk_bf16(o[6], o[7]);
                *(u32x4*)rowp = w; }
    }
};
template <class Epi, class Sched, bool ALIGN_EPI = false, bool SP2 = false>
__device__ __forceinline__ void gemm_phase(PG8_LAS unsigned char* lds, const Gemm g, const Sched& S, const Epi& E, int tid_in) {
    int tid_ = tid_in; asm volatile("" : "+v"(tid_)); const int tid = tid_, wid = __builtin_amdgcn_readfirstlane(tid >> 6), lane = tid & 63, wr = wid >> 2, wc = wid & 3, fr = lane & 15, fq = lane >> 4;
    const int K = g.K, nt = K / BK;
    unsigned voffA[2], voffB[2];
#pragma unroll
    for (int i = 0; i < 2; ++i) { int R, C; stage_rc(tid * 16 + i * 8192, R, C); const int Rb = Epi::PERM ? ((R & ~31) + perm32(R & 31)) : R;
        voffA[i] = (unsigned)(R * K + C) * 2u; voffB[i] = (unsigned)(Rb * K + C) * 2u; }
    const size_t kstep = (size_t)(BK * 2);
    const size_t hstep = (size_t)HALF * K * 2;
    const size_t tstep = 2 * hstep;
    const unsigned ldsw = (unsigned)wid * 1024u;
    const int aoff = lds_byte(wr * 64 + fr, fq * 8), boff = lds_byte(wc * 32 + fr, fq * 8);
#define PG8_SA(b, h) (((b) * 2 + (h)) * HTB)
#define PG8_SB(b, h) ((4 + (b) * 2 + (h)) * HTB)
#define PG8_STAGE(bufoff, gbase, voff) do { _Pragma("unroll") for (int _i = 0; _i < 2; ++_i) \
        __builtin_amdgcn_global_load_lds((const unsigned*)((const char*)(gbase) + (voff)[_i]), (PG8_LAS unsigned*)(lds + (bufoff) + ldsw + _i * 8192), 16, 0, 0); } while (0)
#define PG8_LDA(dst, b, h) do { _Pragma("unroll") for (int m = 0; m < 4; ++m) _Pragma("unroll") for (int k = 0; k < 2; ++k) dst[m][k] = *(const PG8_LAS bf16x8*)(lds + PG8_SA(b, h) + aoff + m * 2048 + k * 1024); } while (0)
#define PG8_LDB(dst, b, h) do { _Pragma("unroll") for (int n = 0; n < 2; ++n) _Pragma("unroll") for (int k = 0; k < 2; ++k) dst[n][k] = *(const PG8_LAS bf16x8*)(lds + PG8_SB(b, h) + boff + n * 2048 + k * 1024); } while (0)
#define PG8_MMA(ai, bj, At, Bt) do { __builtin_amdgcn_s_setprio(1); _Pragma("unroll") for (int m = 0; m < 4; ++m) _Pragma("unroll") for (int n = 0; n < 2; ++n) _Pragma("unroll") for (int k = 0; k < 2; ++k) \
        acc[ai][bj][m][n] = __builtin_amdgcn_mfma_f32_16x16x32_bf16(Bt[n][k], At[m][k], acc[ai][bj][m][n], 0, 0, 0); __builtin_amdgcn_s_setprio(0); } while (0)
#define PG8_WAIT_V(n) asm volatile("s_waitcnt vmcnt(" #n ")" ::: "memory")
#define PG8_WAIT_L(n) asm volatile("s_waitcnt lgkmcnt(" #n ")" ::: "memory")
#define PG8_BAR __builtin_amdgcn_s_barrier()
#define PG8_SCHED __builtin_amdgcn_sched_barrier(0)
    Unit cur, nxt; int ui = 0;
    if (!S.next(0, cur)) return;
    f32x4 acc[2][2][4][2];
#pragma unroll
    for (int a = 0; a < 2; ++a)
#pragma unroll
        for (int b = 0; b < 2; ++b)
#pragma unroll
            for (int m = 0; m < 4; ++m)
#pragma unroll
                for (int n = 0; n < 2; ++n) acc[a][b][m][n] = (f32x4){0.f, 0.f, 0.f, 0.f};
    bf16x8 At[4][2], B0[2][2], B1[2][2];
    const char* cA = (const char*)g.A + (size_t)cur.pm * tstep; const char* cB = (const char*)g.Bt + (size_t)cur.pn * tstep;
    S.a_ready(cur);
    if constexpr (SP2) {
        PG8_STAGE(PG8_SB(0, 0), cB, voffB); PG8_STAGE(PG8_SB(0, 1), cB + hstep, voffB); PG8_STAGE(PG8_SA(0, 0), cA, voffA); PG8_STAGE(PG8_SA(0, 1), cA + hstep, voffA);
        if (wr == 1) PG8_BAR;
        PG8_WAIT_V(2); PG8_BAR;
        PG8_STAGE(PG8_SB(1, 0), cB + kstep, voffB); PG8_STAGE(PG8_SA(1, 0), cA + kstep, voffA); PG8_STAGE(PG8_SB(1, 1), cB + hstep + kstep, voffB);
        PG8_WAIT_V(6); PG8_BAR;
    } else {
        PG8_STAGE(PG8_SB(0, 0), cB, voffB); PG8_STAGE(PG8_SA(0, 0), cA, voffA); PG8_STAGE(PG8_SB(0, 1), cB + hstep, voffB); PG8_STAGE(PG8_SA(0, 1), cA + hstep, voffA);
        if (wr == 1) PG8_BAR;
        PG8_WAIT_V(4); PG8_BAR;
        PG8_STAGE(PG8_SB(1, 0), cB + kstep, voffB); PG8_STAGE(PG8_SA(1, 0), cA + kstep, voffA); PG8_STAGE(PG8_SB(1, 1), cB + hstep + kstep, voffB);
        PG8_WAIT_V(6); PG8_BAR;
    }
    for (;;) {
        const bool has_next = S.next(ui + 1, nxt);
        const char* nA = has_next ? (const char*)g.A + (size_t)nxt.pm * tstep : cA; const char* nB = has_next ? (const char*)g.Bt + (size_t)nxt.pn * tstep : cB;
        for (int t = 0; t < nt; t += 2) {
            const bool last = (t == nt - 2);
            const char* a1 = cA + (size_t)(t + 1) * kstep;
            const char* a2 = last ? nA : cA + (size_t)(t + 2) * kstep; const char* b2 = last ? nB : cB + (size_t)(t + 2) * kstep;
            const char* a3 = a2 + kstep; const char* b3 = b2 + kstep;
            if (last && has_next) S.a_ready(nxt);
            if constexpr (SP2) {
            PG8_LDB(B0, 0, 0); PG8_LDB(B1, 0, 1); PG8_SCHED; PG8_LDA(At, 0, 0); PG8_STAGE(PG8_SA(1, 1), a1 + hstep, voffA);
            PG8_WAIT_V(8); PG8_WAIT_L(0); PG8_BAR; PG8_MMA(0, 0, At, B0); PG8_MMA(0, 1, At, B1); PG8_BAR; PG8_SCHED;
            PG8_LDA(At, 0, 1); PG8_STAGE(PG8_SB(0, 0), b2, voffB); PG8_STAGE(PG8_SB(0, 1), b2 + hstep, voffB); PG8_STAGE(PG8_SA(0, 0), a2, voffA);
            PG8_WAIT_V(8); PG8_WAIT_L(0); PG8_BAR; PG8_MMA(1, 0, At, B0); PG8_MMA(1, 1, At, B1); PG8_BAR; PG8_SCHED;
            PG8_LDB(B0, 1, 0); PG8_LDB(B1, 1, 1); PG8_SCHED; PG8_LDA(At, 1, 0); PG8_STAGE(PG8_SA(0, 1), a2 + hstep, voffA);
            PG8_WAIT_V(8); PG8_WAIT_L(0); PG8_BAR; PG8_MMA(0, 0, At, B0); PG8_MMA(0, 1, At, B1); PG8_BAR; PG8_SCHED;
            PG8_LDA(At, 1, 1); PG8_STAGE(PG8_SB(1, 0), b3, voffB); PG8_STAGE(PG8_SB(1, 1), b3 + hstep, voffB); PG8_STAGE(PG8_SA(1, 0), a3, voffA);
            PG8_WAIT_V(8); PG8_WAIT_L(0); PG8_BAR; PG8_MMA(1, 0, At, B0); PG8_MMA(1, 1, At, B1); PG8_BAR; PG8_SCHED;
            } else {
            PG8_LDB(B0, 0, 0); PG8_SCHED; PG8_LDA(At, 0, 0); PG8_STAGE(PG8_SA(1, 1), a1 + hstep, voffA);
            PG8_WAIT_L(8); PG8_BAR; PG8_WAIT_L(0); PG8_MMA(0, 0, At, B0); PG8_BAR; PG8_SCHED;
            PG8_LDB(B1, 0, 1); PG8_STAGE(PG8_SB(0, 0), b2, voffB);
            PG8_BAR; PG8_WAIT_L(0); PG8_MMA(0, 1, At, B1); PG8_BAR;
            PG8_LDA(At, 0, 1); PG8_STAGE(PG8_SA(0, 0), a2, voffA);
            PG8_BAR; PG8_WAIT_L(0); PG8_MMA(1, 0, At, B0); PG8_BAR; PG8_SCHED;
            PG8_STAGE(PG8_SB(0, 1), b2 + hstep, voffB);
            PG8_WAIT_V(6); PG8_BAR; PG8_MMA(1, 1, At, B1); PG8_BAR;
            PG8_LDB(B0, 1, 0); PG8_SCHED; PG8_LDA(At, 1, 0); PG8_STAGE(PG8_SA(0, 1), a2 + hstep, voffA);
            PG8_WAIT_L(8); PG8_BAR; PG8_WAIT_L(0); PG8_MMA(0, 0, At, B0); PG8_BAR; PG8_SCHED;
            PG8_LDB(B1, 1, 1); PG8_STAGE(PG8_SB(1, 0), b3, voffB);
            PG8_BAR; PG8_WAIT_L(0); PG8_MMA(0, 1, At, B1); PG8_BAR;
            PG8_LDA(At, 1, 1); PG8_STAGE(PG8_SA(1, 0), a3, voffA);
            PG8_BAR; PG8_WAIT_L(0); PG8_MMA(1, 0, At, B0); PG8_BAR; PG8_SCHED;
            PG8_STAGE(PG8_SB(1, 1), b3 + hstep, voffB);
            PG8_WAIT_V(6); PG8_BAR; PG8_MMA(1, 1, At, B1); PG8_BAR;
            }
        }
        if constexpr (ALIGN_EPI) { if (wr == 0) PG8_BAR; }
        if constexpr (!Epi::AFTER_DRAIN) { E(acc, cur, wr, wc, fr, fq); S.done(cur); }
        if (!has_next) break;
#pragma unroll
        for (int a = 0; a < 2; ++a)
#pragma unroll
            for (int b = 0; b < 2; ++b)
#pragma unroll
                for (int m = 0; m < 4; ++m)
#pragma unroll
                    for (int n = 0; n < 2; ++n) acc[a][b][m][n] = (f32x4){0.f, 0.f, 0.f, 0.f};
        cur = nxt; cA = nA; cB = nB; ++ui;
        if constexpr (ALIGN_EPI) { if (wr == 1) PG8_BAR; }
    }
    PG8_WAIT_V(0);
    if constexpr (!ALIGN_EPI) { if (wr == 0) PG8_BAR; }
    PG8_BAR;
    if constexpr (Epi::AFTER_DRAIN) { E.fused(acc, cur, wr, wc, fr, fq, lds, wid, lane); S.done(cur); }
#undef PG8_SA
#undef PG8_SB
#undef PG8_STAGE
#undef PG8_LDA
#undef PG8_LDB
#undef PG8_MMA
#undef PG8_WAIT_V
#undef PG8_WAIT_L
#undef PG8_BAR
#undef PG8_SCHED
}
}

#ifndef PG8_SP2
#define PG8_SP2 true
#endif
#ifndef PG8_ALIGN
#define PG8_ALIGN true
#endif
#include <hip/hip_bf16.h>
#include <cmath>
namespace attn_body {
using bf16=__hip_bfloat16;
using bf16x8=__attribute__((ext_vector_type(8)))short;
using s16x4=__attribute__((ext_vector_type(4)))short;
using f32x16=__attribute__((ext_vector_type(16)))float;
using u32x4=__attribute__((ext_vector_type(4)))unsigned;
constexpr int D=64,QP=1024,KVP=256;
constexpr int NW=8,QBLK=32,QB=QBLK*NW,KVBLK=64;
constexpr int ATTN_UNIT_ROWS=QB;
__device__ __forceinline__ int crow(int r,int hi){return (r&3)+8*(r>>2)+4*hi;}
#define SBAR() __builtin_amdgcn_sched_barrier(0)
__device__ __forceinline__ void cmask(f32x16&p0,f32x16&p1,int jb,int qrel,int hi){
  const float NEG=-INFINITY; int kb=64*jb+4*hi;
  #pragma unroll
  for(int r=0;r<16;++r){int kv=kb+(r&3)+8*(r>>2); if(kv>qrel)p0[r]=NEG; if(kv+32>qrel)p1[r]=NEG;}
}

constexpr int NSLOT=3, SLOTB=8192;
constexpr int LDS_K=0, LDS_V=NSLOT*SLOTB, LDS_WS=2*NSLOT*SLOTB, LDS_OST=LDS_WS+NW*64*4, LDS_BYTES=LDS_OST+NW*4096;
constexpr float C2=0.125f*1.4426950408889634f;
__device__ __forceinline__ void glds16(const void*gsrc,unsigned lds_dst){unsigned keep;
  asm volatile("s_mov_b32 %0, m0\n\ts_mov_b32 m0, %2\n\ts_nop 0\n\tglobal_load_lds_dwordx4 %1, off\n\ts_mov_b32 m0, %0":"=&s"(keep):"v"(gsrc),"s"(lds_dst):"memory");}
__device__ __forceinline__ float max3f(float a,float b,float c){float r;asm("v_max3_f32 %0, %1, %2, %3":"=v"(r):"v"(a),"v"(b),"v"(c));return r;}
__device__ __forceinline__ float max2f(float a,float b){float r;asm("v_max_f32_e32 %0, %1, %2":"=v"(r):"v"(a),"v"(b));return r;}
__device__ __forceinline__ float fadd_s(float a,float b){float r;asm("v_add_f32_e32 %0, %1, %2":"=v"(r):"v"(a),"v"(b));return r;}
__device__ __forceinline__ float fsub_s(float a,float b){float r;asm("v_sub_f32_e32 %0, %1, %2":"=v"(r):"v"(a),"v"(b));return r;}
typedef float f32x2_t __attribute__((ext_vector_type(2))); typedef __bf16 bf16x2_t __attribute__((ext_vector_type(2)));
__device__ __forceinline__ unsigned cvtpk_s(float lo,float hi){f32x2_t v={lo,hi};bf16x2_t b=__builtin_convertvector(v,bf16x2_t);return __builtin_bit_cast(unsigned,b);}
#define WAIT_BAR(N) asm volatile("s_waitcnt vmcnt(" #N ") lgkmcnt(0)\n\ts_barrier":::"memory")

__device__ __forceinline__ void qkt(f32x16&p0,f32x16&p1,const char*Kslot,const bf16x8*qr,const f32x16&negm,int r32,int hi){
  const char*kb=Kslot+hi*1024+r32*16;
  #pragma unroll
  for(int d0=0;d0<4;++d0){
    const bf16x8 b0=*reinterpret_cast<const bf16x8*>(kb+d0*2048);
    const bf16x8 b1=*reinterpret_cast<const bf16x8*>(kb+d0*2048+512);
    if(d0==0){p0=__builtin_amdgcn_mfma_f32_32x32x16_bf16(b0,qr[0],negm,0,0,0);p1=__builtin_amdgcn_mfma_f32_32x32x16_bf16(b1,qr[0],negm,0,0,0);}
    else{p0=__builtin_amdgcn_mfma_f32_32x32x16_bf16(b0,qr[d0],p0,0,0,0);p1=__builtin_amdgcn_mfma_f32_32x32x16_bf16(b1,qr[d0],p1,0,0,0);}}
}
typedef __attribute__((address_space(3))) const char* lds_cptr;
typedef short v4i16_t __attribute__((ext_vector_type(4)));
__device__ __forceinline__ void kload8(bf16x8*kf,lds_cptr kp){
  kf[0]=*(const __attribute__((address_space(3))) bf16x8*)(kp);      kf[1]=*(const __attribute__((address_space(3))) bf16x8*)(kp+512);
  kf[2]=*(const __attribute__((address_space(3))) bf16x8*)(kp+2048); kf[3]=*(const __attribute__((address_space(3))) bf16x8*)(kp+2560);
  kf[4]=*(const __attribute__((address_space(3))) bf16x8*)(kp+4096); kf[5]=*(const __attribute__((address_space(3))) bf16x8*)(kp+4608);
  kf[6]=*(const __attribute__((address_space(3))) bf16x8*)(kp+6144); kf[7]=*(const __attribute__((address_space(3))) bf16x8*)(kp+6656);
}
__device__ __forceinline__ void kload2(bf16x8*kf,lds_cptr kp,int j){ kf[2*j]=*(const __attribute__((address_space(3))) bf16x8*)(kp+j*2048); kf[2*j+1]=*(const __attribute__((address_space(3))) bf16x8*)(kp+j*2048+512); }
__device__ __forceinline__ s16x4 vtr(lds_cptr p){ return __builtin_bit_cast(s16x4,__builtin_amdgcn_ds_read_tr16_b64_v4i16((__attribute__((address_space(3))) v4i16_t*)p)); }
__device__ __forceinline__ float rowmax(const f32x16&p0,const f32x16&p1){
  float a=max3f(p0[0],p0[1],p1[0]),b=max3f(p0[2],p0[3],p1[1]);a=max3f(a,p1[2],p1[3]);
  #pragma unroll
  for(int r=4;r<16;r+=4){a=max3f(a,p0[r],p0[r+1]);b=max3f(b,p0[r+2],p0[r+3]);a=max3f(a,p1[r],p1[r+1]);b=max3f(b,p1[r+2],p1[r+3]);}
  const float m=max2f(a,b);
  auto rr=__builtin_amdgcn_permlane32_swap(__float_as_uint(m),__float_as_uint(m),false,false);
  return max2f(__uint_as_float(rr[0]),__uint_as_float(rr[1]));
}
__device__ __forceinline__ void pv(f32x16*o,int vb,bf16x8 pa0,bf16x8 pa1,bf16x8 pa2,bf16x8 pa3){
  #pragma unroll
  for(int d0=0;d0<2;++d0){s16x4 lo[4],hi[4];
    #pragma unroll
    for(int ks=0;ks<4;++ks){
      asm volatile("ds_read_b64_tr_b16 %0,%1 offset:%c2":"=&v"(lo[ks]):"v"(vb),"i"(d0*4096+ks*1024):"memory");
      asm volatile("ds_read_b64_tr_b16 %0,%1 offset:%c2":"=&v"(hi[ks]):"v"(vb),"i"(d0*4096+ks*1024+512):"memory");}
    asm volatile("s_waitcnt lgkmcnt(0)":::"memory");SBAR();
    #define PK(k) (bf16x8){lo[k][0],lo[k][1],lo[k][2],lo[k][3],hi[k][0],hi[k][1],hi[k][2],hi[k][3]}
    o[d0]=__builtin_amdgcn_mfma_f32_32x32x16_bf16(pa0,PK(0),o[d0],0,0,0);
    o[d0]=__builtin_amdgcn_mfma_f32_32x32x16_bf16(pa1,PK(1),o[d0],0,0,0);
    o[d0]=__builtin_amdgcn_mfma_f32_32x32x16_bf16(pa2,PK(2),o[d0],0,0,0);
    o[d0]=__builtin_amdgcn_mfma_f32_32x32x16_bf16(pa3,PK(3),o[d0],0,0,0);
    #undef PK
  }
}

#ifndef ATTN_STORE16
#define ATTN_STORE16(p,v) (*(u32x4*)(p)=(v))
#endif
template<int THRL> __device__ __forceinline__ void attn_unit(long rowbase,int T,int h,int qb,const bf16*Q,const bf16*K,const bf16*V,bf16*O,char*shm,int tid_in){
  int tid_=tid_in; asm volatile("":"+v"(tid_)); const int tid=tid_,lane=tid&63,r32=lane&31,hi=lane>>5; const int wid=__builtin_amdgcn_readfirstlane(tid>>6);
  const int q0=qb*QB;
  const bf16*Qw=Q+(rowbase+q0+wid*QBLK)*QP+h*D;
  const bf16*Kh=K+rowbase*KVP+(h>>2)*D,*Vh=V+rowbase*KVP+(h>>2)*D;
  const unsigned lds0=(unsigned)(uintptr_t)shm;
  float*wsf=(float*)(shm+LDS_WS)+wid*64;
  const bf16*ksrc=Kh+(long)lane*KVP+wid*8;
  const bf16*vsrc=Vh+(long)(16*(wid&3)+(lane>>2))*KVP+(wid>>2)*32+(lane&3)*8;
  const unsigned kdst=lds0+LDS_K+wid*1024, vdst=lds0+LDS_V+wid*1024;
  #define DMA_K(t,slot) glds16(ksrc+(long)(t)*KVBLK*KVP,(unsigned)__builtin_amdgcn_readfirstlane(kdst+(slot)))
  #define DMA_V(t,slot) glds16(vsrc+(long)(t)*KVBLK*KVP,(unsigned)__builtin_amdgcn_readfirstlane(vdst+(slot)))
  const int vb0=(int)(lds0+LDS_V)+((lane>>4)&1)*32+(lane&3)*8+(4*hi+((lane&15)>>2))*64;
  const char*Kbase=shm+LDS_K; bf16x8 kf[8];
  const lds_cptr shm3=(lds_cptr)shm; const lds_cptr kp0=shm3+LDS_K+hi*1024+r32*16; const lds_cptr vp0=shm3+LDS_V+((lane>>4)&1)*32+(lane&3)*8+(4*hi+((lane&15)>>2))*64;
  const int NT=T/KVBLK;
  DMA_K(0,0);DMA_V(0,0);DMA_K(1,SLOTB);
  bf16x8 qr[4];
  #pragma unroll
  for(int d0=0;d0<4;++d0)qr[d0]=*reinterpret_cast<const bf16x8*>(&Qw[(long)r32*QP+d0*16+hi*8]);
  float mhat=0.f,l_reg=0.f;f32x16 o[2];o[0]=f32x16{};o[1]=f32x16{};f32x16 negm=f32x16{};asm volatile("":"+v"(negm));

  #define CMASK(P0,P1,t) do{}while(0)
  bool resc=false;
  #define START(P0,P1) do{ const float rm=rowmax(P0,P1); resc=false; \
    { const float dl=rm; mhat=fadd_s(mhat,dl); \
      _Pragma("unroll") for(int r=0;r<16;++r){P0[r]=fsub_s(P0[r],dl);P1[r]=fsub_s(P1[r],dl);} \
      _Pragma("unroll") for(int r=0;r<16;++r)negm[r]=-mhat; asm volatile("":"+v"(negm)); } \
    _Pragma("unroll") for(int r=0;r<16;++r)P0[r]=__builtin_amdgcn_exp2f(P0[r]); }while(0)
  #define RESC() do{ if(resc){ asm volatile("s_waitcnt lgkmcnt(0)":::"memory"); \
      _Pragma("unroll") for(int d_=0;d_<2;++d_) _Pragma("unroll") for(int r=0;r<16;++r)o[d_][r]*=wsf[crow(r,hi)]; } }while(0)
  f32x16 pA0,pA1,pB0,pB1;
  int sl_prev=0,sl_cur=0,sl_next=SLOTB;
  #define ROT() do{sl_prev=sl_cur;sl_cur=sl_next;sl_next=(sl_next==(NSLOT-1)*SLOTB)?0:sl_next+SLOTB;}while(0)
  DMA_K(2,2*SLOTB);
  WAIT_BAR(3);
  qkt(pA0,pA1,Kbase,qr,negm,r32,hi);asm volatile("s_nop 15\n\ts_nop 7":"+v"(pA0),"+v"(pA1));CMASK(pA0,pA1,0);
  START(pA0,pA1);
  _Pragma("unroll") for(int r=0;r<16;++r)pA1[r]=__builtin_amdgcn_exp2f(pA1[r]);
  WAIT_BAR(0);
  DMA_K(3,0);DMA_V(1,SLOTB);
  ROT();
  kload8(kf,kp0+sl_cur);
  WAIT_BAR(2);
  s16x4 vlo[8],vhi[8]; u32x4 pw0,pw1,pw2,pw3;
  #define PKW(P,B) cvtpk_s(P[B],P[B+1])
  #define PAF(k) __builtin_bit_cast(bf16x8,pw##k)
  #define VFR(i) (bf16x8){vlo[i][0],vlo[i][1],vlo[i][2],vlo[i][3],vhi[i][0],vhi[i][1],vhi[i][2],vhi[i][3]}
  #define PIN(x) asm volatile("":"+v"(x))
  #define MX3(a,b,c) __builtin_fmaxf(__builtin_fmaxf((a),(b)),(c))
  #define GAPA(MF,A0,A1,A2,A3,W0,W1,PW) do{ MF; sacc+=A0; sacc+=A1; sacc+=A2; sacc+=A3; PIN(sacc); W0; W1; PIN(PW); SBAR(); }while(0)
  #define EX(v) __builtin_amdgcn_exp2f(v)
  #define GAPB(MF,X,B) do{ MF; X[B]=EX(X[B]); X[B+1]=EX(X[B+1]); X[B+2]=EX(X[B+2]); X[B+3]=EX(X[B+3]); PIN(X); SBAR(); }while(0)
  #define VRD(i) do{ vlo[i]=vtr(vp_+(((i)>>2)*4096+((i)&3)*1024)); vhi[i]=vtr(vp_+(((i)>>2)*4096+((i)&3)*1024+512)); }while(0)
  #define KRD(G,j) do{ if(G){ kload2(kf,kp0+sl_next,j); SBAR(); } }while(0)
  #define STEP(C0,C1,P0,P1,t,GK,GV,GL) do{ SBAR(); \
    const lds_cptr vp_=vp0+sl_prev; \
    VRD(0); SBAR(); float sacc=(P0[0]+P0[1]); \
    GAPA(C0=__builtin_amdgcn_mfma_f32_32x32x16_bf16(kf[0],qr[0],negm,0,0,0), P0[2],P0[3],P0[4],P0[5],     pw0[0]=PKW(P0,0), pw0[1]=PKW(P0,2), pw0); \
    VRD(4); SBAR(); GAPA(C1=__builtin_amdgcn_mfma_f32_32x32x16_bf16(kf[1],qr[0],negm,0,0,0), P0[6],P0[7],P0[8],P0[9],     pw0[2]=PKW(P0,4), pw0[3]=PKW(P0,6), pw0); \
    VRD(1); SBAR(); GAPA(C0=__builtin_amdgcn_mfma_f32_32x32x16_bf16(kf[2],qr[1],C0,0,0,0),   P0[10],P0[11],P0[12],P0[13], pw1[0]=PKW(P0,8), pw1[1]=PKW(P0,10), pw1); \
    VRD(5); SBAR(); GAPA(C1=__builtin_amdgcn_mfma_f32_32x32x16_bf16(kf[3],qr[1],C1,0,0,0),   P0[14],P0[15],P1[0],P1[1],   pw1[2]=PKW(P0,12),pw1[3]=PKW(P0,14), pw1); \
    VRD(2); SBAR(); GAPA(C0=__builtin_amdgcn_mfma_f32_32x32x16_bf16(kf[4],qr[2],C0,0,0,0),   P1[2],P1[3],P1[4],P1[5],     pw2[0]=PKW(P1,0), pw2[1]=PKW(P1,2), pw2); \
    VRD(6); SBAR(); GAPA(C1=__builtin_amdgcn_mfma_f32_32x32x16_bf16(kf[5],qr[2],C1,0,0,0),   P1[6],P1[7],P1[8],P1[9],     pw2[2]=PKW(P1,4), pw2[3]=PKW(P1,6), pw2); \
    VRD(3); SBAR(); GAPA(C0=__builtin_amdgcn_mfma_f32_32x32x16_bf16(kf[6],qr[3],C0,0,0,0),   P1[10],P1[11],P1[12],P1[13], pw3[0]=PKW(P1,8), pw3[1]=PKW(P1,10), pw3); \
    VRD(7); SBAR(); GAPA(C1=__builtin_amdgcn_mfma_f32_32x32x16_bf16(kf[7],qr[3],C1,0,0,0),   P1[14],P1[15],0.f,0.f,       pw3[2]=PKW(P1,12),pw3[3]=PKW(P1,14), pw3); \
    l_reg+=sacc; \
    if(GK){DMA_K((t)+3,sl_cur);} if(GV){DMA_V((t)+1,sl_next);} \
    CMASK(C0,C1,t); \
    { float a=MX3(C0[0],C0[1],C1[0]),b=MX3(C0[2],C0[3],C1[1]); a=MX3(a,C1[2],C1[3]); \
      _Pragma("unroll") for(int r=4;r<16;r+=4){a=MX3(a,C0[r],C0[r+1]);b=MX3(b,C0[r+2],C0[r+3]);a=MX3(a,C1[r],C1[r+1]);b=MX3(b,C1[r+2],C1[r+3]);} \
      float rm=__builtin_fmaxf(a,b); { auto rr=__builtin_amdgcn_permlane32_swap(__float_as_uint(rm),__float_as_uint(rm),false,false); rm=__builtin_fmaxf(__uint_as_float(rr[0]),__uint_as_float(rr[1])); } \
      resc=false; \
      if(__builtin_expect(__any(rm>(float)THRL),0)){ const float dl=__builtin_fmaxf(rm,0.f); mhat+=dl; \
        _Pragma("unroll") for(int r=0;r<16;++r){C0[r]-=dl;C1[r]-=dl;} \
        _Pragma("unroll") for(int r=0;r<16;++r)negm[r]=-mhat; asm volatile("":"+v"(negm)); \
        const float f=__builtin_amdgcn_exp2f(-dl); l_reg*=f; if(hi==0)wsf[r32]=f; resc=true; } } \
    SBAR(); \
    GAPB(o[0]=__builtin_amdgcn_mfma_f32_32x32x16_bf16(PAF(0),VFR(0),o[0],0,0,0), C0,0); \
    GAPB(o[1]=__builtin_amdgcn_mfma_f32_32x32x16_bf16(PAF(0),VFR(4),o[1],0,0,0), C0,4); \
    KRD(GL,0); GAPB(o[0]=__builtin_amdgcn_mfma_f32_32x32x16_bf16(PAF(1),VFR(1),o[0],0,0,0), C0,8); \
    KRD(GL,1); GAPB(o[1]=__builtin_amdgcn_mfma_f32_32x32x16_bf16(PAF(1),VFR(5),o[1],0,0,0), C0,12); \
    KRD(GL,2); GAPB(o[0]=__builtin_amdgcn_mfma_f32_32x32x16_bf16(PAF(2),VFR(2),o[0],0,0,0), C1,0); \
    KRD(GL,3); GAPB(o[1]=__builtin_amdgcn_mfma_f32_32x32x16_bf16(PAF(2),VFR(6),o[1],0,0,0), C1,4); \
    GAPB(o[0]=__builtin_amdgcn_mfma_f32_32x32x16_bf16(PAF(3),VFR(3),o[0],0,0,0), C1,8); \
    GAPB(o[1]=__builtin_amdgcn_mfma_f32_32x32x16_bf16(PAF(3),VFR(7),o[1],0,0,0), C1,12); \
    }while(0)
  int t=1;
  #undef CMASK
  #define CMASK(P0,P1,t) do{}while(0)
  for(;t+5<NT;t+=2){
    STEP(pB0,pB1,pA0,pA1,t,true,true,true);     WAIT_BAR(2); RESC(); ROT();
    STEP(pA0,pA1,pB0,pB1,t+1,true,true,true);   WAIT_BAR(2); RESC(); ROT();
  }
  #undef CMASK
  #define CMASK(P0,P1,t) do{}while(0)
  #define ENDW(tt) do{ if((tt)+3<NT){WAIT_BAR(2);} else if((tt)+2<NT){WAIT_BAR(1);} else {WAIT_BAR(0);} }while(0)
  for(;t+1<NT;t+=2){
    STEP(pB0,pB1,pA0,pA1,t,(t+3<NT),(t+1<NT),(t+1<NT));       ENDW(t);   RESC(); ROT();
    STEP(pA0,pA1,pB0,pB1,t+1,(t+4<NT),(t+2<NT),(t+2<NT));     ENDW(t+1); RESC(); ROT();
  }
  STEP(pB0,pB1,pA0,pA1,NT-1,false,false,false); RESC();
  { float sacc=pB0[0]+pB0[1]; _Pragma("unroll") for(int r=2;r<16;++r)sacc+=pB0[r]; _Pragma("unroll") for(int r=0;r<16;++r)sacc+=pB1[r]; l_reg+=sacc;
    pw0=(u32x4){PKW(pB0,0),PKW(pB0,2),PKW(pB0,4),PKW(pB0,6)};pw1=(u32x4){PKW(pB0,8),PKW(pB0,10),PKW(pB0,12),PKW(pB0,14)};pw2=(u32x4){PKW(pB1,0),PKW(pB1,2),PKW(pB1,4),PKW(pB1,6)};pw3=(u32x4){PKW(pB1,8),PKW(pB1,10),PKW(pB1,12),PKW(pB1,14)};
    SBAR(); pv(o,vb0+sl_cur,PAF(0),PAF(1),PAF(2),PAF(3)); }
  #undef PKW
  #undef PAF
  #undef VFR
  #undef PIN
  #undef MX3
  #undef GAPA
  #undef GAPB
  #undef EX
  #undef VRD
  #undef KRD
  #undef STEP
  #undef ENDW
  {auto rr=__builtin_amdgcn_permlane32_swap(__float_as_uint(l_reg),__float_as_uint(l_reg),false,false);l_reg=__uint_as_float(rr[0])+__uint_as_float(rr[1]);}
  if(hi==0)wsf[32+r32]=l_reg;asm volatile("s_waitcnt lgkmcnt(0)":::"memory");
  float rli[16];
  #pragma unroll
  for(int r=0;r<16;++r)rli[r]=__builtin_amdgcn_rcpf(wsf[32+crow(r,hi)]);
  bf16*Ow=O+(rowbase+q0+wid*QBLK)*QP+h*D;
  { bf16*stg=(bf16*)(shm+LDS_OST)+wid*2048;
    #pragma unroll
    for(int r=0;r<16;++r){const int orow=crow(r,hi);
      #pragma unroll
      for(int d0=0;d0<2;++d0)stg[orow*64+d0*32+r32]=__float2bfloat16(o[d0][r]*rli[r]);}
    asm volatile("s_waitcnt lgkmcnt(0)":::"memory");
    #pragma unroll
    for(int i=0;i<4;++i){const int row=i*8+(lane>>3),ch=lane&7; const u32x4 v=*(const u32x4*)(stg+row*64+ch*8); ATTN_STORE16(Ow+(long)row*QP+ch*8,v);} }
  asm volatile("s_waitcnt lgkmcnt(0)\n\ts_barrier":::"memory");
  #undef DMA_K
  #undef DMA_V
  #undef CMASK
  #undef START
  #undef RESC
  #undef ROT
}
constexpr int ATTN_LDS_BYTES=LDS_BYTES;
#undef SBAR
#undef WAIT_BAR
}
namespace cg = cooperative_groups;
#define GAS __attribute__((address_space(1)))
#define LAS __attribute__((address_space(3)))
#define CAS __attribute__((address_space(4)))
typedef unsigned short bf16;
typedef unsigned v4u __attribute__((ext_vector_type(4)));
typedef unsigned v2u __attribute__((ext_vector_type(2)));
typedef float f32x4 __attribute__((ext_vector_type(4)));
typedef float f2 __attribute__((ext_vector_type(2)));
typedef short bf16x8 __attribute__((ext_vector_type(8)));
constexpr int NWAVES = 8;
constexpr int D = 1024, MP = 16384, MT = 81920, TSAMP = 4096, NSEQ = 17, DEPTH = 2;
constexpr int NINP = 2816, NINSRC = 2688, DFF = 2816, PRP = 2048, KVP = 256;
constexpr int NITEM_SCAN = 6144;
constexpr float NORM_EPS = 1e-6f, QK_EPS = 1e-6f, GN_EPS = 64e-5f, DECAY_SCALE = 0.6065306597126334f;
constexpr size_t MiB = 1u << 20;
constexpr size_t WS_MOD = 0;
constexpr size_t WS_CTL = 896 * 1024;
constexpr size_t WS_BON = 1 * MiB;
constexpr size_t WS_WSM = 7 * MiB;
constexpr size_t WS_WIN = 8 * MiB, WS_WOUT = 19 * MiB, WS_WFFI = 23 * MiB, WS_WFFO = 45 * MiB;
constexpr size_t WS_XN = 56 * MiB;
constexpr size_t WS_MIX = 216 * MiB;
constexpr size_t WS_PROJ = 376 * MiB;
constexpr size_t WS_KV = 696 * MiB;
constexpr size_t WS_P = 736 * MiB, WS_QS = 832 * MiB;
constexpr size_t WS_SLAB = 928 * MiB;
constexpr size_t WS_ACT = 376 * MiB;
constexpr size_t WS_END = 976 * MiB;
constexpr int LDS_BYTES = 163840;

__device__ __forceinline__ int bid_() { int v = (int)blockIdx.x; asm volatile("" : "+s"(v)); return v; }
__device__ __forceinline__ unsigned f2bf(float f) { unsigned u = __builtin_bit_cast(unsigned, f); return (u + 0x7fffu + ((u >> 16) & 1u)) >> 16; }
__device__ __forceinline__ unsigned pk2(float lo, float hi) { return f2bf(lo) | (f2bf(hi) << 16); }
__device__ __forceinline__ float bflo(unsigned u) { return __builtin_bit_cast(float, u << 16); }
__device__ __forceinline__ float bfhi(unsigned u) { return __builtin_bit_cast(float, u & 0xffff0000u); }
__device__ __forceinline__ f32x4 ld4bf(const bf16* p) { const v2u u = *(const v2u*)p; return (f32x4){bflo(u.x), bfhi(u.x), bflo(u.y), bfhi(u.y)}; }
__device__ __forceinline__ float sigmoidf_(float x) { return __builtin_amdgcn_rcpf(1.0f + __builtin_amdgcn_exp2f(-1.4426950408889634f * x)); }
__device__ __forceinline__ float tanhf_(float x) { return 1.0f - 2.0f * __builtin_amdgcn_rcpf(1.0f + __builtin_amdgcn_exp2f(2.8853900817779268f * x)); }
__device__ __forceinline__ float shx(float v, int o, int lane) { return __builtin_bit_cast(float, __builtin_amdgcn_ds_bpermute((lane ^ o) << 2, __builtin_bit_cast(int, v))); }
__device__ __forceinline__ float wave_sum(float v, int lane) {
#pragma unroll
    for (int o = 1; o < 64; o <<= 1) v += shx(v, o, lane);
    return v;
}
#define LDS_WAIT() asm volatile("s_waitcnt lgkmcnt(0)" ::: "memory")

struct Args { const float* in[25]; float* out; unsigned char* ws; };

__device__ __forceinline__ void p0_transpose_item(const float* W, int K, int N, bf16* WT, int k0, int src_n0, int dst_n0, bool zero, LAS float* scr, int lane) {
    if (!zero) {
#pragma unroll 8
        for (int i = 0; i < 32; ++i) { const int kk = 2 * i + (lane >> 5); scr[kk * 33 + (lane & 31)] = W[(size_t)(k0 + kk) * N + src_n0 + (lane & 31)]; }
    } else {
#pragma unroll 8
        for (int i = 0; i < 32; ++i) { const int kk = 2 * i + (lane >> 5); scr[kk * 33 + (lane & 31)] = 0.f; }
    }
    LDS_WAIT(); asm volatile("" ::: "memory");
    const int c = lane & 7;
#pragma unroll
    for (int j = 0; j < 4; ++j) { const int n = (lane >> 3) + 8 * j; const LAS float* s = scr + (8 * c) * 33 + n;
        v4u o; o.x = pk2(s[0 * 33], s[1 * 33]); o.y = pk2(s[2 * 33], s[3 * 33]); o.z = pk2(s[4 * 33], s[5 * 33]); o.w = pk2(s[6 * 33], s[7 * 33]);
        *(v4u*)(WT + (size_t)(dst_n0 + n) * K + k0 + 8 * c) = o; }
    LDS_WAIT(); asm volatile("" ::: "memory");
}
__device__ __forceinline__ void p0_prologue(const CAS Args* A, LAS unsigned char* lds, int wave, int lane, int G) {
    LAS float* scr = (LAS float*)(lds + wave * 16384);
    const int gw = bid_() * NWAVES + wave, NGW = G * NWAVES;
    constexpr int I_IN = 16 * 88, I_OUT = 16 * 32, I_FFI = 16 * 176, I_FFO = 44 * 32, I_LORA = 16 * 2, I_GATE = 2 * 16;
    constexpr int PER_L = I_IN + I_OUT + I_FFI + I_FFO + 2 * I_LORA + I_GATE;
    unsigned char* ws = A->ws;
    for (int it = gw; it < 2 * PER_L; it += NGW) {
        const int l = it / PER_L; int r = it % PER_L;
        if (r < I_IN) { const int kb = r / 88, nb = r % 88; const bool z = nb * 32 >= NINSRC;
            p0_transpose_item(A->in[8] + (size_t)l * D * NINSRC, D, NINSRC, (bf16*)(ws + WS_WIN) + (size_t)l * NINP * D, kb * 64, nb * 32, nb * 32, z, scr, lane); continue; } r -= I_IN;
        if (r < I_OUT) { const int kb = r / 32, nb = r % 32;
            p0_transpose_item(A->in[22] + (size_t)l * D * D, D, D, (bf16*)(ws + WS_WOUT) + (size_t)l * D * D, kb * 64, nb * 32, nb * 32, false, scr, lane); continue; } r -= I_OUT;
        if (r < I_FFI) { const int kb = r / 176, nb = r % 176; const int dn = nb * 32, pn = dn >> 8, rr = dn & 255; const int sn = rr < 128 ? pn * 128 + rr : DFF + pn * 128 + (rr - 128);
            p0_transpose_item(A->in[23] + (size_t)l * D * 2 * DFF, D, 2 * DFF, (bf16*)(ws + WS_WFFI) + (size_t)l * 2 * DFF * D, kb * 64, sn, dn, false, scr, lane); continue; } r -= I_FFI;
        if (r < I_FFO) { const int kb = r / 32, nb = r % 32;
            p0_transpose_item(A->in[24] + (size_t)l * DFF * D, DFF, D, (bf16*)(ws + WS_WFFO) + (size_t)l * D * DFF, kb * 64, nb * 32, nb * 32, false, scr, lane); continue; } r -= I_FFO;
        if (r < I_LORA) { const int d = r / 16, nb = r % 16;
            p0_transpose_item(A->in[11] + (size_t)(l * 2 + d) * 64 * 512, 64, 512, (bf16*)(ws + WS_WSM) + (size_t)(l * 2 + d) * 512 * 64, 0, nb * 32, nb * 32, false, scr, lane); continue; } r -= I_LORA;
        if (r < I_LORA) { const int d = r / 16, nb = r % 16;
            p0_transpose_item(A->in[13] + (size_t)(l * 2 + d) * 64 * 512, 64, 512, (bf16*)(ws + WS_WSM) + 131072 + (size_t)(l * 2 + d) * 512 * 64, 0, nb * 32, nb * 32, false, scr, lane); continue; } r -= I_LORA;
        { const int kb = r / 16, nb = r % 16;
            p0_transpose_item(A->in[14] + (size_t)l * 128 * 512, 128, 512, (bf16*)(ws + WS_WSM) + 262144 + (size_t)l * 512 * 128, kb * 64, nb * 32, nb * 32, false, scr, lane); }
    }
}
__device__ __forceinline__ void p0_mod(const CAS Args* A, LAS unsigned char* lds, int tid) {
    const int item = bid_(); if (item >= 192) return;
    LAS float* cs = (LAS float*)lds;
    LAS float* red = (LAS float*)(lds + 81920);
    for (int e = tid; e < NSEQ * 1024; e += 512) { const int s = e >> 10, k = e & 1023; const float c = s == 0 ? A->in[2][k] : A->in[3][(s - 1) * 1024 + k];
        cs[k * 20 + s] = c * sigmoidf_(c); }
    __syncthreads();
    const int l = item / 96, col0 = (item % 96) * 64, kq = tid >> 6, col = tid & 63;
    const float* w = A->in[4] + (size_t)l * 1024 * 6144 + col0 + col;
    float acc[NSEQ];
#pragma unroll
    for (int s = 0; s < NSEQ; ++s) acc[s] = 0.f;
#pragma unroll 4
    for (int k = kq * 128; k < kq * 128 + 128; ++k) { const float wv = w[(size_t)k * 6144];
        const LAS f32x4* c4 = (const LAS f32x4*)(cs + k * 20);
        const f32x4 c0 = c4[0], c1 = c4[1], c2 = c4[2], c3 = c4[3]; const float c16 = cs[k * 20 + 16];
#pragma unroll
        for (int i = 0; i < 4; ++i) { acc[i] += wv * c0[i]; acc[4 + i] += wv * c1[i]; acc[8 + i] += wv * c2[i]; acc[12 + i] += wv * c3[i]; }
        acc[16] += wv * c16; }
#pragma unroll
    for (int s = 0; s < NSEQ; ++s) red[(kq * NSEQ + s) * 64 + col] = acc[s];
    __syncthreads();
    float* mod = (float*)(A->ws + WS_MOD);
    for (int e = tid; e < NSEQ * 64; e += 512) { const int s = e >> 6, c = e & 63; float v = A->in[5][l * 6144 + col0 + c];
#pragma unroll
        for (int q = 0; q < 8; ++q) v += red[(q * NSEQ + s) * 64 + c];
        mod[(size_t)(s * 2 + l) * 6144 + col0 + c] = v; }
    __syncthreads();
}
__device__ __forceinline__ int seq_of(int m) { return m < MP ? 0 : 1 + ((m - MP) >> 12); }
__device__ __forceinline__ void norm_phase(const float* xp, const float* xs, const float* g, const float* modl  , bf16* XN, int wave, int lane, int G) {
    const int gw = bid_() * NWAVES + wave, NGW = G * NWAVES;
    f32x4 gv[4];
#pragma unroll
    for (int j = 0; j < 4; ++j) gv[j] = ((const f32x4*)g)[64 * j + lane];
    for (int m = gw; m < MT; m += NGW) {
        const float* xrow = m < MP ? xp + (size_t)m * D : xs + (size_t)(m - MP) * D;
        const f32x4* xr = (const f32x4*)xrow + lane;
        f32x4 v[4]; float s = 0.f;
#pragma unroll
        for (int j = 0; j < 4; ++j) { v[j] = xr[64 * j]; s += (v[j].x * v[j].x + v[j].y * v[j].y) + (v[j].z * v[j].z + v[j].w * v[j].w); }
        const float rstd = 1.0f / sqrtf(wave_sum(s, lane) * (1.f / D) + NORM_EPS);
        const float* mp = modl + (size_t)seq_of(m) * 12288;
        unsigned long long* o8 = (unsigned long long*)(XN + (size_t)m * D) + lane;
#pragma unroll
        for (int j = 0; j < 4; ++j) { const f32x4 sh = ((const f32x4*)mp)[64 * j + lane], sc = ((const f32x4*)(mp + 1024))[64 * j + lane];
            const f32x4 y = v[j] * rstd * gv[j] * (1.0f + sc) + sh;
            o8[64 * j] = (unsigned long long)pk2(y.x, y.y) | ((unsigned long long)pk2(y.z, y.w) << 32); }
    }
}
__device__ __forceinline__ void qk_prep_phase(bf16* mix, bf16* kv, const float* qg, const float* kg, int wave, int lane, int G) {
    const int gw = bid_() * NWAVES + wave, NGW = G * NWAVES;
    const int hsel = lane >> 5, li = lane & 31, half = li >> 4, i = li & 15, d1 = half * 32 + i, d2 = d1 + 16;
    const float freq = __builtin_amdgcn_exp2f(-(float)i * (13.287712379549449f / 16.0f));
    const float q1 = qg[d1], q2 = qg[d2], k1 = kg[d1], k2 = kg[d2];
    for (int m = gw; m < MT; m += NGW) {
        const int t = m < MP ? m : (m - MP) & (TSAMP - 1);
        const float pos = (float)(half ? (t & 63) : (t >> 6));
        float sn, cn; sincosf(pos * freq, &sn, &cn);
        bf16* pp[5]; float x1[5], x2[5];
#pragma unroll
        for (int it = 0; it < 5; ++it) { const int hh = it * 2 + hsel;
            pp[it] = hh < 8 ? mix + (size_t)m * 1024 + 512 + hh * 64 : kv + (size_t)m * KVP + (hh - 8) * 64;
            x1[it] = bflo(pp[it][d1]); x2[it] = bflo(pp[it][d2]); }
        asm volatile("" ::: "memory");
        unsigned short r1[5], r2[5];
#pragma unroll
        for (int it = 0; it < 5; ++it) { const int hh = it * 2 + hsel;
            float ss = x1[it] * x1[it] + x2[it] * x2[it];
#pragma unroll
            for (int o = 1; o < 32; o <<= 1) ss += shx(ss, o, lane);
            const float rstd = 1.0f / sqrtf(ss * (1.f / 64.f) + QK_EPS);
            const float y1 = x1[it] * rstd * (hh < 8 ? q1 : k1), y2 = x2[it] * rstd * (hh < 8 ? q2 : k2);
            float o1 = y1 * cn - y2 * sn, o2 = y2 * cn + y1 * sn;
            if (hh < 8) { o1 *= attn_body::C2; o2 *= attn_body::C2; }
            r1[it] = (unsigned short)f2bf(o1); r2[it] = (unsigned short)f2bf(o2); }
#pragma unroll
        for (int it = 0; it < 5; ++it) { pp[it][d1] = r1[it]; pp[it][d2] = r2[it]; }
    }
}
struct ScanP { const bf16* proj; const float* conv_w; const float* w0; const float* a0; const float* k_k; const float* k_a; const float* r_k; const bf16* upw; const bf16* upa; };
__device__ __forceinline__ f32x4 conv4(const bf16* proj, const float* cw, int m, int col, bool hp, bool hn) {
    const bf16* p = proj + (size_t)m * PRP + col;
    const f32x4 c0 = *(const f32x4*)(cw + col), c1 = *(const f32x4*)(cw + 1536 + col), c2 = *(const f32x4*)(cw + 3072 + col);
    f32x4 r = c1 * ld4bf(p);
    if (hp) r += c0 * ld4bf(p - PRP);
    if (hn) r += c2 * ld4bf(p + PRP);
    return r;
}
template <int MODE>
__device__ __forceinline__ void scan_prologue(const ScanP& P, int m0, int seqbase, int T, int h, int d, float* slab, LAS float* lw, float* bon, int lane) {
    const int fr = lane & 15, fq = lane >> 4, m = m0 + fr, pos = m - seqbase; const bool hp = pos > 0, hn = pos < T - 1;
    float* srow = slab + fr * 384;
    f32x4 k4[4], kk4[4], r4[4]; float ss = 0.f;
    v2u pk_[4][3], pv_[4][3], pr_[4][3];
    const v2u zz = (v2u){0u, 0u};
#pragma unroll
    for (int n = 0; n < 4; ++n) { const bf16* p = P.proj + (size_t)m * PRP + h * 64 + 16 * n + 4 * fq;
        pk_[n][1] = *(const v2u*)(p + 512); pk_[n][0] = zz; pk_[n][2] = zz;
        if (hp) pk_[n][0] = *(const v2u*)(p + 512 - PRP);
        if (hn) pk_[n][2] = *(const v2u*)(p + 512 + PRP);
        if (MODE != 1) { pv_[n][1] = *(const v2u*)(p + 1024); pv_[n][0] = zz; pv_[n][2] = zz;
            if (hp) pv_[n][0] = *(const v2u*)(p + 1024 - PRP);
            if (hn) pv_[n][2] = *(const v2u*)(p + 1024 + PRP); }
        if (MODE == 2) { pr_[n][1] = *(const v2u*)(p); pr_[n][0] = zz; pr_[n][2] = zz;
            if (hp) pr_[n][0] = *(const v2u*)(p - PRP);
            if (hn) pr_[n][2] = *(const v2u*)(p + PRP); } }
    v4u xw_[2]; bf16x8 xa_[2];
#pragma unroll
    for (int ks = 0; ks < 2; ++ks) { xw_[ks] = *(const v4u*)(P.proj + (size_t)m * PRP + 1536 + d * 64 + ks * 32 + 8 * fq); xa_[ks] = *(const bf16x8*)(P.proj + (size_t)m * PRP + 1664 + d * 64 + ks * 32 + 8 * fq); }
    asm volatile("" ::: "memory");
#define CONV3_(arr, which) ({ const float* cw_ = P.conv_w + (which) * 512 + col; const f32x4 c0 = *(const f32x4*)cw_, c1 = *(const f32x4*)(cw_ + 1536), c2 = *(const f32x4*)(cw_ + 3072); \
        const v2u u0 = arr[n][0], u1 = arr[n][1], u2 = arr[n][2]; \
        c0 * (f32x4){bflo(u0.x), bfhi(u0.x), bflo(u0.y), bfhi(u0.y)} + c1 * (f32x4){bflo(u1.x), bfhi(u1.x), bflo(u1.y), bfhi(u1.y)} + c2 * (f32x4){bflo(u2.x), bfhi(u2.x), bflo(u2.y), bfhi(u2.y)}; })
#pragma unroll
    for (int n = 0; n < 4; ++n) { const int c = 16 * n + 4 * fq, col = h * 64 + c;
        k4[n] = CONV3_(pk_, 1);
        if (MODE != 1) { const f32x4 v4 = CONV3_(pv_, 2); *(f32x4*)(srow + 320 + c) = v4; LAS float* xsel = (fr == (d ? 15 : 0)) ? lw + 2048 + c : lw + 2304 + lane * 4; *(LAS f32x4*)(xsel + 192) = v4; }
        if (MODE == 2) { r4[n] = CONV3_(pr_, 0); *(LAS f32x4*)(lw + 1024 + fr * 64 + c) = r4[n]; }
        kk4[n] = k4[n] * *(const f32x4*)(P.k_k + col);
        ss += (kk4[n].x * kk4[n].x + kk4[n].y * kk4[n].y) + (kk4[n].z * kk4[n].z + kk4[n].w * kk4[n].w); }
#undef CONV3_
    ss += shx(ss, 16, lane); ss += shx(ss, 32, lane);
    const float rs = 1.0f / sqrtf(ss + 1e-12f);
    f32x4 Dw[4], Da[4];
#pragma unroll
    for (int n = 0; n < 4; ++n) { Dw[n] = (f32x4){0.f, 0.f, 0.f, 0.f}; Da[n] = (f32x4){0.f, 0.f, 0.f, 0.f}; }
#pragma unroll
    for (int ks = 0; ks < 2; ++ks) {
        const v4u xw = xw_[ks]; const bf16x8 xa = xa_[ks];
        v4u tw;
#pragma unroll
        for (int e = 0; e < 4; ++e) tw[e] = pk2(tanhf_(bflo(xw[e])), tanhf_(bfhi(xw[e])));
        const bf16x8 twv = __builtin_bit_cast(bf16x8, tw);
#pragma unroll
        for (int n = 0; n < 4; ++n) { const size_t wo = (size_t)(h * 64 + 16 * n + fr) * 64 + ks * 32 + 8 * fq;
            Dw[n] = __builtin_amdgcn_mfma_f32_16x16x32_bf16(*(const bf16x8*)(P.upw + wo), twv, Dw[n], 0, 0, 0);
            Da[n] = __builtin_amdgcn_mfma_f32_16x16x32_bf16(*(const bf16x8*)(P.upa + wo), xa, Da[n], 0, 0, 0); }
    }
    float bp = 0.f;
#pragma unroll
    for (int n = 0; n < 4; ++n) { const int c = 16 * n + 4 * fq, col = h * 64 + c;
        const f32x4 w0 = *(const f32x4*)(P.w0 + col), a0 = *(const f32x4*)(P.a0 + col), ka = *(const f32x4*)(P.k_a + col);
        f32x4 wv, bv, kd, av;
#pragma unroll
        for (int i = 0; i < 4; ++i) { const float ic = sigmoidf_(Da[n][i] + a0[i]);
            wv[i] = __builtin_amdgcn_exp2f(-DECAY_SCALE * 1.4426950408889634f * sigmoidf_(Dw[n][i] + w0[i]));
            const float kk = kk4[n][i] * rs; av[i] = -kk; bv[i] = kk * ic; kd[i] = k4[n][i] * (1.0f + (ic - 1.0f) * ka[i]); }
        *(LAS f32x4*)(lw + fr * 64 + c) = av; *(LAS f32x4*)(lw + 3072 + fr * 64 + c) = wv; *(LAS f32x4*)(lw + (MODE == 3 ? 1024 : 4096) + fr * 64 + c) = bv;
        if (MODE != 1) *(f32x4*)(srow + 192 + c) = kd;
        { LAS float* xsel = (fr == (d ? 15 : 0)) ? lw + 2048 + c : lw + 2304 + lane * 4;
          *(LAS f32x4*)(xsel) = wv; if (MODE != 3) *(LAS f32x4*)(xsel + 64) = bv; if (MODE != 1) *(LAS f32x4*)(xsel + 128) = kd; }
        if (MODE == 2) { const f32x4 rk = *(const f32x4*)(P.r_k + col); const f32x4 t = r4[n] * kd * rk; bp += (t.x + t.y) + (t.z + t.w); }
        asm volatile("" ::: "memory");
    }
    if (MODE == 2) { bp += shx(bp, 16, lane); bp += shx(bp, 32, lane); if (fq == 0) bon[(size_t)m * 8 + h] = 0.5f * bp; }
}
template <int MODE>
__device__ __forceinline__ void scan_item(const CAS Args* A, int l, int item, float* slab0, LAS float* ldsw, int lane) {
    unsigned char* ws = A->ws;
    const bool isP = item < 2048; const int it2 = isP ? item : item - 2048;
    const int d = it2 & 1, h = (it2 >> 1) & 7, chunk = it2 >> 4, m0c = isP ? chunk * 128 : MP + chunk * 256, nsub = isP ? 8 : 16;
    const int seqbase = isP ? 0 : MP + (chunk >> 4) * TSAMP, T = isP ? MP : TSAMP;
    ScanP P; P.proj = (const bf16*)(ws + WS_PROJ); P.conv_w = A->in[9] + (size_t)l * 3 * 1536; P.w0 = A->in[10] + (size_t)(l * 2 + d) * 512; P.a0 = A->in[12] + (size_t)(l * 2 + d) * 512;
    P.k_k = A->in[15] + l * 512; P.k_a = A->in[16] + l * 512; P.r_k = A->in[17] + l * 512;
    P.upw = (const bf16*)(ws + WS_WSM) + (size_t)(l * 2 + d) * 512 * 64; P.upa = (const bf16*)(ws + WS_WSM) + 131072 + (size_t)(l * 2 + d) * 512 * 64;
    float* bon = (float*)(ws + WS_BON) + (size_t)d * MT * 8;
    bf16* yb = (bf16*)(ws + WS_XN) + (size_t)d * MT * 512;
    f2 S[32], Pm[32];
    if (MODE == 3) {
#pragma unroll
        for (int i = 0; i < 32; ++i) Pm[i] = (f2){lane == 2 * i ? 1.f : 0.f, lane == 2 * i + 1 ? 1.f : 0.f}; }
    if (MODE == 2) { const f32x4* q = (const f32x4*)((const float*)(ws + WS_QS) + ((size_t)item * 64 + lane) * 64);
#pragma unroll
        for (int i = 0; i < 16; ++i) { const f32x4 v = q[i]; S[2 * i] = (f2){v.x, v.y}; S[2 * i + 1] = (f2){v.z, v.w}; } }
    else {
#pragma unroll
        for (int i = 0; i < 32; ++i) S[i] = MODE == 1 ? (f2){lane == 2 * i ? 1.f : 0.f, lane == 2 * i + 1 ? 1.f : 0.f} : (f2){0.f, 0.f}; }
#pragma nounroll
    for (int sc = 0; sc < nsub; ++sc) {
        const int sub = d ? nsub - 1 - sc : sc, t0 = m0c + sub * 16;
        float* slab = slab0;
        { int lane_l = lane; asm volatile("" : "+v"(lane_l)); scan_prologue<MODE>(P, t0, seqbase, T, h, d, slab, ldsw, bon, lane_l);
#ifdef DUP_PRO
          asm volatile("" : "+v"(lane_l)); scan_prologue<MODE>(P, t0, seqbase, T, h, d, slab, ldsw, bon, lane_l);
#endif
        }
        asm volatile("" ::: "memory");
#define RL2(x, j) (f2){__builtin_bit_cast(float, __builtin_amdgcn_readlane(__builtin_bit_cast(int, x), 2 * (j))), __builtin_bit_cast(float, __builtin_amdgcn_readlane(__builtin_bit_cast(int, x), 2 * (j) + 1))}
        const GAS float* sl = (const GAS float*)slab + lane;
        LDS_WAIT();
        float nw[1], nb[1], nk[1], nv[1];
        { const LAS float* xl = ldsw + 2048 + lane; nw[0] = 0.f; nb[0] = 0.f; nk[0] = 0.f; nv[0] = 0.f; if (MODE != 1) { nk[0] = xl[128]; nv[0] = xl[192]; } }
#pragma nounroll
        for (int st = 0; st < 16; ++st) {
            const int s = d ? 15 - st : st;
            const float cw = nw[0], cb = nb[0], ck = nk[0], vv = nv[0];
            if (st < 15) { const GAS float* p = sl + (d ? s - 1 : s + 1) * 384;  if (MODE != 1) { nk[0] = p[192]; nv[0] = p[320]; } }
            const LAS f32x4* ua = (const LAS f32x4*)(ldsw + s * 64); const LAS f32x4* ur = (const LAS f32x4*)(ldsw + 1024 + s * 64); const LAS f32x4* uw = (const LAS f32x4*)(ldsw + 3072 + s * 64); const LAS f32x4* ub = (const LAS f32x4*)(ldsw + (MODE == 3 ? 1024 : 4096) + s * 64);
            f2 sa2 = (f2){0.f, 0.f}, sb2 = (f2){0.f, 0.f}, pa2 = (f2){0.f, 0.f}, pb2 = (f2){0.f, 0.f};
#pragma unroll
            for (int j = 0; j < 16; ++j) { const f32x4 aq = ua[j]; const f2 a0 = (f2){aq.x, aq.y}, a1 = (f2){aq.z, aq.w}; sa2 = S[2 * j] * a0 + sa2; sb2 = S[2 * j + 1] * a1 + sb2;
                if (MODE == 3) { pa2 = Pm[2 * j] * a0 + pa2; pb2 = Pm[2 * j + 1] * a1 + pb2; } }
            const float sa = (sa2.x + sa2.y) + (sb2.x + sb2.y), pa = (pa2.x + pa2.y) + (pb2.x + pb2.y); const f2 pas = (f2){pa, pa};
            const f2 sas = (f2){sa, sa}, vvs = (f2){vv, vv};
            f2 y2 = (f2){0.f, 0.f}, y3 = (f2){0.f, 0.f};
            f32x4 nwq[2], nbq[2], nrq[2];
            nwq[0] = uw[0]; nwq[1] = uw[1]; nbq[0] = ub[0]; nbq[1] = ub[1]; nrq[0] = (f32x4){0.f, 0.f, 0.f, 0.f}; nrq[1] = nrq[0];
            if (MODE == 2) { nrq[0] = ur[0]; nrq[1] = ur[1]; }
#pragma unroll
            for (int g = 0; g < 8; ++g) {
                const f32x4 cwq0 = nwq[0], cwq1 = nwq[1], cbq0 = nbq[0], cbq1 = nbq[1], crq0 = nrq[0], crq1 = nrq[1];
                if (g < 7) { nwq[0] = uw[2 * g + 2]; nwq[1] = uw[2 * g + 3]; nbq[0] = ub[2 * g + 2]; nbq[1] = ub[2 * g + 3];
                    if (MODE == 2) { nrq[0] = ur[2 * g + 2]; nrq[1] = ur[2 * g + 3]; } }
                f2 bb[4], ww[4], kq[4], rr[4];
                ww[0] = (f2){cwq0.x, cwq0.y}; ww[1] = (f2){cwq0.z, cwq0.w}; ww[2] = (f2){cwq1.x, cwq1.y}; ww[3] = (f2){cwq1.z, cwq1.w};
                bb[0] = (f2){cbq0.x, cbq0.y}; bb[1] = (f2){cbq0.z, cbq0.w}; bb[2] = (f2){cbq1.x, cbq1.y}; bb[3] = (f2){cbq1.z, cbq1.w};
                rr[0] = (f2){crq0.x, crq0.y}; rr[1] = (f2){crq0.z, crq0.w}; rr[2] = (f2){crq1.x, crq1.y}; rr[3] = (f2){crq1.z, crq1.w};
#pragma unroll
                for (int q = 0; q < 4; ++q) { const int j = g * 4 + q; if (MODE != 1) kq[q] = RL2(ck, j); }
                __builtin_amdgcn_sched_barrier(0);
#pragma unroll
                for (int q = 0; q < 4; ++q) { const int j = g * 4 + q;
                    f2 t = sas * bb[q];
                    if (MODE != 1) t = vvs * kq[q] + t;
                    S[j] = S[j] * ww[q] + t;
                    if (MODE == 3) Pm[j] = Pm[j] * ww[q] + pas * bb[q];
                    if (MODE == 2) { if (j & 1) y3 = S[j] * rr[q] + y3; else y2 = S[j] * rr[q] + y2; } }
            }
            if (MODE == 2) yb[(size_t)(t0 + s) * 512 + h * 64 + lane] = (bf16)f2bf((y2.x + y2.y) + (y3.x + y3.y));
        }
#undef RL2
    }
    if (MODE != 2) { f32x4* q = (f32x4*)((float*)(ws + (MODE == 1 ? WS_P : WS_QS)) + ((size_t)item * 64 + lane) * 64);
#pragma unroll
        for (int i = 0; i < 16; ++i) q[i] = (f32x4){S[2 * i].x, S[2 * i].y, S[2 * i + 1].x, S[2 * i + 1].y}; }
    if (MODE == 3) { f32x4* q = (f32x4*)((float*)(ws + WS_P) + ((size_t)item * 64 + lane) * 64);
#pragma unroll
        for (int i = 0; i < 16; ++i) q[i] = (f32x4){Pm[2 * i].x, Pm[2 * i].y, Pm[2 * i + 1].x, Pm[2 * i + 1].y}; }
}
template <bool PASS_C>
__device__ __forceinline__ void scan_phase(const CAS Args* A, LAS unsigned char* lds, int l, int wave, int lane, int G) {
    const int gw = bid_() * NWAVES + wave, NGW = G * NWAVES;
    float* slab0 = (float*)(A->ws + WS_SLAB) + (size_t)gw * 6144;
    LAS float* ldsw = (LAS float*)(lds + wave * 20480);
    if (PASS_C) { for (int item = gw; item < NITEM_SCAN; item += NGW) scan_item<2>(A, l, item, slab0, ldsw, lane); }
    else { for (int item = gw; item < NITEM_SCAN; item += NGW) { int ll = lane; asm volatile("" : "+v"(ll)); scan_item<3>(A, l, item, slab0, ldsw, ll); } }
}
#ifdef EXP_SLOAD
typedef const CAS f2* cf2p_;
__device__ __forceinline__ void probe_sload(const CAS Args* A, int wave, int lane, int G) {
    const int gw = bid_() * NWAVES + wave;
    float* pslab = (float*)(A->ws + WS_SLAB) + (size_t)gw * 12288;
    f2 acc = (f2){0.f, 0.f}, acc2 = (f2){0.f, 0.f};
#pragma nounroll
    for (int rep = 0; rep < EXP_SLOAD; ++rep) {
        float* ps = pslab + (rep & 1) * 6144;
#pragma unroll 4
        for (int i = 0; i < 96; ++i) ps[i * 64 + lane] = (float)(i + rep) * 0.001f;
        unsigned long long sp = (unsigned long long)(uintptr_t)ps;
        sp = __builtin_amdgcn_readfirstlane((unsigned)sp) | ((unsigned long long)__builtin_amdgcn_readfirstlane((unsigned)(sp >> 32)) << 32);
        asm volatile("s_waitcnt vmcnt(0) lgkmcnt(0)" : "+s"(sp) : : "memory");
        cf2p_ u = (cf2p_)sp;
#pragma nounroll
        for (int i = 0; i < 3072; i += 32) {
#pragma unroll
            for (int j = 0; j < 32; j += 2) { acc = acc * u[i + j] + acc; acc2 = acc2 * u[i + j + 1] + acc2; }
        }
    }
    if (acc.x + acc2.y == 12345.678f) pslab[lane] = acc.y + acc2.x;
}
#endif
__device__ __forceinline__ void scanB_phase(const CAS Args* A, LAS unsigned char* lds, int wave, int lane, int G) {
    unsigned char* ws = A->ws;
    LAS float* ex = (LAS float*)lds;
    LAS float* pl = (LAS float*)(lds + 32768);
    const int tid = wave * 64 + lane;
    for (int chain = bid_(); chain < NSEQ * 16; chain += G) {
        const int d = chain & 1, h = (chain >> 1) & 7, seq = chain >> 4;
        const int nc = seq == 0 ? 128 : 16, ibase = seq == 0 ? 0 : 2048 + (seq - 1) * 256;
        f2 S[32]; f2 cur[4];
#pragma unroll
        for (int i = 0; i < 32; ++i) S[i] = (f2){0.f, 0.f};
#pragma unroll
        for (int i = 0; i < 4; ++i) cur[i] = (f2){0.f, 0.f};
        { const int c0 = d ? nc - 1 : 0; const size_t it0 = (size_t)ibase + (size_t)(c0 * 8 + h) * 2 + d;
          const f32x4* ps = (const f32x4*)((const float*)(ws + WS_P) + it0 * 4096); ((LAS f32x4*)pl)[tid] = ps[tid]; ((LAS f32x4*)pl)[tid + 512] = ps[tid + 512]; }
        __syncthreads();
        for (int ci = 0; ci < nc; ++ci) {
            const int c = d ? nc - 1 - ci : ci; const size_t item = (size_t)ibase + (size_t)(c * 8 + h) * 2 + d;
            LAS float* pc = pl + (ci & 1) * 4096; LAS float* pn = pl + ((ci + 1) & 1) * 4096;
            f32x4 pf0 = (f32x4){0.f, 0.f, 0.f, 0.f}, pf1 = pf0;
            if (ci + 1 < nc) { const int cn = d ? nc - 2 - ci : ci + 1; const size_t itn = (size_t)ibase + (size_t)(cn * 8 + h) * 2 + d;
                const f32x4* ps = (const f32x4*)((const float*)(ws + WS_P) + itn * 4096); pf0 = ps[tid]; pf1 = ps[tid + 512]; }
            float* qrow = (float*)(ws + WS_QS) + (item * 64 + lane) * 64 + wave * 8;
            const f32x4 q0 = *(const f32x4*)qrow, q1 = *(const f32x4*)(qrow + 4);
            *(f32x4*)qrow = (f32x4){cur[0].x, cur[0].y, cur[1].x, cur[1].y}; *(f32x4*)(qrow + 4) = (f32x4){cur[2].x, cur[2].y, cur[3].x, cur[3].y};
            f2 n0 = (f2){0.f, 0.f}, n1 = n0, n2 = n0, n3 = n0;
#pragma unroll
            for (int kp = 0; kp < 32; ++kp) {
                const f2 sx = (f2){S[kp].x, S[kp].x}, sy = (f2){S[kp].y, S[kp].y};
                const LAS f32x4* r0 = (const LAS f32x4*)(pc + (2 * kp) * 64 + wave * 8); const LAS f32x4* r1 = (const LAS f32x4*)(pc + (2 * kp + 1) * 64 + wave * 8);
                const f32x4 a0 = r0[0], a1 = r0[1], b0 = r1[0], b1 = r1[1];
                n0 = sx * (f2){a0.x, a0.y} + n0; n1 = sx * (f2){a0.z, a0.w} + n1; n2 = sx * (f2){a1.x, a1.y} + n2; n3 = sx * (f2){a1.z, a1.w} + n3;
                n0 = sy * (f2){b0.x, b0.y} + n0; n1 = sy * (f2){b0.z, b0.w} + n1; n2 = sy * (f2){b1.x, b1.y} + n2; n3 = sy * (f2){b1.z, b1.w} + n3; }
            n0 += (f2){q0.x, q0.y}; n1 += (f2){q0.z, q0.w}; n2 += (f2){q1.x, q1.y}; n3 += (f2){q1.z, q1.w};
            cur[0] = n0; cur[1] = n1; cur[2] = n2; cur[3] = n3;
            LAS float* er = ex + lane * 68 + wave * 8;
            *(LAS f32x4*)er = (f32x4){n0.x, n0.y, n1.x, n1.y}; *(LAS f32x4*)(er + 4) = (f32x4){n2.x, n2.y, n3.x, n3.y};
            ((LAS f32x4*)pn)[tid] = pf0; ((LAS f32x4*)pn)[tid + 512] = pf1;
            __syncthreads();
#pragma unroll
            for (int i = 0; i < 16; ++i) { const f32x4 v = *(const LAS f32x4*)(ex + lane * 68 + 4 * i); S[2 * i] = (f2){v.x, v.y}; S[2 * i + 1] = (f2){v.z, v.w}; }
            __syncthreads();
        }
    }
}
__device__ __forceinline__ void post_phase(const CAS Args* A, int l, int wave, int lane, int G) {
    unsigned char* ws = A->ws;
    const int gw = bid_() * NWAVES + wave, NGW = G * NWAVES;
    const bf16* proj = (const bf16*)(ws + WS_PROJ); const float* cw = A->in[9] + (size_t)l * 3 * 1536;
    const bf16* y0 = (const bf16*)(ws + WS_XN); const bf16* y1 = y0 + (size_t)MT * 512;
    const float* b0 = (const float*)(ws + WS_BON); const float* b1 = b0 + (size_t)MT * 8;
    const bf16* gt = (const bf16*)(ws + WS_WSM) + 262144 + (size_t)l * 512 * 128;
    const float* lng = A->in[18] + l * 512; const float* lnb = A->in[19] + l * 512;
    bf16* mix = (bf16*)(ws + WS_MIX);
    const int h = gw & 7;
    bf16x8 gfrag[4][4];
    { const int fr0 = lane & 15, fq0 = lane >> 4;
#pragma unroll
      for (int ks = 0; ks < 4; ++ks)
#pragma unroll
        for (int n = 0; n < 4; ++n) gfrag[n][ks] = *(const bf16x8*)(gt + (size_t)(h * 64 + 16 * n + fr0) * 128 + ks * 32 + 8 * fq0);
    }
    f32x4 cwv[4][3], lg4[4], lb4[4];
    { const int fq0 = lane >> 4;
#pragma unroll
      for (int n = 0; n < 4; ++n) { const int col = h * 64 + 16 * n + 4 * fq0;
          cwv[n][0] = *(const f32x4*)(cw + 1024 + col); cwv[n][1] = *(const f32x4*)(cw + 1536 + 1024 + col); cwv[n][2] = *(const f32x4*)(cw + 3072 + 1024 + col);
          lg4[n] = *(const f32x4*)(lng + col); lb4[n] = *(const f32x4*)(lnb + col); } }
    for (int item = gw; item < (MT / 16) * 8; item += NGW) {
        int lane_l = lane; asm volatile("" : "+v"(lane_l)); const int fr = lane_l & 15, fq = lane_l >> 4;
        const int m = (item >> 3) * 16 + fr;
        const int seqbase = m < MP ? 0 : MP + ((m - MP) >> 12) * TSAMP, T = m < MP ? MP : TSAMP, pos = m - seqbase; const bool hp = pos > 0, hn = pos < T - 1;
        f32x4 y4[4]; float s = 0.f;
#pragma unroll
        for (int n = 0; n < 4; ++n) { const size_t o = (size_t)m * 512 + h * 64 + 16 * n + 4 * fq; y4[n] = ld4bf(y0 + o) + ld4bf(y1 + o); s += (y4[n].x + y4[n].y) + (y4[n].z + y4[n].w); }
        s += shx(s, 16, lane); s += shx(s, 32, lane);
        const float mu = s * (1.f / 64.f); float q = 0.f;
#pragma unroll
        for (int n = 0; n < 4; ++n) { y4[n] = y4[n] - mu; q += (y4[n].x * y4[n].x + y4[n].y * y4[n].y) + (y4[n].z * y4[n].z + y4[n].w * y4[n].w); }
        q += shx(q, 16, lane); q += shx(q, 32, lane);
        const float rstd = 1.0f / sqrtf(q * (1.f / 64.f) + GN_EPS);
        const float bon = b0[(size_t)m * 8 + h] + b1[(size_t)m * 8 + h];
        f32x4 Dg[4];
#pragma unroll
        for (int n = 0; n < 4; ++n) Dg[n] = (f32x4){0.f, 0.f, 0.f, 0.f};
#pragma unroll
        for (int ks = 0; ks < 4; ++ks) {
            const v4u xg = *(const v4u*)(proj + (size_t)m * PRP + 1792 + ks * 32 + 8 * fq); v4u sg;
#pragma unroll
            for (int e = 0; e < 4; ++e) sg[e] = pk2(sigmoidf_(bflo(xg[e])), sigmoidf_(bfhi(xg[e])));
            const bf16x8 sgv = __builtin_bit_cast(bf16x8, sg);
#pragma unroll
            for (int n = 0; n < 4; ++n) Dg[n] = __builtin_amdgcn_mfma_f32_16x16x32_bf16(gfrag[n][ks], sgv, Dg[n], 0, 0, 0);
        }
#pragma unroll
        for (int n = 0; n < 4; ++n) { const int col = h * 64 + 16 * n + 4 * fq;
            const bf16* pv = proj + (size_t)m * PRP + 1024 + col;
            f32x4 v4 = cwv[n][1] * ld4bf(pv);
            if (hp) v4 += cwv[n][0] * ld4bf(pv - PRP);
            if (hn) v4 += cwv[n][2] * ld4bf(pv + PRP);
            const f32x4 o = ((y4[n] * rstd) * lg4[n] + lb4[n] + bon * v4) * Dg[n];
            v2u w; w.x = pk2(o.x, o.y); w.y = pk2(o.z, o.w);
            *(v2u*)(mix + (size_t)m * 1024 + col) = w; }
    }
}
__device__ __forceinline__ void attn_phase(const CAS Args* A, char* lds, int G, int tid) {
    using attn_body::bf16;
    bf16* Q = (bf16*)(A->ws + WS_MIX) + 512; const bf16* K = (const bf16*)(A->ws + WS_KV); const bf16* V = K + 128;
#ifdef DUP_ATTNP
    for (int u = blockIdx.x; u < 512; u += G) { const int h = u & 7, qb = u >> 3;
        attn_body::attn_unit<8>(0, MP, h, qb, Q, K, V, (bf16*)(A->ws + 976 * MiB), lds, tid); }
#endif
    for (int u = blockIdx.x; u < 512; u += G) { const int h = u & 7, qb = u >> 3;
        attn_body::attn_unit<8>(0, MP, h, qb, Q, K, V, Q, lds, tid); }
    for (int u = blockIdx.x; u < 2048; u += G) { const int h = u & 7, qb = (u >> 3) & 15, sq = u >> 7;
        attn_body::attn_unit<8>((long)MP + (long)sq * TSAMP, TSAMP, h, qb, Q, K, V, Q, lds, tid); }
}

#define XB_TMO      128
#define XB_XCNT(j)  (256  + 64 * (j))
#define XB_XSUB(j)  (1280 + 64 * (j))
#define XB_XGEN(j)  (2304 + 64 * (j))
#define XB_TOP      3328
#define XB_TOPGEN   3392
#define XCD_BAR_WORDS 3456
#define XB_SPIN_CAP (1u << 18)

__device__ __forceinline__ unsigned xb_ld(unsigned* p)              { return __hip_atomic_load(p, __ATOMIC_RELAXED, __HIP_MEMORY_SCOPE_AGENT); }
__device__ __forceinline__ unsigned xb_add(unsigned* p, unsigned v) { return __hip_atomic_fetch_add(p, v, __ATOMIC_RELAXED, __HIP_MEMORY_SCOPE_AGENT); }
__device__ __forceinline__ unsigned xb_xcc_id() { return (unsigned)__builtin_amdgcn_s_getreg((3 << 11) | 20) & 0xFu; }
#define XB_SPIN(cond, bar) do { unsigned _sp = 0; while (cond) { __builtin_amdgcn_s_sleep(1); \
    if ((++_sp & 255u) == 0u) { if (xb_ld(&(bar)[XB_TMO])) break; if (_sp > XB_SPIN_CAP) { atomicAdd(&(bar)[XB_TMO], 1u); break; } } } } while (0)

struct XcdBarrier {
    unsigned* bar; unsigned x;
    volatile LAS unsigned* st;
};

__device__ __forceinline__ XcdBarrier xcd_barrier_post(unsigned* bar, volatile LAS unsigned* st, bool leader) {
    XcdBarrier b; b.bar = bar; b.x = xb_xcc_id(); b.st = st;
    if (leader) (void)xb_add(&bar[XB_XCNT(b.x)], 1u);
    return b;
}
__device__ __forceinline__ void xcd_barrier_complete(unsigned* bar, unsigned x, unsigned& nloc, unsigned& nx) {
    const unsigned G = gridDim.x * gridDim.y * gridDim.z;
    unsigned sum, cnt, mine, sp = 0u;
    for (;;) {
        sum = 0u; cnt = 0u; mine = 0u;
#pragma unroll
        for (unsigned j = 0; j < 16; ++j) { const unsigned c = xb_ld(&bar[XB_XCNT(j)]); sum += c; cnt += (c > 0u) ? 1u : 0u; mine = (j == x) ? c : mine; }
        if (sum == G) break;
        __builtin_amdgcn_s_sleep(1);
        if ((++sp & 255u) == 0u) { if (xb_ld(&bar[XB_TMO])) break; if (sp > XB_SPIN_CAP) { atomicAdd(&bar[XB_TMO], 1u); break; } }
    }
    nloc = mine > 0u ? mine : 1u; nx = cnt > 0u ? cnt : 1u;
}

__device__ __forceinline__ void xcd_barrier(const XcdBarrier& b, bool leader) {
    asm volatile("s_waitcnt vmcnt(0)" ::: "memory");
    __syncthreads();
    if (leader) {
        unsigned* bar = b.bar;
        __builtin_amdgcn_s_waitcnt(0);
        unsigned nloc = b.st[0], nx = b.st[1];
        if (nloc == 0u) { xcd_barrier_complete(bar, b.x, nloc, nx); b.st[0] = nloc; b.st[1] = nx; }
        const unsigned old = xb_add(&bar[XB_XSUB(b.x)], 1u);
        const unsigned gen = old / nloc;
        if (old + 1u == (gen + 1u) * nloc) {
            __builtin_amdgcn_fence(__ATOMIC_RELEASE, "agent");
            asm volatile("s_waitcnt vmcnt(0)" ::: "memory");
            const unsigned og = xb_add(&bar[XB_TOP], 1u);
            const unsigned tg = og / nx;
            if (og + 1u == (tg + 1u) * nx) xb_add(&bar[XB_TOPGEN], 1u);
            else XB_SPIN(xb_ld(&bar[XB_TOPGEN]) == tg, bar);
            __builtin_amdgcn_fence(__ATOMIC_ACQUIRE, "agent");
            xb_add(&bar[XB_XGEN(b.x)], 1u);
            asm volatile("s_waitcnt vmcnt(0)" ::: "memory");
        } else {
            XB_SPIN(xb_ld(&bar[XB_XGEN(b.x)]) == gen, bar);
            __builtin_amdgcn_fence(__ATOMIC_ACQUIRE, "agent");
            asm volatile("s_waitcnt vmcnt(0)" ::: "memory");
        }
    }
    __syncthreads();
}

__device__ __forceinline__ void attn_phase_dyn(const CAS Args* A, char* lds, unsigned* ctr, int tid, bool leader) {
    using attn_body::bf16;
    bf16* Q = (bf16*)(A->ws + WS_MIX) + 512; const bf16* K = (const bf16*)(A->ws + WS_KV); const bf16* V = K + 128;
    const int h0 = (int)(xb_xcc_id() & 7u);
    volatile LAS unsigned* slot = (volatile LAS unsigned*)((LAS unsigned char*)lds + 154368 + 64);
#pragma nounroll
    for (int qi = 0; qi < 8; ++qi) {
        const int h = (h0 + qi) & 7;
        for (;;) {
            if (leader) *slot = atomicAdd(ctr + h * 64, 1u);
            __syncthreads();
            const int k = (int)__builtin_amdgcn_readfirstlane((int)*slot);
            __syncthreads();
            if (k >= 320) break;
            if (k < 64) attn_body::attn_unit<8>(0, MP, h, k, Q, K, V, Q, lds, tid);
            else { const int ks = k - 64; attn_body::attn_unit<8>((long)MP + (long)(ks >> 4) * TSAMP, TSAMP, h, ks & 15, Q, K, V, Q, lds, tid); }
        }
    }
}
#ifndef STOP_AFTER
#define STOP_AFTER 99
#endif
__device__ __forceinline__ int fresh(int v) { asm volatile("" : "+s"(v)); return v; }
__device__ __forceinline__ int freshv(int v) { asm volatile("" : "+v"(v)); return v; }
__device__ __forceinline__ const CAS Args* get_args() { unsigned long long v = (unsigned long long)(uintptr_t)__builtin_amdgcn_kernarg_segment_ptr(); asm volatile("" : "+s"(v)); return (const CAS Args*)v; }
__global__ void __launch_bounds__(NWAVES * 64, 2) hymba_fwd(Args args_unused) {
    extern __shared__ __attribute__((aligned(16))) unsigned char lds[];
    cg::grid_group grid = cg::this_grid();
    const int wave = __builtin_amdgcn_readfirstlane((int)threadIdx.x >> 6), G = gridDim.x;
#define LANE_() ({ int z_ = 0; asm volatile("" : "+s"(z_)); (int)__builtin_amdgcn_mbcnt_hi(~0u, __builtin_amdgcn_mbcnt_lo(~0u, (unsigned)z_)); })
#define lane LANE_()
#define tid (wave * 64 + LANE_())
    LAS unsigned char* l3 = (LAS unsigned char*)lds;
    volatile LAS unsigned* xmisc = (volatile LAS unsigned*)(l3 + 154368);
    if (wave == 0 && LANE_() == 0) { xmisc[0] = 0u; xmisc[1] = 0u; }
    __syncthreads();
    (void)xcd_barrier_post((unsigned*)(get_args()->ws + WS_CTL), xmisc, wave == 0 && LANE_() == 0);
#ifdef USE_CG_SYNC
#define GSYNC() do { grid.sync(); } while (0)
#else
#define GSYNC() do { XcdBarrier b_; b_.bar = (unsigned*)(get_args()->ws + WS_CTL); b_.x = xb_xcc_id(); b_.st = (volatile LAS unsigned*)((LAS unsigned char*)lds + 154368); xcd_barrier(b_, fresh(wave) == 0 && LANE_() == 0); } while (0)
#endif
#ifdef EXP_READOUT
    { const CAS Args* a = get_args(); if (blockIdx.x == 0 && tid == 0) { const float v = a->out[EXP_READOUT]; if (v == 123.456f) ((float*)(a->ws + WS_MOD))[0] = v; } }
#ifdef EXP_READALL
    { const CAS Args* a = get_args(); float acc = 0.f; for (size_t i = (size_t)blockIdx.x * 512 + tid; i < (size_t)MT * D; i += (size_t)gridDim.x * 512) acc += a->out[i]; if (acc == 123.456f) ((float*)(a->ws + WS_MOD))[1] = acc; }
#endif
#endif
    { const CAS Args* a = get_args(); p0_mod(a, l3, tid); p0_prologue(a, l3, wave, freshv(lane), fresh(G)); }
#ifdef DUP_P0
    __syncthreads(); { const CAS Args* a = get_args(); p0_mod(a, l3, tid); p0_prologue(a, l3, wave, freshv(lane), fresh(G)); }
#endif
    GSYNC(); if (STOP_AFTER == 0) return;
#pragma nounroll
    for (int l0 = 0; l0 < DEPTH; ++l0) {
        int l = l0; asm volatile("" : "+s"(l));
        { const CAS Args* a = get_args(); unsigned char* ws = a->ws; float* out = a->out;
          const float* xp = l == 0 ? a->in[0] : out; const float* xs = l == 0 ? a->in[1] : out + (size_t)MP * D;
          norm_phase(xp, xs, a->in[6] + l * D, (const float*)(ws + WS_MOD) + (size_t)l * 6144, (bf16*)(ws + WS_XN), wave, freshv(lane), fresh(G));
#ifdef DUP_NORM
          norm_phase(xp, xs, a->in[6] + l * D, (const float*)(ws + WS_MOD) + (size_t)l * 6144, (bf16*)(ws + WS_XN), wave, freshv(lane), fresh(G));
#endif
        }
        GSYNC(); if (STOP_AFTER == 1) return;
        { const CAS Args* a = get_args(); unsigned char* ws = a->ws;
          pg8::Gemm g{(const bf16*)(ws + WS_XN), (const bf16*)(ws + WS_WIN) + (size_t)l * NINP * D, MT, NINP, D}; pg8::StaticOrder S; S.init(MT, NINP, fresh(G), fresh((int)blockIdx.x));
          pg8::EpiInProj E{(bf16*)(ws + WS_PROJ), (bf16*)(ws + WS_MIX), (bf16*)(ws + WS_KV)};
          pg8::gemm_phase<pg8::EpiInProj, pg8::StaticOrder, PG8_ALIGN, PG8_SP2>(l3, g, S, E, tid);
#ifdef DUP_GEMM
          __syncthreads(); pg8::gemm_phase<pg8::EpiInProj, pg8::StaticOrder, PG8_ALIGN, PG8_SP2>(l3, g, S, E, tid);
#endif
        }
        GSYNC(); if (STOP_AFTER == 2) return;
        { const CAS Args* a = get_args(); unsigned char* ws = a->ws;
          qk_prep_phase((bf16*)(ws + WS_MIX), (bf16*)(ws + WS_KV), a->in[20] + l * 64, a->in[21] + l * 64, wave, freshv(lane), fresh(G)); }
#ifndef NO_SCANA
        scan_phase<false>(get_args(), l3, l, wave, freshv(lane), fresh(G));
#endif
#ifdef DUP_SCANA
        scan_phase<false>(get_args(), l3, l, wave, freshv(lane), fresh(G));
#endif
        GSYNC(); if (STOP_AFTER == 3) return;
#ifndef NO_SCANB
        scanB_phase(get_args(), l3, wave, freshv(lane), fresh(G));
#endif
        __syncthreads();
        { const CAS Args* a = get_args(); attn_phase_dyn(a, (char*)lds, (unsigned*)(a->ws + WS_CTL) + 4096 + l * 1024, tid, fresh(wave) == 0 && LANE_() == 0); }
        GSYNC(); if (STOP_AFTER == 4) return;

#ifdef EXP_SLOAD
        probe_sload(get_args(), wave, freshv(lane), fresh(G));
#endif
#ifndef NO_SCANC
        scan_phase<true>(get_args(), l3, l, wave, freshv(lane), fresh(G));
#endif
#ifdef DUP_SCANC
        scan_phase<true>(get_args(), l3, l, wave, freshv(lane), fresh(G));
#endif
        GSYNC(); if (STOP_AFTER == 5) return;
#ifndef NO_POST
        post_phase(get_args(), l, wave, freshv(lane), fresh(G));
#endif
#ifdef DUP_POST
        post_phase(get_args(), l, wave, freshv(lane), fresh(G));
#endif
        GSYNC(); if (STOP_AFTER == 6) return;
#ifndef NO_P7
        { const CAS Args* a = get_args(); unsigned char* ws = a->ws; float* out = a->out;
          const float* xp = l == 0 ? a->in[0] : out; const float* xs = l == 0 ? a->in[1] : out + (size_t)MP * D;
          pg8::Gemm g{(const bf16*)(ws + WS_MIX), (const bf16*)(ws + WS_WOUT) + (size_t)l * D * D, MT, D, D}; pg8::StaticOrder S; S.init(MT, D, fresh(G), fresh((int)blockIdx.x));
          pg8::EpiResid E{xp, xs, out, (const float*)(ws + WS_MOD) + (size_t)l * 6144 + 2048};
          pg8::gemm_phase<pg8::EpiResid, pg8::StaticOrder, PG8_ALIGN, PG8_SP2>(l3, g, S, E, tid); }
#endif
        GSYNC(); if (STOP_AFTER == 7) return;
        { const CAS Args* a = get_args(); unsigned char* ws = a->ws; float* out = a->out;
          norm_phase(out, out + (size_t)MP * D, a->in[7] + l * D, (const float*)(ws + WS_MOD) + (size_t)l * 6144 + 3072, (bf16*)(ws + WS_XN), wave, freshv(lane), fresh(G)); }
        GSYNC(); if (STOP_AFTER == 8) return;
        { const CAS Args* a = get_args(); unsigned char* ws = a->ws;
          pg8::Gemm g{(const bf16*)(ws + WS_XN), (const bf16*)(ws + WS_WFFI) + (size_t)l * 2 * DFF * D, MT, 2 * DFF, D}; pg8::StaticOrder S; S.init(MT, 2 * DFF, fresh(G), fresh((int)blockIdx.x));
          pg8::EpiSwiGLU E{(bf16*)(ws + WS_ACT)};
          pg8::gemm_phase<pg8::EpiSwiGLU, pg8::StaticOrder, PG8_ALIGN, PG8_SP2>(l3, g, S, E, tid);
#ifdef DUP_GEMM
          __syncthreads(); pg8::gemm_phase<pg8::EpiSwiGLU, pg8::StaticOrder, PG8_ALIGN, PG8_SP2>(l3, g, S, E, tid);
#endif
        }
        GSYNC(); if (STOP_AFTER == 9) return;
        { const CAS Args* a = get_args(); unsigned char* ws = a->ws; float* out = a->out;
          pg8::Gemm g{(const bf16*)(ws + WS_ACT), (const bf16*)(ws + WS_WFFO) + (size_t)l * D * DFF, MT, D, DFF}; pg8::StaticOrder S; S.init(MT, D, fresh(G), fresh((int)blockIdx.x));
          pg8::EpiResid E{out, out + (size_t)MP * D, out, (const float*)(ws + WS_MOD) + (size_t)l * 6144 + 5120};
          pg8::gemm_phase<pg8::EpiResid, pg8::StaticOrder, PG8_ALIGN, PG8_SP2>(l3, g, S, E, tid); }
        if (l0 + 1 < DEPTH) GSYNC();
    }
}

extern "C" void kernel_launch(void* const* d_in, const int* in_sizes, int n_in, void* d_out, int out_size, void* d_ws, size_t ws_size, hipStream_t stream) {
    static int grid = 0;
    if (grid == 0) {
        if (n_in != 25 || ws_size < WS_END) { fprintf(stderr, "kernel_launch: unexpected n_in %d / ws %zu\n", n_in, ws_size); grid = -1; return; }
        int dev = 0, cus = 0, per_cu = 0;
        hipGetDevice(&dev); hipDeviceGetAttribute(&cus, hipDeviceAttributeMultiprocessorCount, dev);
        if (hipFuncSetAttribute((const void*)hymba_fwd, hipFuncAttributeMaxDynamicSharedMemorySize, LDS_BYTES) != hipSuccess) { fprintf(stderr, "kernel_launch: hipFuncSetAttribute failed\n"); grid = -1; return; }
        if (hipOccupancyMaxActiveBlocksPerMultiprocessor(&per_cu, (const void*)hymba_fwd, NWAVES * 64, LDS_BYTES) != hipSuccess || per_cu < 1) { fprintf(stderr, "kernel_launch: occupancy query says %d\n", per_cu); per_cu = 1; }
        (void)hipGetLastError();
        grid = cus * 1;
    }
    if (grid < 0) return;
    if (hipMemsetAsync((char*)d_ws + WS_CTL, 0, 32768, stream) != hipSuccess) { fprintf(stderr, "kernel_launch: memset failed\n"); return; }
    Args a{};
    for (int i = 0; i < 25; ++i) a.in[i] = (const float*)d_in[i];
    a.out = (float*)d_out; a.ws = (unsigned char*)d_ws;
    void* kargs[] = {&a};
    hipError_t e = hipLaunchCooperativeKernel((const void*)hymba_fwd, dim3(grid), dim3(NWAVES * 64), kargs, LDS_BYTES, stream);
    if (e != hipSuccess) fprintf(stderr, "cooperative launch failed: %s (grid %d)\n", hipGetErrorString(e), grid);
}
```

```cpp
#include <hip/hip_runtime.h>
#include <hip/hip_cooperative_groups.h>
#include <cstdio>
#include <cstdint>
namespace pg8 {
#define PG8_LAS __attribute__((address_space(3)))
typedef unsigned short bf16_t;
typedef short bf16x8 __attribute__((ext_vector_type(8)));
typedef float f32x4 __attribute__((ext_vector_type(4)));
typedef unsigned u32x4 __attribute__((ext_vector_type(4)));
constexpr int BM = 256, BK = 64, HALF = 128, HTB = HALF * BK * 2  , STAGE_BYTES = 8 * HTB, NXCD = 8, WGM = 8;

__host__ __device__ __forceinline__ int lds_byte(int r, int c) { const int st = (r >> 4) * 2 + (c >> 5), rr = r & 15, cc = c & 31, ob = rr * 64 + cc * 2; return st * 1024 + (ob ^ (((ob >> 9) & 1) << 5)); }
__host__ __device__ __forceinline__ void stage_rc(int b, int& R, int& C) { const int st = b / 1024, sb = b % 1024, swz = sb ^ (((sb >> 9) & 1) << 5); R = (st >> 1) * 16 + swz / 64; C = (st & 1) * 32 + (swz % 64) / 2; }
__host__ __device__ __forceinline__ int perm32(int rho) { const int n = rho >> 4, i = rho & 15; return 8 * (i >> 2) + 4 * n + (i & 3); }

struct Unit { int pm, pn; };
struct Gemm { const bf16_t* A; const bf16_t* Bt; int M, N, K; };

struct StaticOrder {
    int nM, nN, nwg, G, c;
    __host__ __device__ void init(int M, int N, int G_, int c_) { nM = M / BM; nN = N / BM; nwg = nM * nN; G = G_; c = c_; }
    __host__ __device__ bool next(int i, Unit& u) const {
        const int L = i * G + c; if (L >= nwg) return false;
        int wgid = (int)L; { const int q = nwg / NXCD, r = nwg % NXCD, xcd = wgid % NXCD, off = wgid / NXCD; wgid = (xcd < r ? xcd * (q + 1) : r * (q + 1) + (xcd - r) * q) + off; }
        const int nig = WGM * nN, gid = wgid / nig, fm = gid * WGM, gsz = (nM - fm) < WGM ? (nM - fm) : WGM;
        u.pm = fm + ((wgid % nig) % gsz); u.pn = (wgid % nig) / gsz; return true;
    }
    __device__ __forceinline__ void a_ready(const Unit&) const {}
    __device__ __forceinline__ void done(const Unit&) const {}
};

__device__ __forceinline__ unsigned cvt_pk_bf16(float lo, float hi) { unsigned r; asm volatile("v_cvt_pk_bf16_f32 %0, %1, %2" : "=v"(r) : "v"(lo), "v"(hi)); return r; }
struct EpiInProj {
    static constexpr bool PERM = true, AFTER_DRAIN = false;
    bf16_t* projR; bf16_t* mixin; bf16_t* kv;
    __device__ __forceinline__ void operator()(const f32x4 (&acc)[2][2][4][2], const Unit& u, int wr, int wc, int fr, int fq) const {
        const int pn = u.pn; bf16_t* base; int ldc, colt;
        if (pn < 6) { base = projR; ldc = 2048; colt = pn * 256; }
        else if (pn < 8) { base = mixin; ldc = 1024; colt = 512 + (pn - 6) * 256; }
        else if (pn == 8) { base = kv; ldc = 256; colt = 0; }
        else { base = projR; ldc = 2048; colt = 1536 + (pn - 9) * 256; }
        const int row0 = u.pm * BM + wr * 64 + fr, col0 = colt + wc * 32 + 8 * fq;
#pragma unroll
        for (int ai = 0; ai < 2; ++ai)
#pragma unroll
            for (int m = 0; m < 4; ++m) { bf16_t* rowp = base + (size_t)(row0 + ai * HALF + m * 16) * ldc + col0;
#pragma unroll
                for (int bj = 0; bj < 2; ++bj) { const f32x4 v0 = acc[ai][bj][m][0], v1 = acc[ai][bj][m][1];
                    u32x4 w; w.x = cvt_pk_bf16(v0[0], v0[1]); w.y = cvt_pk_bf16(v0[2], v0[3]); w.z = cvt_pk_bf16(v1[0], v1[1]); w.w = cvt_pk_bf16(v1[2], v1[3]);
                    *(u32x4*)(rowp + bj * HALF) = w; } }
    }
};
struct EpiResid {
    static constexpr bool PERM = false, AFTER_DRAIN = false;
    const float* xp; const float* xs; float* out; const float* gate;
    __device__ __forceinline__ void operator()(const f32x4 (&acc)[2][2][4][2], const Unit& u, int wr, int wc, int fr, int fq) const {
        const int seq = u.pm < 64 ? 0 : 1 + ((u.pm - 64) >> 4);
        const float* gp = gate + (size_t)seq * 12288;
        const int col0 = u.pn * BM + wc * 32 + 4 * fq;
        f32x4 gv[2][2];
#pragma unroll
        for (int bj = 0; bj < 2; ++bj)
#pragma unroll
            for (int n = 0; n < 2; ++n) gv[bj][n] = *(const f32x4*)(gp + col0 + bj * HALF + n * 16);

#ifdef EXP_XOUT
        const float* xb = out;
#else
        const float* xb = u.pm < 64 ? xp : xs - (size_t)16384 * 1024;
#endif

#pragma unroll
        for (int ai = 0; ai < 2; ++ai) {
            f32x4 bsv[4][2][2];
#pragma unroll
            for (int m = 0; m < 4; ++m) { const size_t off = (size_t)(u.pm * BM + ai * HALF + wr * 64 + m * 16 + fr) * 1024 + col0;
#pragma unroll
                for (int bj = 0; bj < 2; ++bj)
#pragma unroll
                    for (int n = 0; n < 2; ++n) bsv[m][bj][n] = *(const f32x4*)(xb + off + bj * HALF + n * 16); }
            asm volatile("" ::: "memory");
#pragma unroll
            for (int m = 0; m < 4; ++m) { const size_t off = (size_t)(u.pm * BM + ai * HALF + wr * 64 + m * 16 + fr) * 1024 + col0;
#pragma unroll
                for (int bj = 0; bj < 2; ++bj)
#pragma unroll
                    for (int n = 0; n < 2; ++n) *(f32x4*)(out + off + bj * HALF + n * 16) = bsv[m][bj][n] + gv[bj][n] * acc[ai][bj][m][n]; }
            asm volatile("" ::: "memory");
        }
    }
};
struct EpiSwiGLU {
    static constexpr bool PERM = true, AFTER_DRAIN = false;
    bf16_t* act;
    __device__ __forceinline__ void operator()(const f32x4 (&acc)[2][2][4][2], const Unit& u, int wr, int wc, int fr, int fq) const {
        const int row0 = u.pm * BM + wr * 64 + fr, col0 = u.pn * 128 + wc * 32 + 8 * fq;
#pragma unroll
        for (int ai = 0; ai < 2; ++ai)
#pragma unroll
            for (int m = 0; m < 4; ++m) { bf16_t* rowp = act + (size_t)(row0 + ai * HALF + m * 16) * 2816 + col0;
                float o[8];
#pragma unroll
                for (int n = 0; n < 2; ++n)
#pragma unroll
                    for (int i = 0; i < 4; ++i) { const float g = acc[ai][0][m][n][i], up = acc[ai][1][m][n][i];
                        o[n * 4 + i] = g * __builtin_amdgcn_rcpf(1.0f + __builtin_amdgcn_exp2f(-1.4426950408889634f * g)) * up; }
                u32x4 w; w.x = cvt_pk_bf16(o[0], o[1]); w.y = cvt_pk_bf16(o[2], o[3]); w.z = cvt_pk_bf16(o[4], o[5]); w.w = cvt_pk_bf16(o[6], o[7]);
                *(u32x4*)rowp = w; }
    }
};
template <class Epi, class Sched, bool ALIGN_EPI = false, bool SP2 = false>
__device__ __forceinline__ void gemm_phase(PG8_LAS unsigned char* lds, const Gemm g, const Sched& S, const Epi& E, int tid_in) {
    int tid_ = tid_in; asm volatile("" : "+v"(tid_)); const int tid = tid_, wid = __builtin_amdgcn_readfirstlane(tid >> 6), lane = tid & 63, wr = wid >> 2, wc = wid & 3, fr = lane & 15, fq = lane >> 4;
    const int K = g.K, nt = K / BK;
    unsigned voffA[2], voffB[2];
#pragma unroll
    for (int i = 0; i < 2; ++i) { int R, C; stage_rc(tid * 16 + i * 8192, R, C); const int Rb = Epi::PERM ? ((R & ~31) + perm32(R & 31)) : R;
        voffA[i] = (unsigned)(R * K + C) * 2u; voffB[i] = (unsigned)(Rb * K + C) * 2u; }
    const size_t kstep = (size_t)(BK * 2);
    const size_t hstep = (size_t)HALF * K * 2;
    const size_t tstep = 2 * hstep;
    const unsigned ldsw = (unsigned)wid * 1024u;
    const int aoff = lds_byte(wr * 64 + fr, fq * 8), boff = lds_byte(wc * 32 + fr, fq * 8);
#define PG8_SA(b, h) (((b) * 2 + (h)) * HTB)
#define PG8_SB(b, h) ((4 + (b) * 2 + (h)) * HTB)
#define PG8_STAGE(bufoff, gbase, voff) do { _Pragma("unroll") for (int _i = 0; _i < 2; ++_i) \
        __builtin_amdgcn_global_load_lds((const unsigned*)((const char*)(gbase) + (voff)[_i]), (PG8_LAS unsigned*)(lds + (bufoff) + ldsw + _i * 8192), 16, 0, 0); } while (0)
#define PG8_LDA(dst, b, h) do { _Pragma("unroll") for (int m = 0; m < 4; ++m) _Pragma("unroll") for (int k = 0; k < 2; ++k) dst[m][k] = *(const PG8_LAS bf16x8*)(lds + PG8_SA(b, h) + aoff + m * 2048 + k * 1024); } while (0)
#define PG8_LDB(dst, b, h) do { _Pragma("unroll") for (int n = 0; n < 2; ++n) _Pragma("unroll") for (int k = 0; k < 2; ++k) dst[n][k] = *(const PG8_LAS bf16x8*)(lds + PG8_SB(b, h) + boff + n * 2048 + k * 1024); } while (0)
#define PG8_MMA(ai, bj, At, Bt) do { __builtin_amdgcn_s_setprio(1); _Pragma("unroll") for (int m = 0; m < 4; ++m) _Pragma("unroll") for (int n = 0; n < 2; ++n) _Pragma("unroll") for (int k = 0; k < 2; ++k) \
        acc[ai][bj][m][n] = __builtin_amdgcn_mfma_f32_16x16x32_bf16(Bt[n][k], At[m][k], acc[ai][bj][m][n], 0, 0, 0); __builtin_amdgcn_s_setprio(0); } while (0)
#define PG8_WAIT_V(n) asm volatile("s_waitcnt vmcnt(" #n ")" ::: "memory")
#define PG8_WAIT_L(n) asm volatile("s_waitcnt lgkmcnt(" #n ")" ::: "memory")
#define PG8_BAR __builtin_amdgcn_s_barrier()
#define PG8_SCHED __builtin_amdgcn_sched_barrier(0)
    Unit cur, nxt; int ui = 0;
    if (!S.next(0, cur)) return;
    f32x4 acc[2][2][4][2];
#pragma unroll
    for (int a = 0; a < 2; ++a)
#pragma unroll
        for (int b = 0; b < 2; ++b)
#pragma unroll
            for (int m = 0; m < 4; ++m)
#pragma unroll
                for (int n = 0; n < 2; ++n) acc[a][b][m][n] = (f32x4){0.f, 0.f, 0.f, 0.f};
    bf16x8 At[4][2], B0[2][2], B1[2][2];
    const char* cA = (const char*)g.A + (size_t)cur.pm * tstep; const char* cB = (const char*)g.Bt + (size_t)cur.pn * tstep;
    S.a_ready(cur);
    if constexpr (SP2) {
        PG8_STAGE(PG8_SB(0, 0), cB, voffB); PG8_STAGE(PG8_SB(0, 1), cB + hstep, voffB); PG8_STAGE(PG8_SA(0, 0), cA, voffA); PG8_STAGE(PG8_SA(0, 1), cA + hstep, voffA);
        if (wr == 1) PG8_BAR;
        PG8_WAIT_V(2); PG8_BAR;
        PG8_STAGE(PG8_SB(1, 0), cB + kstep, voffB); PG8_STAGE(PG8_SA(1, 0), cA + kstep, voffA); PG8_STAGE(PG8_SB(1, 1), cB + hstep + kstep, voffB);
        PG8_WAIT_V(6); PG8_BAR;
    } else {
        PG8_STAGE(PG8_SB(0, 0), cB, voffB); PG8_STAGE(PG8_SA(0, 0), cA, voffA); PG8_STAGE(PG8_SB(0, 1), cB + hstep, voffB); PG8_STAGE(PG8_SA(0, 1), cA + hstep, voffA);
        if (wr == 1) PG8_BAR;
        PG8_WAIT_V(4); PG8_BAR;
        PG8_STAGE(PG8_SB(1, 0), cB + kstep, voffB); PG8_STAGE(PG8_SA(1, 0), cA + kstep, voffA); PG8_STAGE(PG8_SB(1, 1), cB + hstep + kstep, voffB);
        PG8_WAIT_V(6); PG8_BAR;
    }
    for (;;) {
        const bool has_next = S.next(ui + 1, nxt);
        const char* nA = has_next ? (const char*)g.A + (size_t)nxt.pm * tstep : cA; const char* nB = has_next ? (const char*)g.Bt + (size_t)nxt.pn * tstep : cB;
        for (int t = 0; t < nt; t += 2) {
            const bool last = (t == nt - 2);
            const char* a1 = cA + (size_t)(t + 1) * kstep;
            const char* a2 = last ? nA : cA + (size_t)(t + 2) * kstep; const char* b2 = last ? nB : cB + (size_t)(t + 2) * kstep;
            const char* a3 = a2 + kstep; const char* b3 = b2 + kstep;
            if (last && has_next) S.a_ready(nxt);
            if constexpr (SP2) {
            PG8_LDB(B0, 0, 0); PG8_LDB(B1, 0, 1); PG8_SCHED; PG8_LDA(At, 0, 0); PG8_STAGE(PG8_SA(1, 1), a1 + hstep, voffA);
            PG8_WAIT_V(8); PG8_WAIT_L(0); PG8_BAR; PG8_MMA(0, 0, At, B0); PG8_MMA(0, 1, At, B1); PG8_BAR; PG8_SCHED;
            PG8_LDA(At, 0, 1); PG8_STAGE(PG8_SB(0, 0), b2, voffB); PG8_STAGE(PG8_SB(0, 1), b2 + hstep, voffB); PG8_STAGE(PG8_SA(0, 0), a2, voffA);
            PG8_WAIT_V(8); PG8_WAIT_L(0); PG8_BAR; PG8_MMA(1, 0, At, B0); PG8_MMA(1, 1, At, B1); PG8_BAR; PG8_SCHED;
            PG8_LDB(B0, 1, 0); PG8_LDB(B1, 1, 1); PG8_SCHED; PG8_LDA(At, 1, 0); PG8_STAGE(PG8_SA(0, 1), a2 + hstep, voffA);
            PG8_WAIT_V(8); PG8_WAIT_L(0); PG8_BAR; PG8_MMA(0, 0, At, B0); PG8_MMA(0, 1, At, B1); PG8_BAR; PG8_SCHED;
            PG8_LDA(At, 1, 1); PG8_STAGE(PG8_SB(1, 0), b3, voffB); PG8_STAGE(PG8_SB(1, 1), b3 + hstep, voffB); PG8_STAGE(PG8_SA(1, 0), a3, voffA);
            PG8_WAIT_V(8); PG8_WAIT_L(0); PG8_BAR; PG8_MMA(1, 0, At, B0); PG8_MMA(1, 1, At, B1); PG8_BAR; PG8_SCHED;
            } else {
            PG8_LDB(B0, 0, 0); PG8_SCHED; PG8_LDA(At, 0, 0); PG8_STAGE(PG8_SA(1, 1), a1 + hstep, voffA);
            PG8_WAIT_L(8); PG8_BAR; PG8_WAIT_L(0); PG8_MMA(0, 0, At, B0); PG8_BAR; PG8_SCHED;
            PG8_LDB(B1, 0, 1); PG8_STAGE(PG8_SB(0, 0), b2, voffB);
            PG8_BAR; PG8_WAIT_L(0); PG8_MMA(0, 1, At, B1); PG8_BAR;
            PG8_LDA(At, 0, 1); PG8_STAGE(PG8_SA(0, 0), a2, voffA);
            PG8_BAR; PG8_WAIT_L(0); PG8_MMA(1, 0, At, B0); PG8_BAR; PG8_SCHED;
            PG8_STAGE(PG8_SB(0, 1), b2 + hstep, voffB);
            PG8_WAIT_V(6); PG8_BAR; PG8_MMA(1, 1, At, B1); PG8_BAR;
            PG8_LDB(B0, 1, 0); PG8_SCHED; PG8_LDA(At, 1, 0); PG8_STAGE(PG8_SA(0, 1), a2 + hstep, voffA);
            PG8_WAIT_L(8); PG8_BAR; PG8_WAIT_L(0); PG8_MMA(0, 0, At, B0); PG8_BAR; PG8_SCHED;
            PG8_LDB(B1, 1, 1); PG8_STAGE(PG8_SB(1, 0), b3, voffB);
            PG8_BAR; PG8_WAIT_L(0); PG8_MMA(0, 1, At, B1); PG8_BAR;
            PG8_LDA(At, 1, 1); PG8_STAGE(PG8_SA(1, 0), a3, voffA);
            PG8_BAR; PG8_WAIT_L(0); PG8_MMA(1, 0, At, B0); PG8_BAR; PG8_SCHED;
            PG8_STAGE(PG8_SB(1, 1), b3 + hstep, voffB);
            PG8_WAIT_V(6); PG8_BAR; PG8_MMA(1, 1, At, B1); PG8_BAR;
            }
        }
        if constexpr (ALIGN_EPI) { if (wr == 0) PG8_BAR; }
        if constexpr (!Epi::AFTER_DRAIN) { E(acc, cur, wr, wc, fr, fq); S.done(cur); }
        if (!has_next) break;
#pragma unroll
        for (int a = 0; a < 2; ++a)
#pragma unroll
            for (int b = 0; b < 2; ++b)
#pragma unroll
                for (int m = 0; m < 4; ++m)
#pragma unroll
                    for (int n = 0; n < 2; ++n) acc[a][b][m][n] = (f32x4){0.f, 0.f, 0.f, 0.f};
        cur = nxt; cA = nA; cB = nB; ++ui;
        if constexpr (ALIGN_EPI) { if (wr == 1) PG8_BAR; }
    }
    PG8_WAIT_V(0);
    if constexpr (!ALIGN_EPI) { if (wr == 0) PG8_BAR; }
    PG8_BAR;
    if constexpr (Epi::AFTER_DRAIN) { E.fused(acc, cur, wr, wc, fr, fq, lds, wid, lane); S.done(cur); }
#undef PG8_SA
#undef PG8_SB
#undef PG8_STAGE
#undef PG8_LDA
#undef PG8_LDB
#undef PG8_MMA
#undef PG8_WAIT_V
#undef PG8_WAIT_L
#undef PG8_BAR
#undef PG8_SCHED
}
}

#ifndef PG8_SP2
#define PG8_SP2 true
#endif
#ifndef PG8_ALIGN
#define PG8_ALIGN true
#endif
#include <hip/hip_bf16.h>
#include <cmath>
namespace attn_body {
using bf16=__hip_bfloat16;
using bf16x8=__attribute__((ext_vector_type(8)))short;
using s16x4=__attribute__((ext_vector_type(4)))short;
using f32x16=__attribute__((ext_vector_type(16)))float;
using u32x4=__attribute__((ext_vector_type(4)))unsigned;
constexpr int D=64,QP=1024,KVP=256;
constexpr int NW=8,QBLK=32,QB=QBLK*NW,KVBLK=64;
constexpr int ATTN_UNIT_ROWS=QB;
__device__ __forceinline__ int crow(int r,int hi){return (r&3)+8*(r>>2)+4*hi;}
#define SBAR() __builtin_amdgcn_sched_barrier(0)
__device__ __forceinline__ void cmask(f32x16&p0,f32x16&p1,int jb,int qrel,int hi){
  const float NEG=-INFINITY; int kb=64*jb+4*hi;
  #pragma unroll
  for(int r=0;r<16;++r){int kv=kb+(r&3)+8*(r>>2); if(kv>qrel)p0[r]=NEG; if(kv+32>qrel)p1[r]=NEG;}
}

constexpr int NSLOT=3, SLOTB=8192;
constexpr int LDS_K=0, LDS_V=NSLOT*SLOTB, LDS_WS=2*NSLOT*SLOTB, LDS_OST=LDS_WS+NW*64*4, LDS_BYTES=LDS_OST+NW*4096;
constexpr float C2=0.125f*1.4426950408889634f;
__device__ __forceinline__ void glds16(const void*gsrc,unsigned lds_dst){unsigned keep;
  asm volatile("s_mov_b32 %0, m0\n\ts_mov_b32 m0, %2\n\ts_nop 0\n\tglobal_load_lds_dwordx4 %1, off\n\ts_mov_b32 m0, %0":"=&s"(keep):"v"(gsrc),"s"(lds_dst):"memory");}
__device__ __forceinline__ float max3f(float a,float b,float c){float r;asm("v_max3_f32 %0, %1, %2, %3":"=v"(r):"v"(a),"v"(b),"v"(c));return r;}
__device__ __forceinline__ float max2f(float a,float b){float r;asm("v_max_f32_e32 %0, %1, %2":"=v"(r):"v"(a),"v"(b));return r;}
__device__ __forceinline__ float fadd_s(float a,float b){float r;asm("v_add_f32_e32 %0, %1, %2":"=v"(r):"v"(a),"v"(b));return r;}
__device__ __forceinline__ float fsub_s(float a,float b){float r;asm("v_sub_f32_e32 %0, %1, %2":"=v"(r):"v"(a),"v"(b));return r;}
typedef float f32x2_t __attribute__((ext_vector_type(2))); typedef __bf16 bf16x2_t __attribute__((ext_vector_type(2)));
__device__ __forceinline__ unsigned cvtpk_s(float lo,float hi){f32x2_t v={lo,hi};bf16x2_t b=__builtin_convertvector(v,bf16x2_t);return __builtin_bit_cast(unsigned,b);}
#define WAIT_BAR(N) asm volatile("s_waitcnt vmcnt(" #N ") lgkmcnt(0)\n\ts_barrier":::"memory")

__device__ __forceinline__ void qkt(f32x16&p0,f32x16&p1,const char*Kslot,const bf16x8*qr,const f32x16&negm,int r32,int hi){
  const char*kb=Kslot+hi*1024+r32*16;
  #pragma unroll
  for(int d0=0;d0<4;++d0){
    const bf16x8 b0=*reinterpret_cast<const bf16x8*>(kb+d0*2048);
    const bf16x8 b1=*reinterpret_cast<const bf16x8*>(kb+d0*2048+512);
    if(d0==0){p0=__builtin_amdgcn_mfma_f32_32x32x16_bf16(b0,qr[0],negm,0,0,0);p1=__builtin_amdgcn_mfma_f32_32x32x16_bf16(b1,qr[0],negm,0,0,0);}
    else{p0=__builtin_amdgcn_mfma_f32_32x32x16_bf16(b0,qr[d0],p0,0,0,0);p1=__builtin_amdgcn_mfma_f32_32x32x16_bf16(b1,qr[d0],p1,0,0,0);}}
}
typedef __attribute__((address_space(3))) const char* lds_cptr;
typedef short v4i16_t __attribute__((ext_vector_type(4)));
__device__ __forceinline__ void kload8(bf16x8*kf,lds_cptr kp){
  kf[0]=*(const __attribute__((address_space(3))) bf16x8*)(kp);      kf[1]=*(const __attribute__((address_space(3))) bf16x8*)(kp+512);
  kf[2]=*(const __attribute__((address_space(3))) bf16x8*)(kp+2048); kf[3]=*(const __attribute__((address_space(3))) bf16x8*)(kp+2560);
  kf[4]=*(const __attribute__((address_space(3))) bf16x8*)(kp+4096); kf[5]=*(const __attribute__((address_space(3))) bf16x8*)(kp+4608);
  kf[6]=*(const __attribute__((address_space(3))) bf16x8*)(kp+6144); kf[7]=*(const __attribute__((address_space(3))) bf16x8*)(kp+6656);
}
__device__ __forceinline__ void kload2(bf16x8*kf,lds_cptr kp,int j){ kf[2*j]=*(const __attribute__((address_space(3))) bf16x8*)(kp+j*2048); kf[2*j+1]=*(const __attribute__((address_space(3))) bf16x8*)(kp+j*2048+512); }
__device__ __forceinline__ s16x4 vtr(lds_cptr p){ return __builtin_bit_cast(s16x4,__builtin_amdgcn_ds_read_tr16_b64_v4i16((__attribute__((address_space(3))) v4i16_t*)p)); }
__device__ __forceinline__ float rowmax(const f32x16&p0,const f32x16&p1){
  float a=max3f(p0[0],p0[1],p1[0]),b=max3f(p0[2],p0[3],p1[1]);a=max3f(a,p1[2],p1[3]);
  #pragma unroll
  for(int r=4;r<16;r+=4){a=max3f(a,p0[r],p0[r+1]);b=max3f(b,p0[r+2],p0[r+3]);a=max3f(a,p1[r],p1[r+1]);b=max3f(b,p1[r+2],p1[r+3]);}
  const float m=max2f(a,b);
  auto rr=__builtin_amdgcn_permlane32_swap(__float_as_uint(m),__float_as_uint(m),false,false);
  return max2f(__uint_as_float(rr[0]),__uint_as_float(rr[1]));
}
__device__ __forceinline__ void pv(f32x16*o,int vb,bf16x8 pa0,bf16x8 pa1,bf16x8 pa2,bf16x8 pa3){
  #pragma unroll
  for(int d0=0;d0<2;++d0){s16x4 lo[4],hi[4];
    #pragma unroll
    for(int ks=0;ks<4;++ks){
      asm volatile("ds_read_b64_tr_b16 %0,%1 offset:%c2":"=&v"(lo[ks]):"v"(vb),"i"(d0*4096+ks*1024):"memory");
      asm volatile("ds_read_b64_tr_b16 %0,%1 offset:%c2":"=&v"(hi[ks]):"v"(vb),"i"(d0*4096+ks*1024+512):"memory");}
    asm volatile("s_waitcnt lgkmcnt(0)":::"memory");SBAR();
    #define PK(k) (bf16x8){lo[k][0],lo[k][1],lo[k][2],lo[k][3],hi[k][0],hi[k][1],hi[k][2],hi[k][3]}
    o[d0]=__builtin_amdgcn_mfma_f32_32x32x16_bf16(pa0,PK(0),o[d0],0,0,0);
    o[d0]=__builtin_amdgcn_mfma_f32_32x32x16_bf16(pa1,PK(1),o[d0],0,0,0);
    o[d0]=__builtin_amdgcn_mfma_f32_32x32x16_bf16(pa2,PK(2),o[d0],0,0,0);
    o[d0]=__builtin_amdgcn_mfma_f32_32x32x16_bf16(pa3,PK(3),o[d0],0,0,0);
    #undef PK
  }
}

#ifndef ATTN_STORE16
#define ATTN_STORE16(p,v) (*(u32x4*)(p)=(v))
#endif
template<int THRL> __device__ __forceinline__ void attn_unit(long rowbase,int T,int h,int qb,const bf16*Q,const bf16*K,const bf16*V,bf16*O,char*shm,int tid_in){
  int tid_=tid_in; asm volatile("":"+v"(tid_)); const int tid=tid_,lane=tid&63,r32=lane&31,hi=lane>>5; const int wid=__builtin_amdgcn_readfirstlane(tid>>6);
  const int q0=qb*QB;
  const bf16*Qw=Q+(rowbase+q0+wid*QBLK)*QP+h*D;
  const bf16*Kh=K+rowbase*KVP+(h>>2)*D,*Vh=V+rowbase*KVP+(h>>2)*D;
  const unsigned lds0=(unsigned)(uintptr_t)shm;
  float*wsf=(float*)(shm+LDS_WS)+wid*64;
  const bf16*ksrc=Kh+(long)lane*KVP+wid*8;
  const bf16*vsrc=Vh+(long)(16*(wid&3)+(lane>>2))*KVP+(wid>>2)*32+(lane&3)*8;
  const unsigned kdst=lds0+LDS_K+wid*1024, vdst=lds0+LDS_V+wid*1024;
  #define DMA_K(t,slot) glds16(ksrc+(long)(t)*KVBLK*KVP,(unsigned)__builtin_amdgcn_readfirstlane(kdst+(slot)))
  #define DMA_V(t,slot) glds16(vsrc+(long)(t)*KVBLK*KVP,(unsigned)__builtin_amdgcn_readfirstlane(vdst+(slot)))
  const int vb0=(int)(lds0+LDS_V)+((lane>>4)&1)*32+(lane&3)*8+(4*hi+((lane&15)>>2))*64;
  const char*Kbase=shm+LDS_K; bf16x8 kf[8];
  const lds_cptr shm3=(lds_cptr)shm; const lds_cptr kp0=shm3+LDS_K+hi*1024+r32*16; const lds_cptr vp0=shm3+LDS_V+((lane>>4)&1)*32+(lane&3)*8+(4*hi+((lane&15)>>2))*64;
  const int NT=T/KVBLK;
  DMA_K(0,0);DMA_V(0,0);DMA_K(1,SLOTB);
  bf16x8 qr[4];
  #pragma unroll
  for(int d0=0;d0<4;++d0)qr[d0]=*reinterpret_cast<const bf16x8*>(&Qw[(long)r32*QP+d0*16+hi*8]);
  float mhat=0.f,l_reg=0.f;f32x16 o[2];o[0]=f32x16{};o[1]=f32x16{};f32x16 negm=f32x16{};asm volatile("":"+v"(negm));

  #define CMASK(P0,P1,t) do{}while(0)
  bool resc=false;
  #define START(P0,P1) do{ const float rm=rowmax(P0,P1); resc=false; \
    { const float dl=rm; mhat=fadd_s(mhat,dl); \
      _Pragma("unroll") for(int r=0;r<16;++r){P0[r]=fsub_s(P0[r],dl);P1[r]=fsub_s(P1[r],dl);} \
      _Pragma("unroll") for(int r=0;r<16;++r)negm[r]=-mhat; asm volatile("":"+v"(negm)); } \
    _Pragma("unroll") for(int r=0;r<16;++r)P0[r]=__builtin_amdgcn_exp2f(P0[r]); }while(0)
  #define RESC() do{ if(resc){ asm volatile("s_waitcnt lgkmcnt(0)":::"memory"); \
      _Pragma("unroll") for(int d_=0;d_<2;++d_) _Pragma("unroll") for(int r=0;r<16;++r)o[d_][r]*=wsf[crow(r,hi)]; } }while(0)
  f32x16 pA0,pA1,pB0,pB1;
  int sl_prev=0,sl_cur=0,sl_next=SLOTB;
  #define ROT() do{sl_prev=sl_cur;sl_cur=sl_next;sl_next=(sl_next==(NSLOT-1)*SLOTB)?0:sl_next+SLOTB;}while(0)
  DMA_K(2,2*SLOTB);
  WAIT_BAR(3);
  qkt(pA0,pA1,Kbase,qr,negm,r32,hi);asm volatile("s_nop 15\n\ts_nop 7":"+v"(pA0),"+v"(pA1));CMASK(pA0,pA1,0);
  START(pA0,pA1);
  _Pragma("unroll") for(int r=0;r<16;++r)pA1[r]=__builtin_amdgcn_exp2f(pA1[r]);
  WAIT_BAR(0);
  DMA_K(3,0);DMA_V(1,SLOTB);
  ROT();
  kload8(kf,kp0+sl_cur);
  WAIT_BAR(2);
  s16x4 vlo[8],vhi[8]; u32x4 pw0,pw1,pw2,pw3;
  #define PKW(P,B) cvtpk_s(P[B],P[B+1])
  #define PAF(k) __builtin_bit_cast(bf16x8,pw##k)
  #define VFR(i) (bf16x8){vlo[i][0],vlo[i][1],vlo[i][2],vlo[i][3],vhi[i][0],vhi[i][1],vhi[i][2],vhi[i][3]}
  #define PIN(x) asm volatile("":"+v"(x))
  #define MX3(a,b,c) __builtin_fmaxf(__builtin_fmaxf((a),(b)),(c))
  #define GAPA(MF,A0,A1,A2,A3,W0,W1,PW) do{ MF; sacc+=A0; sacc+=A1; sacc+=A2; sacc+=A3; PIN(sacc); W0; W1; PIN(PW); SBAR(); }while(0)
  #define EX(v) __builtin_amdgcn_exp2f(v)
  #define GAPB(MF,X,B) do{ MF; X[B]=EX(X[B]); X[B+1]=EX(X[B+1]); X[B+2]=EX(X[B+2]); X[B+3]=EX(X[B+3]); PIN(X); SBAR(); }while(0)
  #define VRD(i) do{ vlo[i]=vtr(vp_+(((i)>>2)*4096+((i)&3)*1024)); vhi[i]=vtr(vp_+(((i)>>2)*4096+((i)&3)*1024+512)); }while(0)
  #define KRD(G,j) do{ if(G){ kload2(kf,kp0+sl_next,j); SBAR(); } }while(0)
  #define STEP(C0,C1,P0,P1,t,GK,GV,GL) do{ SBAR(); \
    const lds_cptr vp_=vp0+sl_prev; \
    VRD(0); SBAR(); float sacc=(P0[0]+P0[1]); \
    GAPA(C0=__builtin_amdgcn_mfma_f32_32x32x16_bf16(kf[0],qr[0],negm,0,0,0), P0[2],P0[3],P0[4],P0[5],     pw0[0]=PKW(P0,0), pw0[1]=PKW(P0,2), pw0); \
    VRD(4); SBAR(); GAPA(C1=__builtin_amdgcn_mfma_f32_32x32x16_bf16(kf[1],qr[0],negm,0,0,0), P0[6],P0[7],P0[8],P0[9],     pw0[2]=PKW(P0,4), pw0[3]=PKW(P0,6), pw0); \
    VRD(1); SBAR(); GAPA(C0=__builtin_amdgcn_mfma_f32_32x32x16_bf16(kf[2],qr[1],C0,0,0,0),   P0[10],P0[11],P0[12],P0[13], pw1[0]=PKW(P0,8), pw1[1]=PKW(P0,10), pw1); \
    VRD(5); SBAR(); GAPA(C1=__builtin_amdgcn_mfma_f32_32x32x16_bf16(kf[3],qr[1],C1,0,0,0),   P0[14],P0[15],P1[0],P1[1],   pw1[2]=PKW(P0,12),pw1[3]=PKW(P0,14), pw1); \
    VRD(2); SBAR(); GAPA(C0=__builtin_amdgcn_mfma_f32_32x32x16_bf16(kf[4],qr[2],C0,0,0,0),   P1[2],P1[3],P1[4],P1[5],     pw2[0]=PKW(P1,0), pw2[1]=PKW(P1,2), pw2); \
    VRD(6); SBAR(); GAPA(C1=__builtin_amdgcn_mfma_f32_32x32x16_bf16(kf[5],qr[2],C1,0,0,0),   P1[6],P1[7],P1[8],P1[9],     pw2[2]=PKW(P1,4), pw2[3]=PKW(P1,6), pw2); \
    VRD(3); SBAR(); GAPA(C0=__builtin_amdgcn_mfma_f32_32x32x16_bf16(kf[6],qr[3],C0,0,0,0),   P1[10],P1[11],P1[12],P1[13], pw3[0]=PKW(P1,8), pw3[1]=PKW(P1,10), pw3); \
    VRD(7); SBAR(); GAPA(C1=__builtin_amdgcn_mfma_f32_32x32x16_bf16(kf[7],qr[3],C1,0,0,0),   P1[14],P1[15],0.f,0.f,       pw3[2]=PKW(P1,12),pw3[3]=PKW(P1,14), pw3); \
    l_reg+=sacc; \
    if(GK){DMA_K((t)+3,sl_cur);} if(GV){DMA_V((t)+1,sl_next);} \
    CMASK(C0,C1,t); \
    { float a=MX3(C0[0],C0[1],C1[0]),b=MX3(C0[2],C0[3],C1[1]); a=MX3(a,C1[2],C1[3]); \
      _Pragma("unroll") for(int r=4;r<16;r+=4){a=MX3(a,C0[r],C0[r+1]);b=MX3(b,C0[r+2],C0[r+3]);a=MX3(a,C1[r],C1[r+1]);b=MX3(b,C1[r+2],C1[r+3]);} \
      float rm=__builtin_fmaxf(a,b); { auto rr=__builtin_amdgcn_permlane32_swap(__float_as_uint(rm),__float_as_uint(rm),false,false); rm=__builtin_fmaxf(__uint_as_float(rr[0]),__uint_as_float(rr[1])); } \
      resc=false; \
      if(__builtin_expect(__any(rm>(float)THRL),0)){ const float dl=__builtin_fmaxf(rm,0.f); mhat+=dl; \
        _Pragma("unroll") for(int r=0;r<16;++r){C0[r]-=dl;C1[r]-=dl;} \
        _Pragma("unroll") for(int r=0;r<16;++r)negm[r]=-mhat; asm volatile("":"+v"(negm)); \
        const float f=__builtin_amdgcn_exp2f(-dl); l_reg*=f; if(hi==0)wsf[r32]=f; resc=true; } } \
    SBAR(); \
    GAPB(o[0]=__builtin_amdgcn_mfma_f32_32x32x16_bf16(PAF(0),VFR(0),o[0],0,0,0), C0,0); \
    GAPB(o[1]=__builtin_amdgcn_mfma_f32_32x32x16_bf16(PAF(0),VFR(4),o[1],0,0,0), C0,4); \
    KRD(GL,0); GAPB(o[0]=__builtin_amdgcn_mfma_f32_32x32x16_bf16(PAF(1),VFR(1),o[0],0,0,0), C0,8); \
    KRD(GL,1); GAPB(o[1]=__builtin_amdgcn_mfma_f32_32x32x16_bf16(PAF(1),VFR(5),o[1],0,0,0), C0,12); \
    KRD(GL,2); GAPB(o[0]=__builtin_amdgcn_mfma_f32_32x32x16_bf16(PAF(2),VFR(2),o[0],0,0,0), C1,0); \
    KRD(GL,3); GAPB(o[1]=__builtin_amdgcn_mfma_f32_32x32x16_bf16(PAF(2),VFR(6),o[1],0,0,0), C1,4); \
    GAPB(o[0]=__builtin_amdgcn_mfma_f32_32x32x16_bf16(PAF(3),VFR(3),o[0],0,0,0), C1,8); \
    GAPB(o[1]=__builtin_amdgcn_mfma_f32_32x32x16_bf16(PAF(3),VFR(7),o[1],0,0,0), C1,12); \
    }while(0)
  int t=1;
  #undef CMASK
  #define CMASK(P0,P1,t) do{}while(0)
  for(;t+5<NT;t+=2){
    STEP(pB0,pB1,pA0,pA1,t,true,true,true);     WAIT_BAR(2); RESC(); ROT();
    STEP(pA0,pA1,pB0,pB1,t+1,true,true,true);   WAIT_BAR(2); RESC(); ROT();
  }
  #undef CMASK
  #define CMASK(P0,P1,t) do{}while(0)
  #define ENDW(tt) do{ if((tt)+3<NT){WAIT_BAR(2);} else if((tt)+2<NT){WAIT_BAR(1);} else {WAIT_BAR(0);} }while(0)
  for(;t+1<NT;t+=2){
    STEP(pB0,pB1,pA0,pA1,t,(t+3<NT),(t+1<NT),(t+1<NT));       ENDW(t);   RESC(); ROT();
    STEP(pA0,pA1,pB0,pB1,t+1,(t+4<NT),(t+2<NT),(t+2<NT));     ENDW(t+1); RESC(); ROT();
  }
  STEP(pB0,pB1,pA0,pA1,NT-1,false,false,false); RESC();
  { float sacc=pB0[0]+pB0[1]; _Pragma("unroll") for(int r=2;r<16;++r)sacc+=pB0[r]; _Pragma("unroll") for(int r=0;r<16;++r)sacc+=pB1[r]; l_reg+=sacc;
    pw0=(u32x4){PKW(pB0,0),PKW(pB0,2),PKW(pB0,4),PKW(pB0,6)};pw1=(u32x4){PKW(pB0,8),PKW(pB0,10),PKW(pB0,12),PKW(pB0,14)};pw2=(u32x4){PKW(pB1,0),PKW(pB1,2),PKW(pB1,4),PKW(pB1,6)};pw3=(u32x4){PKW(pB1,8),PKW(pB1,10),PKW(pB1,12),PKW(pB1,14)};
    SBAR(); pv(o,vb0+sl_cur,PAF(0),PAF(1),PAF(2),PAF(3)); }
  #undef PKW
  #undef PAF
  #undef VFR
  #undef PIN
  #undef MX3
  #undef GAPA
  #undef GAPB
  #undef EX
  #undef VRD
  #undef KRD
  #undef STEP
  #undef ENDW
  {auto rr=__builtin_amdgcn_permlane32_swap(__float_as_uint(l_reg),__float_as_uint(l_reg),false,false);l_reg=__uint_as_float(rr[0])+__uint_as_float(rr[1]);}
  if(hi==0)wsf[32+r32]=l_reg;asm volatile("s_waitcnt lgkmcnt(0)":::"memory");
  float rli[16];
  #pragma unroll
  for(int r=0;r<16;++r)rli[r]=__builtin_amdgcn_rcpf(wsf[32+crow(r,hi)]);
  bf16*Ow=O+(rowbase+q0+wid*QBLK)*QP+h*D;
  { bf16*stg=(bf16*)(shm+LDS_OST)+wid*2048;
    #pragma unroll
    for(int r=0;r<16;++r){const int orow=crow(r,hi);
      #pragma unroll
      for(int d0=0;d0<2;++d0)stg[orow*64+d0*32+r32]=__float2bfloat16(o[d0][r]*rli[r]);}
    asm volatile("s_waitcnt lgkmcnt(0)":::"memory");
    #pragma unroll
    for(int i=0;i<4;++i){const int row=i*8+(lane>>3),ch=lane&7; const u32x4 v=*(const u32x4*)(stg+row*64+ch*8); ATTN_STORE16(Ow+(long)row*QP+ch*8,v);} }
  asm volatile("s_waitcnt lgkmcnt(0)\n\ts_barrier":::"memory");
  #undef DMA_K
  #undef DMA_V
  #undef CMASK
  #undef START
  #undef RESC
  #undef ROT
}
constexpr int ATTN_LDS_BYTES=LDS_BYTES;
#undef SBAR
#undef WAIT_BAR
}
namespace cg = cooperative_groups;
#define GAS __attribute__((address_space(1)))
#define LAS __attribute__((address_space(3)))
#define CAS __attribute__((address_space(4)))
typedef unsigned short bf16;
typedef unsigned v4u __attribute__((ext_vector_type(4)));
typedef unsigned v2u __attribute__((ext_vector_type(2)));
typedef float f32x4 __attribute__((ext_vector_type(4)));
typedef float f2 __attribute__((ext_vector_type(2)));
typedef short bf16x8 __attribute__((ext_vector_type(8)));
constexpr int NWAVES = 8;
constexpr int D = 1024, MP = 16384, MT = 81920, TSAMP = 4096, NSEQ = 17, DEPTH = 2;
constexpr int NINP = 2816, NINSRC = 2688, DFF = 2816, PRP = 2048, KVP = 256;
constexpr int NITEM_SCAN = 6144;
constexpr float NORM_EPS = 1e-6f, QK_EPS = 1e-6f, GN_EPS = 64e-5f, DECAY_SCALE = 0.6065306597126334f;
constexpr size_t MiB = 1u << 20;
constexpr size_t WS_MOD = 0;
constexpr size_t WS_CTL = 896 * 1024;
constexpr size_t WS_BON = 1 * MiB;
constexpr size_t WS_WSM = 7 * MiB;
constexpr size_t WS_WIN = 8 * MiB, WS_WOUT = 19 * MiB, WS_WFFI = 23 * MiB, WS_WFFO = 45 * MiB;
constexpr size_t WS_XN = 56 * MiB;
constexpr size_t WS_MIX = 216 * MiB;
constexpr size_t WS_PROJ = 376 * MiB;
constexpr size_t WS_KV = 696 * MiB;
constexpr size_t WS_P = 736 * MiB, WS_QS = 832 * MiB;
constexpr size_t WS_SLAB = 928 * MiB;
constexpr size_t WS_ACT = 376 * MiB;
constexpr size_t WS_END = 976 * MiB;
constexpr int LDS_BYTES = 163840;

__device__ __forceinline__ int bid_() { int v = (int)blockIdx.x; asm volatile("" : "+s"(v)); return v; }
typedef __bf16 bf16x2_hw __attribute__((ext_vector_type(2)));
__device__ __forceinline__ unsigned pk2(float lo, float hi) { const f2 v = {lo, hi}; return __builtin_bit_cast(unsigned, __builtin_convertvector(v, bf16x2_hw)); }
__device__ __forceinline__ unsigned f2bf(float f) { return pk2(f, f) & 0xffffu; }
__device__ __forceinline__ float bflo(unsigned u) { return __builtin_bit_cast(float, u << 16); }
__device__ __forceinline__ float bfhi(unsigned u) { return __builtin_bit_cast(float, u & 0xffff0000u); }
__device__ __forceinline__ f32x4 ld4bf(const bf16* p) { const v2u u = *(const v2u*)p; return (f32x4){bflo(u.x), bfhi(u.x), bflo(u.y), bfhi(u.y)}; }
__device__ __forceinline__ float sigmoidf_(float x) { return __builtin_amdgcn_rcpf(1.0f + __builtin_amdgcn_exp2f(-1.4426950408889634f * x)); }
__device__ __forceinline__ float tanhf_(float x) { return 1.0f - 2.0f * __builtin_amdgcn_rcpf(1.0f + __builtin_amdgcn_exp2f(2.8853900817779268f * x)); }
__device__ __forceinline__ float shx(float v, int o, int lane) { return __builtin_bit_cast(float, __builtin_amdgcn_ds_bpermute((lane ^ o) << 2, __builtin_bit_cast(int, v))); }
__device__ __forceinline__ float wave_sum(float v, int lane) {
#pragma unroll
    for (int o = 1; o < 64; o <<= 1) v += shx(v, o, lane);
    return v;
}
#define LDS_WAIT() asm volatile("s_waitcnt lgkmcnt(0)" ::: "memory")

struct Args { const float* in[25]; float* out; unsigned char* ws; };

__device__ __forceinline__ void p0_transpose_item(const float* W, int K, int N, bf16* WT, int k0, int src_n0, int dst_n0, bool zero, LAS float* scr, int lane) {
    if (!zero) {
#pragma unroll 8
        for (int i = 0; i < 32; ++i) { const int kk = 2 * i + (lane >> 5); scr[kk * 33 + (lane & 31)] = W[(size_t)(k0 + kk) * N + src_n0 + (lane & 31)]; }
    } else {
#pragma unroll 8
        for (int i = 0; i < 32; ++i) { const int kk = 2 * i + (lane >> 5); scr[kk * 33 + (lane & 31)] = 0.f; }
    }
    LDS_WAIT(); asm volatile("" ::: "memory");
    const int c = lane & 7;
#pragma unroll
    for (int j = 0; j < 4; ++j) { const int n = (lane >> 3) + 8 * j; const LAS float* s = scr + (8 * c) * 33 + n;
        v4u o; o.x = pk2(s[0 * 33], s[1 * 33]); o.y = pk2(s[2 * 33], s[3 * 33]); o.z = pk2(s[4 * 33], s[5 * 33]); o.w = pk2(s[6 * 33], s[7 * 33]);
        *(v4u*)(WT + (size_t)(dst_n0 + n) * K + k0 + 8 * c) = o; }
    LDS_WAIT(); asm volatile("" ::: "memory");
}
__device__ __forceinline__ void p0_prologue(const CAS Args* A, LAS unsigned char* lds, int wave, int lane, int G) {
    LAS float* scr = (LAS float*)(lds + wave * 16384);
    const int gw = bid_() * NWAVES + wave, NGW = G * NWAVES;
    constexpr int I_IN = 16 * 88, I_OUT = 16 * 32, I_FFI = 16 * 176, I_FFO = 44 * 32, I_LORA = 16 * 2, I_GATE = 2 * 16;
    constexpr int PER_L = I_IN + I_OUT + I_FFI + I_FFO + 2 * I_LORA + I_GATE;
    unsigned char* ws = A->ws;
    for (int it = gw; it < 2 * PER_L; it += NGW) {
        const int l = it / PER_L; int r = it % PER_L;
        if (r < I_IN) { const int kb = r / 88, nb = r % 88; const bool z = nb * 32 >= NINSRC;
            p0_transpose_item(A->in[8] + (size_t)l * D * NINSRC, D, NINSRC, (bf16*)(ws + WS_WIN) + (size_t)l * NINP * D, kb * 64, nb * 32, nb * 32, z, scr, lane); continue; } r -= I_IN;
        if (r < I_OUT) { const int kb = r / 32, nb = r % 32;
            p0_transpose_item(A->in[22] + (size_t)l * D * D, D, D, (bf16*)(ws + WS_WOUT) + (size_t)l * D * D, kb * 64, nb * 32, nb * 32, false, scr, lane); continue; } r -= I_OUT;
        if (r < I_FFI) { const int kb = r / 176, nb = r % 176; const int dn = nb * 32, pn = dn >> 8, rr = dn & 255; const int sn = rr < 128 ? pn * 128 + rr : DFF + pn * 128 + (rr - 128);
            p0_transpose_item(A->in[23] + (size_t)l * D * 2 * DFF, D, 2 * DFF, (bf16*)(ws + WS_WFFI) + (size_t)l * 2 * DFF * D, kb * 64, sn, dn, false, scr, lane); continue; } r -= I_FFI;
        if (r < I_FFO) { const int kb = r / 32, nb = r % 32;
            p0_transpose_item(A->in[24] + (size_t)l * DFF * D, DFF, D, (bf16*)(ws + WS_WFFO) + (size_t)l * D * DFF, kb * 64, nb * 32, nb * 32, false, scr, lane); continue; } r -= I_FFO;
        if (r < I_LORA) { const int d = r / 16, nb = r % 16;
            p0_transpose_item(A->in[11] + (size_t)(l * 2 + d) * 64 * 512, 64, 512, (bf16*)(ws + WS_WSM) + (size_t)(l * 2 + d) * 512 * 64, 0, nb * 32, nb * 32, false, scr, lane); continue; } r -= I_LORA;
        if (r < I_LORA) { const int d = r / 16, nb = r % 16;
            p0_transpose_item(A->in[13] + (size_t)(l * 2 + d) * 64 * 512, 64, 512, (bf16*)(ws + WS_WSM) + 131072 + (size_t)(l * 2 + d) * 512 * 64, 0, nb * 32, nb * 32, false, scr, lane); continue; } r -= I_LORA;
        { const int kb = r / 16, nb = r % 16;
            p0_transpose_item(A->in[14] + (size_t)l * 128 * 512, 128, 512, (bf16*)(ws + WS_WSM) + 262144 + (size_t)l * 512 * 128, kb * 64, nb * 32, nb * 32, false, scr, lane); }
    }
}
__device__ __forceinline__ void p0_mod(const CAS Args* A, LAS unsigned char* lds, int tid) {
    const int item = bid_(); if (item >= 192) return;
    LAS float* cs = (LAS float*)lds;
    LAS float* red = (LAS float*)(lds + 81920);
    for (int e = tid; e < NSEQ * 1024; e += 512) { const int s = e >> 10, k = e & 1023; const float c = s == 0 ? A->in[2][k] : A->in[3][(s - 1) * 1024 + k];
        cs[k * 20 + s] = c * sigmoidf_(c); }
    __syncthreads();
    const int l = item / 96, col0 = (item % 96) * 64, kq = tid >> 6, col = tid & 63;
    const float* w = A->in[4] + (size_t)l * 1024 * 6144 + col0 + col;
    float acc[NSEQ];
#pragma unroll
    for (int s = 0; s < NSEQ; ++s) acc[s] = 0.f;
#pragma unroll 4
    for (int k = kq * 128; k < kq * 128 + 128; ++k) { const float wv = w[(size_t)k * 6144];
        const LAS f32x4* c4 = (const LAS f32x4*)(cs + k * 20);
        const f32x4 c0 = c4[0], c1 = c4[1], c2 = c4[2], c3 = c4[3]; const float c16 = cs[k * 20 + 16];
#pragma unroll
        for (int i = 0; i < 4; ++i) { acc[i] += wv * c0[i]; acc[4 + i] += wv * c1[i]; acc[8 + i] += wv * c2[i]; acc[12 + i] += wv * c3[i]; }
        acc[16] += wv * c16; }
#pragma unroll
    for (int s = 0; s < NSEQ; ++s) red[(kq * NSEQ + s) * 64 + col] = acc[s];
    __syncthreads();
    float* mod = (float*)(A->ws + WS_MOD);
    for (int e = tid; e < NSEQ * 64; e += 512) { const int s = e >> 6, c = e & 63; float v = A->in[5][l * 6144 + col0 + c];
#pragma unroll
        for (int q = 0; q < 8; ++q) v += red[(q * NSEQ + s) * 64 + c];
        mod[(size_t)(s * 2 + l) * 6144 + col0 + c] = v; }
    __syncthreads();
}
__device__ __forceinline__ int seq_of(int m) { return m < MP ? 0 : 1 + ((m - MP) >> 12); }
__device__ __forceinline__ void norm_phase(const float* xp, const float* xs, const float* g, const float* modl  , bf16* XN, int wave, int lane, int G) {
    const int gw = bid_() * NWAVES + wave, NGW = G * NWAVES;
    f32x4 gv[4];
#pragma unroll
    for (int j = 0; j < 4; ++j) gv[j] = ((const f32x4*)g)[64 * j + lane];
    for (int m = gw; m < MT; m += NGW) {
        const float* xrow = m < MP ? xp + (size_t)m * D : xs + (size_t)(m - MP) * D;
        const f32x4* xr = (const f32x4*)xrow + lane;
        f32x4 v[4]; float s = 0.f;
#pragma unroll
        for (int j = 0; j < 4; ++j) { v[j] = xr[64 * j]; s += (v[j].x * v[j].x + v[j].y * v[j].y) + (v[j].z * v[j].z + v[j].w * v[j].w); }
        const float rstd = __builtin_amdgcn_rsqf(wave_sum(s, lane) * (1.f / D) + NORM_EPS);
        const float* mp = modl + (size_t)seq_of(m) * 12288;
        unsigned long long* o8 = (unsigned long long*)(XN + (size_t)m * D) + lane;
#pragma unroll
        for (int j = 0; j < 4; ++j) { const f32x4 sh = ((const f32x4*)mp)[64 * j + lane], sc = ((const f32x4*)(mp + 1024))[64 * j + lane];
            const f32x4 y = v[j] * rstd * gv[j] * (1.0f + sc) + sh;
            o8[64 * j] = (unsigned long long)pk2(y.x, y.y) | ((unsigned long long)pk2(y.z, y.w) << 32); }
    }
}
__device__ __forceinline__ void qk_prep_phase(bf16* mix, bf16* kv, const float* qg, const float* kg, int wave, int lane, int G) {
    const int gw = bid_() * NWAVES + wave, NGW = G * NWAVES;
    const int hsel = lane >> 5, li = lane & 31, half = li >> 4, i = li & 15, d1 = half * 32 + i, d2 = d1 + 16;
    const float freq = __builtin_amdgcn_exp2f(-(float)i * (13.287712379549449f / 16.0f));
    const float q1 = qg[d1], q2 = qg[d2], k1 = kg[d1], k2 = kg[d2];
    for (int m = gw; m < MT; m += NGW) {
        const int t = m < MP ? m : (m - MP) & (TSAMP - 1);
        const float pos = (float)(half ? (t & 63) : (t >> 6));
        const float rev = pos * freq * 0.15915494309189535f; const float sn = __builtin_amdgcn_sinf(rev), cn = __builtin_amdgcn_cosf(rev);
        bf16* pp[5]; float x1[5], x2[5];
#pragma unroll
        for (int it = 0; it < 5; ++it) { const int hh = it * 2 + hsel;
            pp[it] = hh < 8 ? mix + (size_t)m * 1024 + 512 + hh * 64 : kv + (size_t)m * KVP + (hh - 8) * 64;
            x1[it] = bflo(pp[it][d1]); x2[it] = bflo(pp[it][d2]); }
        asm volatile("" ::: "memory");
        unsigned short r1[5], r2[5];
#pragma unroll
        for (int it = 0; it < 5; ++it) { const int hh = it * 2 + hsel;
            float ss = x1[it] * x1[it] + x2[it] * x2[it];
#pragma unroll
            for (int o = 1; o < 32; o <<= 1) ss += shx(ss, o, lane);
            const float rstd = __builtin_amdgcn_rsqf(ss * (1.f / 64.f) + QK_EPS);
            const float y1 = x1[it] * rstd * (hh < 8 ? q1 : k1), y2 = x2[it] * rstd * (hh < 8 ? q2 : k2);
            float o1 = y1 * cn - y2 * sn, o2 = y2 * cn + y1 * sn;
            if (hh < 8) { o1 *= attn_body::C2; o2 *= attn_body::C2; }
            r1[it] = (unsigned short)f2bf(o1); r2[it] = (unsigned short)f2bf(o2); }
#pragma unroll
        for (int it = 0; it < 5; ++it) { pp[it][d1] = r1[it]; pp[it][d2] = r2[it]; }
    }
}
struct ScanP { const bf16* proj; const float* conv_w; const float* w0; const float* a0; const float* k_k; const float* k_a; const float* r_k; const bf16* upw; const bf16* upa; };
__device__ __forceinline__ f32x4 conv4(const bf16* proj, const float* cw, int m, int col, bool hp, bool hn) {
    const bf16* p = proj + (size_t)m * PRP + col;
    const f32x4 c0 = *(const f32x4*)(cw + col), c1 = *(const f32x4*)(cw + 1536 + col), c2 = *(const f32x4*)(cw + 3072 + col);
    f32x4 r = c1 * ld4bf(p);
    if (hp) r += c0 * ld4bf(p - PRP);
    if (hn) r += c2 * ld4bf(p + PRP);
    return r;
}
template <int MODE>
__device__ __forceinline__ void scan_prologue(const ScanP& P, int m0, int seqbase, int T, int h, int d, float* slab, LAS float* lw, float* bon, int lane) {
    const int fr = lane & 15, fq = lane >> 4, m = m0 + fr, pos = m - seqbase; const bool hp = pos > 0, hn = pos < T - 1;
    float* srow = slab + fr * 384;
    f32x4 k4[4], kk4[4], r4[4]; float ss = 0.f;
    v2u pk_[4][3], pv_[4][3], pr_[4][3];
    const v2u zz = (v2u){0u, 0u};
#pragma unroll
    for (int n = 0; n < 4; ++n) { const bf16* p = P.proj + (size_t)m * PRP + h * 64 + 16 * n + 4 * fq;
        pk_[n][1] = *(const v2u*)(p + 512); pk_[n][0] = zz; pk_[n][2] = zz;
        if (hp) pk_[n][0] = *(const v2u*)(p + 512 - PRP);
        if (hn) pk_[n][2] = *(const v2u*)(p + 512 + PRP);
        if (MODE != 1) { pv_[n][1] = *(const v2u*)(p + 1024); pv_[n][0] = zz; pv_[n][2] = zz;
            if (hp) pv_[n][0] = *(const v2u*)(p + 1024 - PRP);
            if (hn) pv_[n][2] = *(const v2u*)(p + 1024 + PRP); }
        if (MODE == 2) { pr_[n][1] = *(const v2u*)(p); pr_[n][0] = zz; pr_[n][2] = zz;
            if (hp) pr_[n][0] = *(const v2u*)(p - PRP);
            if (hn) pr_[n][2] = *(const v2u*)(p + PRP); } }
    v4u xw_[2]; bf16x8 xa_[2];
#pragma unroll
    for (int ks = 0; ks < 2; ++ks) { xw_[ks] = *(const v4u*)(P.proj + (size_t)m * PRP + 1536 + d * 64 + ks * 32 + 8 * fq); xa_[ks] = *(const bf16x8*)(P.proj + (size_t)m * PRP + 1664 + d * 64 + ks * 32 + 8 * fq); }
    asm volatile("" ::: "memory");
#define CONV3_(arr, which) ({ const float* cw_ = P.conv_w + (which) * 512 + col; const f32x4 c0 = *(const f32x4*)cw_, c1 = *(const f32x4*)(cw_ + 1536), c2 = *(const f32x4*)(cw_ + 3072); \
        const v2u u0 = arr[n][0], u1 = arr[n][1], u2 = arr[n][2]; \
        c0 * (f32x4){bflo(u0.x), bfhi(u0.x), bflo(u0.y), bfhi(u0.y)} + c1 * (f32x4){bflo(u1.x), bfhi(u1.x), bflo(u1.y), bfhi(u1.y)} + c2 * (f32x4){bflo(u2.x), bfhi(u2.x), bflo(u2.y), bfhi(u2.y)}; })
#pragma unroll
    for (int n = 0; n < 4; ++n) { const int c = 16 * n + 4 * fq, col = h * 64 + c;
        k4[n] = CONV3_(pk_, 1);
        if (MODE != 1) { const f32x4 v4 = CONV3_(pv_, 2); *(f32x4*)(srow + 320 + c) = v4; LAS float* xsel = (fr == (d ? 15 : 0)) ? lw + 2048 + c : lw + 2304 + lane * 4; *(LAS f32x4*)(xsel + 192) = v4; }
        if (MODE == 2) { r4[n] = CONV3_(pr_, 0); *(LAS f32x4*)(lw + 1024 + fr * 64 + c) = r4[n]; }
        kk4[n] = k4[n] * *(const f32x4*)(P.k_k + col);
        ss += (kk4[n].x * kk4[n].x + kk4[n].y * kk4[n].y) + (kk4[n].z * kk4[n].z + kk4[n].w * kk4[n].w); }
#undef CONV3_
    ss += shx(ss, 16, lane); ss += shx(ss, 32, lane);
    const float rs = __builtin_amdgcn_rsqf(ss + 1e-12f);
    f32x4 Dw[4], Da[4];
#pragma unroll
    for (int n = 0; n < 4; ++n) { Dw[n] = (f32x4){0.f, 0.f, 0.f, 0.f}; Da[n] = (f32x4){0.f, 0.f, 0.f, 0.f}; }
#pragma unroll
    for (int ks = 0; ks < 2; ++ks) {
        const v4u xw = xw_[ks]; const bf16x8 xa = xa_[ks];
        v4u tw;
#pragma unroll
        for (int e = 0; e < 4; ++e) tw[e] = pk2(tanhf_(bflo(xw[e])), tanhf_(bfhi(xw[e])));
        const bf16x8 twv = __builtin_bit_cast(bf16x8, tw);
#pragma unroll
        for (int n = 0; n < 4; ++n) { const size_t wo = (size_t)(h * 64 + 16 * n + fr) * 64 + ks * 32 + 8 * fq;
            Dw[n] = __builtin_amdgcn_mfma_f32_16x16x32_bf16(*(const bf16x8*)(P.upw + wo), twv, Dw[n], 0, 0, 0);
            Da[n] = __builtin_amdgcn_mfma_f32_16x16x32_bf16(*(const bf16x8*)(P.upa + wo), xa, Da[n], 0, 0, 0); }
    }
    float bp = 0.f;
#pragma unroll
    for (int n = 0; n < 4; ++n) { const int c = 16 * n + 4 * fq, col = h * 64 + c;
        const f32x4 w0 = *(const f32x4*)(P.w0 + col), a0 = *(const f32x4*)(P.a0 + col), ka = *(const f32x4*)(P.k_a + col);
        f32x4 wv, bv, kd, av;
#pragma unroll
        for (int i = 0; i < 4; ++i) { const float ic = sigmoidf_(Da[n][i] + a0[i]);
            wv[i] = __builtin_amdgcn_exp2f(-DECAY_SCALE * 1.4426950408889634f * sigmoidf_(Dw[n][i] + w0[i]));
            const float kk = kk4[n][i] * rs; av[i] = -kk; bv[i] = kk * ic; kd[i] = k4[n][i] * (1.0f + (ic - 1.0f) * ka[i]); }
        *(LAS f32x4*)(lw + fr * 64 + c) = av; *(LAS f32x4*)(lw + 3072 + fr * 64 + c) = wv; *(LAS f32x4*)(lw + (MODE == 3 ? 1024 : 4096) + fr * 64 + c) = bv;
        if (MODE != 1) *(f32x4*)(srow + 192 + c) = kd;
        { LAS float* xsel = (fr == (d ? 15 : 0)) ? lw + 2048 + c : lw + 2304 + lane * 4;
          if (MODE != 1) *(LAS f32x4*)(xsel + 128) = kd; }
        if (MODE == 2) { const f32x4 rk = *(const f32x4*)(P.r_k + col); const f32x4 t = r4[n] * kd * rk; bp += (t.x + t.y) + (t.z + t.w); }
        asm volatile("" ::: "memory");
    }
    if (MODE == 2) { bp += shx(bp, 16, lane); bp += shx(bp, 32, lane); if (fq == 0) bon[(size_t)m * 8 + h] = 0.5f * bp; }
}
template <int MODE>
__device__ __forceinline__ void scan_item(const CAS Args* A, int l, int item, float* slab0, LAS float* ldsw, int lane) {
    unsigned char* ws = A->ws;
    const bool isP = item < 2048; const int it2 = isP ? item : item - 2048;
    const int d = it2 & 1, h = (it2 >> 1) & 7, chunk = it2 >> 4, m0c = isP ? chunk * 128 : MP + chunk * 256, nsub = isP ? 8 : 16;
    const int seqbase = isP ? 0 : MP + (chunk >> 4) * TSAMP, T = isP ? MP : TSAMP;
    ScanP P; P.proj = (const bf16*)(ws + WS_PROJ); P.conv_w = A->in[9] + (size_t)l * 3 * 1536; P.w0 = A->in[10] + (size_t)(l * 2 + d) * 512; P.a0 = A->in[12] + (size_t)(l * 2 + d) * 512;
    P.k_k = A->in[15] + l * 512; P.k_a = A->in[16] + l * 512; P.r_k = A->in[17] + l * 512;
    P.upw = (const bf16*)(ws + WS_WSM) + (size_t)(l * 2 + d) * 512 * 64; P.upa = (const bf16*)(ws + WS_WSM) + 131072 + (size_t)(l * 2 + d) * 512 * 64;
    float* bon = (float*)(ws + WS_BON) + (size_t)d * MT * 8;
    bf16* yb = (bf16*)(ws + WS_XN) + (size_t)d * MT * 512;
    f2 S[32], Pm[32];
    if (MODE == 3) {
#pragma unroll
        for (int i = 0; i < 32; ++i) Pm[i] = (f2){lane == 2 * i ? 1.f : 0.f, lane == 2 * i + 1 ? 1.f : 0.f}; }
    if (MODE == 2) { const f32x4* q = (const f32x4*)((const float*)(ws + WS_QS) + ((size_t)item * 64 + lane) * 64);
#pragma unroll
        for (int i = 0; i < 16; ++i) { const f32x4 v = q[i]; S[2 * i] = (f2){v.x, v.y}; S[2 * i + 1] = (f2){v.z, v.w}; } }
    else {
#pragma unroll
        for (int i = 0; i < 32; ++i) S[i] = MODE == 1 ? (f2){lane == 2 * i ? 1.f : 0.f, lane == 2 * i + 1 ? 1.f : 0.f} : (f2){0.f, 0.f}; }
#pragma nounroll
    for (int sc = 0; sc < nsub; ++sc) {
        const int sub = d ? nsub - 1 - sc : sc, t0 = m0c + sub * 16;
        float* slab = slab0;
        { int lane_l = lane; asm volatile("" : "+v"(lane_l)); scan_prologue<MODE>(P, t0, seqbase, T, h, d, slab, ldsw, bon, lane_l);
#ifdef DUP_PRO
          asm volatile("" : "+v"(lane_l)); scan_prologue<MODE>(P, t0, seqbase, T, h, d, slab, ldsw, bon, lane_l);
#endif
        }
        asm volatile("" ::: "memory");
#define RL2(x, j) (f2){__builtin_bit_cast(float, __builtin_amdgcn_readlane(__builtin_bit_cast(int, x), 2 * (j))), __builtin_bit_cast(float, __builtin_amdgcn_readlane(__builtin_bit_cast(int, x), 2 * (j) + 1))}
        const GAS float* sl = (const GAS float*)slab + lane;
        LDS_WAIT();
        float nw[1], nb[1], nk[1], nv[1];
        { const LAS float* xl = ldsw + 2048 + lane; nw[0] = 0.f; nb[0] = 0.f; nk[0] = 0.f; nv[0] = 0.f; if (MODE != 1) { nk[0] = xl[128]; nv[0] = xl[192]; } }
#pragma nounroll
        for (int st = 0; st < 16; ++st) {
            const int s = d ? 15 - st : st;
            const float cw = nw[0], cb = nb[0], ck = nk[0], vv = nv[0];
            if (st < 15) { const GAS float* p = sl + (d ? s - 1 : s + 1) * 384;  if (MODE != 1) { nk[0] = p[192]; nv[0] = p[320]; } }
            const LAS f32x4* ua = (const LAS f32x4*)(ldsw + s * 64); const LAS f32x4* ur = (const LAS f32x4*)(ldsw + 1024 + s * 64); const LAS f32x4* uw = (const LAS f32x4*)(ldsw + 3072 + s * 64); const LAS f32x4* ub = (const LAS f32x4*)(ldsw + (MODE == 3 ? 1024 : 4096) + s * 64);
            f2 sa2 = (f2){0.f, 0.f}, sb2 = (f2){0.f, 0.f}, pa2 = (f2){0.f, 0.f}, pb2 = (f2){0.f, 0.f};
#pragma unroll
            for (int j = 0; j < 16; ++j) { const f32x4 aq = ua[j]; const f2 a0 = (f2){aq.x, aq.y}, a1 = (f2){aq.z, aq.w}; sa2 = S[2 * j] * a0 + sa2; sb2 = S[2 * j + 1] * a1 + sb2;
                if (MODE == 3) { pa2 = Pm[2 * j] * a0 + pa2; pb2 = Pm[2 * j + 1] * a1 + pb2; } }
            const float sa = (sa2.x + sa2.y) + (sb2.x + sb2.y), pa = (pa2.x + pa2.y) + (pb2.x + pb2.y); const f2 pas = (f2){pa, pa};
            const f2 sas = (f2){sa, sa}, vvs = (f2){vv, vv};
            f2 y2 = (f2){0.f, 0.f}, y3 = (f2){0.f, 0.f};
            f32x4 nwq[2], nbq[2], nrq[2];
            nwq[0] = uw[0]; nwq[1] = uw[1]; nbq[0] = ub[0]; nbq[1] = ub[1]; nrq[0] = (f32x4){0.f, 0.f, 0.f, 0.f}; nrq[1] = nrq[0];
            if (MODE == 2) { nrq[0] = ur[0]; nrq[1] = ur[1]; }
#pragma unroll
            for (int g = 0; g < 8; ++g) {
                const f32x4 cwq0 = nwq[0], cwq1 = nwq[1], cbq0 = nbq[0], cbq1 = nbq[1], crq0 = nrq[0], crq1 = nrq[1];
                if (g < 7) { nwq[0] = uw[2 * g + 2]; nwq[1] = uw[2 * g + 3]; nbq[0] = ub[2 * g + 2]; nbq[1] = ub[2 * g + 3];
                    if (MODE == 2) { nrq[0] = ur[2 * g + 2]; nrq[1] = ur[2 * g + 3]; } }
                f2 bb[4], ww[4], kq[4], rr[4];
                ww[0] = (f2){cwq0.x, cwq0.y}; ww[1] = (f2){cwq0.z, cwq0.w}; ww[2] = (f2){cwq1.x, cwq1.y}; ww[3] = (f2){cwq1.z, cwq1.w};
                bb[0] = (f2){cbq0.x, cbq0.y}; bb[1] = (f2){cbq0.z, cbq0.w}; bb[2] = (f2){cbq1.x, cbq1.y}; bb[3] = (f2){cbq1.z, cbq1.w};
                rr[0] = (f2){crq0.x, crq0.y}; rr[1] = (f2){crq0.z, crq0.w}; rr[2] = (f2){crq1.x, crq1.y}; rr[3] = (f2){crq1.z, crq1.w};
#pragma unroll
                for (int q = 0; q < 4; ++q) { const int j = g * 4 + q; if (MODE != 1) kq[q] = RL2(ck, j); }
                __builtin_amdgcn_sched_barrier(0);
#pragma unroll
                for (int q = 0; q < 4; ++q) { const int j = g * 4 + q;
                    f2 t = sas * bb[q];
                    if (MODE != 1) t = vvs * kq[q] + t;
                    S[j] = S[j] * ww[q] + t;
                    if (MODE == 3) Pm[j] = Pm[j] * ww[q] + pas * bb[q];
                    if (MODE == 2) { if (j & 1) y3 = S[j] * rr[q] + y3; else y2 = S[j] * rr[q] + y2; } }
            }
            if (MODE == 2) yb[(size_t)(t0 + s) * 512 + h * 64 + lane] = (bf16)f2bf((y2.x + y2.y) + (y3.x + y3.y));
        }
#undef RL2
    }
    if (MODE != 2) { f32x4* q = (f32x4*)((float*)(ws + (MODE == 1 ? WS_P : WS_QS)) + ((size_t)item * 64 + lane) * 64);
#pragma unroll
        for (int i = 0; i < 16; ++i) q[i] = (f32x4){S[2 * i].x, S[2 * i].y, S[2 * i + 1].x, S[2 * i + 1].y}; }
    if (MODE == 3) { f32x4* q = (f32x4*)((float*)(ws + WS_P) + ((size_t)item * 64 + lane) * 64);
#pragma unroll
        for (int i = 0; i < 16; ++i) q[i] = (f32x4){Pm[2 * i].x, Pm[2 * i].y, Pm[2 * i + 1].x, Pm[2 * i + 1].y}; }
}
template <bool PASS_C>
__device__ __forceinline__ void scan_phase(const CAS Args* A, LAS unsigned char* lds, int l, int wave, int lane, int G) {
    const int gw = bid_() * NWAVES + wave, NGW = G * NWAVES;
    float* slab0 = (float*)(A->ws + WS_SLAB) + (size_t)gw * 6144;
    LAS float* ldsw = (LAS float*)(lds + wave * 20480);
    if (PASS_C) { for (int item = gw; item < NITEM_SCAN; item += NGW) scan_item<2>(A, l, item, slab0, ldsw, lane); }
    else { for (int item = gw; item < NITEM_SCAN; item += NGW) { int ll = lane; asm volatile("" : "+v"(ll)); scan_item<3>(A, l, item, slab0, ldsw, ll); } }
}
#ifdef EXP_SLOAD
typedef const CAS f2* cf2p_;
__device__ __forceinline__ void probe_sload(const CAS Args* A, int wave, int lane, int G) {
    const int gw = bid_() * NWAVES + wave;
    float* pslab = (float*)(A->ws + WS_SLAB) + (size_t)gw * 12288;
    f2 acc = (f2){0.f, 0.f}, acc2 = (f2){0.f, 0.f};
#pragma nounroll
    for (int rep = 0; rep < EXP_SLOAD; ++rep) {
        float* ps = pslab + (rep & 1) * 6144;
#pragma unroll 4
        for (int i = 0; i < 96; ++i) ps[i * 64 + lane] = (float)(i + rep) * 0.001f;
        unsigned long long sp = (unsigned long long)(uintptr_t)ps;
        sp = __builtin_amdgcn_readfirstlane((unsigned)sp) | ((unsigned long long)__builtin_amdgcn_readfirstlane((unsigned)(sp >> 32)) << 32);
        asm volatile("s_waitcnt vmcnt(0) lgkmcnt(0)" : "+s"(sp) : : "memory");
        cf2p_ u = (cf2p_)sp;
#pragma nounroll
        for (int i = 0; i < 3072; i += 32) {
#pragma unroll
            for (int j = 0; j < 32; j += 2) { acc = acc * u[i + j] + acc; acc2 = acc2 * u[i + j + 1] + acc2; }
        }
    }
    if (acc.x + acc2.y == 12345.678f) pslab[lane] = acc.y + acc2.x;
}
#endif
__device__ __forceinline__ void scanB_phase(const CAS Args* A, LAS unsigned char* lds, int wave, int lane, int G) {
    unsigned char* ws = A->ws;
    LAS float* ex = (LAS float*)lds;
    LAS float* pl = (LAS float*)(lds + 32768);
    const int tid = wave * 64 + lane;
    for (int chain = bid_(); chain < NSEQ * 16; chain += G) {
        const int d = chain & 1, h = (chain >> 1) & 7, seq = chain >> 4;
        const int nc = seq == 0 ? 128 : 16, ibase = seq == 0 ? 0 : 2048 + (seq - 1) * 256;
        f2 S[32]; f2 cur[4];
#pragma unroll
        for (int i = 0; i < 32; ++i) S[i] = (f2){0.f, 0.f};
#pragma unroll
        for (int i = 0; i < 4; ++i) cur[i] = (f2){0.f, 0.f};
        { const int c0 = d ? nc - 1 : 0; const size_t it0 = (size_t)ibase + (size_t)(c0 * 8 + h) * 2 + d;
          const f32x4* ps = (const f32x4*)((const float*)(ws + WS_P) + it0 * 4096); ((LAS f32x4*)pl)[tid] = ps[tid]; ((LAS f32x4*)pl)[tid + 512] = ps[tid + 512]; }
        __syncthreads();
        for (int ci = 0; ci < nc; ++ci) {
            const int c = d ? nc - 1 - ci : ci; const size_t item = (size_t)ibase + (size_t)(c * 8 + h) * 2 + d;
            LAS float* pc = pl + (ci & 1) * 4096; LAS float* pn = pl + ((ci + 1) & 1) * 4096;
            f32x4 pf0 = (f32x4){0.f, 0.f, 0.f, 0.f}, pf1 = pf0;
            if (ci + 1 < nc) { const int cn = d ? nc - 2 - ci : ci + 1; const size_t itn = (size_t)ibase + (size_t)(cn * 8 + h) * 2 + d;
                const f32x4* ps = (const f32x4*)((const float*)(ws + WS_P) + itn * 4096); pf0 = ps[tid]; pf1 = ps[tid + 512]; }
            float* qrow = (float*)(ws + WS_QS) + (item * 64 + lane) * 64 + wave * 8;
            const f32x4 q0 = *(const f32x4*)qrow, q1 = *(const f32x4*)(qrow + 4);
            *(f32x4*)qrow = (f32x4){cur[0].x, cur[0].y, cur[1].x, cur[1].y}; *(f32x4*)(qrow + 4) = (f32x4){cur[2].x, cur[2].y, cur[3].x, cur[3].y};
            f2 n0 = (f2){0.f, 0.f}, n1 = n0, n2 = n0, n3 = n0;
#pragma unroll
            for (int kp = 0; kp < 32; ++kp) {
                const f2 sx = (f2){S[kp].x, S[kp].x}, sy = (f2){S[kp].y, S[kp].y};
                const LAS f32x4* r0 = (const LAS f32x4*)(pc + (2 * kp) * 64 + wave * 8); const LAS f32x4* r1 = (const LAS f32x4*)(pc + (2 * kp + 1) * 64 + wave * 8);
                const f32x4 a0 = r0[0], a1 = r0[1], b0 = r1[0], b1 = r1[1];
                n0 = sx * (f2){a0.x, a0.y} + n0; n1 = sx * (f2){a0.z, a0.w} + n1; n2 = sx * (f2){a1.x, a1.y} + n2; n3 = sx * (f2){a1.z, a1.w} + n3;
                n0 = sy * (f2){b0.x, b0.y} + n0; n1 = sy * (f2){b0.z, b0.w} + n1; n2 = sy * (f2){b1.x, b1.y} + n2; n3 = sy * (f2){b1.z, b1.w} + n3; }
            n0 += (f2){q0.x, q0.y}; n1 += (f2){q0.z, q0.w}; n2 += (f2){q1.x, q1.y}; n3 += (f2){q1.z, q1.w};
            cur[0] = n0; cur[1] = n1; cur[2] = n2; cur[3] = n3;
            LAS float* er = ex + lane * 68 + wave * 8;
            *(LAS f32x4*)er = (f32x4){n0.x, n0.y, n1.x, n1.y}; *(LAS f32x4*)(er + 4) = (f32x4){n2.x, n2.y, n3.x, n3.y};
            ((LAS f32x4*)pn)[tid] = pf0; ((LAS f32x4*)pn)[tid + 512] = pf1;
            __syncthreads();
#pragma unroll
            for (int i = 0; i < 16; ++i) { const f32x4 v = *(const LAS f32x4*)(ex + lane * 68 + 4 * i); S[2 * i] = (f2){v.x, v.y}; S[2 * i + 1] = (f2){v.z, v.w}; }
            __syncthreads();
        }
    }
}
__device__ __forceinline__ void post_phase(const CAS Args* A, int l, int wave, int lane, int G) {
    unsigned char* ws = A->ws;
    const int gw = bid_() * NWAVES + wave, NGW = G * NWAVES;
    const bf16* proj = (const bf16*)(ws + WS_PROJ); const float* cw = A->in[9] + (size_t)l * 3 * 1536;
    const bf16* y0 = (const bf16*)(ws + WS_XN); const bf16* y1 = y0 + (size_t)MT * 512;
    const float* b0 = (const float*)(ws + WS_BON); const float* b1 = b0 + (size_t)MT * 8;
    const bf16* gt = (const bf16*)(ws + WS_WSM) + 262144 + (size_t)l * 512 * 128;
    const float* lng = A->in[18] + l * 512; const float* lnb = A->in[19] + l * 512;
    bf16* mix = (bf16*)(ws + WS_MIX);
    const int h = gw & 7;
    bf16x8 gfrag[4][4];
    { const int fr0 = lane & 15, fq0 = lane >> 4;
#pragma unroll
      for (int ks = 0; ks < 4; ++ks)
#pragma unroll
        for (int n = 0; n < 4; ++n) gfrag[n][ks] = *(const bf16x8*)(gt + (size_t)(h * 64 + 16 * n + fr0) * 128 + ks * 32 + 8 * fq0);
    }
    f32x4 cwv[4][3], lg4[4], lb4[4];
    { const int fq0 = lane >> 4;
#pragma unroll
      for (int n = 0; n < 4; ++n) { const int col = h * 64 + 16 * n + 4 * fq0;
          cwv[n][0] = *(const f32x4*)(cw + 1024 + col); cwv[n][1] = *(const f32x4*)(cw + 1536 + 1024 + col); cwv[n][2] = *(const f32x4*)(cw + 3072 + 1024 + col);
          lg4[n] = *(const f32x4*)(lng + col); lb4[n] = *(const f32x4*)(lnb + col); } }
    for (int item = gw; item < (MT / 16) * 8; item += NGW) {
        int lane_l = lane; asm volatile("" : "+v"(lane_l)); const int fr = lane_l & 15, fq = lane_l >> 4;
        const int m = (item >> 3) * 16 + fr;
        const int seqbase = m < MP ? 0 : MP + ((m - MP) >> 12) * TSAMP, T = m < MP ? MP : TSAMP, pos = m - seqbase; const bool hp = pos > 0, hn = pos < T - 1;
        f32x4 y4[4]; float s = 0.f;
#pragma unroll
        for (int n = 0; n < 4; ++n) { const size_t o = (size_t)m * 512 + h * 64 + 16 * n + 4 * fq; y4[n] = ld4bf(y0 + o) + ld4bf(y1 + o); s += (y4[n].x + y4[n].y) + (y4[n].z + y4[n].w); }
        s += shx(s, 16, lane); s += shx(s, 32, lane);
        const float mu = s * (1.f / 64.f); float q = 0.f;
#pragma unroll
        for (int n = 0; n < 4; ++n) { y4[n] = y4[n] - mu; q += (y4[n].x * y4[n].x + y4[n].y * y4[n].y) + (y4[n].z * y4[n].z + y4[n].w * y4[n].w); }
        q += shx(q, 16, lane); q += shx(q, 32, lane);
        const float rstd = __builtin_amdgcn_rsqf(q * (1.f / 64.f) + GN_EPS);
        const float bon = b0[(size_t)m * 8 + h] + b1[(size_t)m * 8 + h];
        f32x4 Dg[4];
#pragma unroll
        for (int n = 0; n < 4; ++n) Dg[n] = (f32x4){0.f, 0.f, 0.f, 0.f};
#pragma unroll
        for (int ks = 0; ks < 4; ++ks) {
            const v4u xg = *(const v4u*)(proj + (size_t)m * PRP + 1792 + ks * 32 + 8 * fq); v4u sg;
#pragma unroll
            for (int e = 0; e < 4; ++e) sg[e] = pk2(sigmoidf_(bflo(xg[e])), sigmoidf_(bfhi(xg[e])));
            const bf16x8 sgv = __builtin_bit_cast(bf16x8, sg);
#pragma unroll
            for (int n = 0; n < 4; ++n) Dg[n] = __builtin_amdgcn_mfma_f32_16x16x32_bf16(gfrag[n][ks], sgv, Dg[n], 0, 0, 0);
        }
#pragma unroll
        for (int n = 0; n < 4; ++n) { const int col = h * 64 + 16 * n + 4 * fq;
            const bf16* pv = proj + (size_t)m * PRP + 1024 + col;
            f32x4 v4 = cwv[n][1] * ld4bf(pv);
            if (hp) v4 += cwv[n][0] * ld4bf(pv - PRP);
            if (hn) v4 += cwv[n][2] * ld4bf(pv + PRP);
            const f32x4 o = ((y4[n] * rstd) * lg4[n] + lb4[n] + bon * v4) * Dg[n];
            v2u w; w.x = pk2(o.x, o.y); w.y = pk2(o.z, o.w);
            *(v2u*)(mix + (size_t)m * 1024 + col) = w; }
    }
}
__device__ __forceinline__ void attn_phase(const CAS Args* A, char* lds, int G, int tid) {
    using attn_body::bf16;
    bf16* Q = (bf16*)(A->ws + WS_MIX) + 512; const bf16* K = (const bf16*)(A->ws + WS_KV); const bf16* V = K + 128;
#ifdef DUP_ATTNP
    for (int u = blockIdx.x; u < 512; u += G) { const int h = u & 7, qb = u >> 3;
        attn_body::attn_unit<8>(0, MP, h, qb, Q, K, V, (bf16*)(A->ws + 976 * MiB), lds, tid); }
#endif
    for (int u = blockIdx.x; u < 512; u += G) { const int h = u & 7, qb = u >> 3;
        attn_body::attn_unit<8>(0, MP, h, qb, Q, K, V, Q, lds, tid); }
    for (int u = blockIdx.x; u < 2048; u += G) { const int h = u & 7, qb = (u >> 3) & 15, sq = u >> 7;
        attn_body::attn_unit<8>((long)MP + (long)sq * TSAMP, TSAMP, h, qb, Q, K, V, Q, lds, tid); }
}

#define XB_TMO      128
#define XB_XCNT(j)  (256  + 64 * (j))
#define XB_XSUB(j)  (1280 + 64 * (j))
#define XB_XGEN(j)  (2304 + 64 * (j))
#define XB_TOP      3328
#define XB_TOPGEN   3392
#define XCD_BAR_WORDS 3456
#define XB_SPIN_CAP (1u << 18)

__device__ __forceinline__ unsigned xb_ld(unsigned* p)              { return __hip_atomic_load(p, __ATOMIC_RELAXED, __HIP_MEMORY_SCOPE_AGENT); }
__device__ __forceinline__ unsigned xb_add(unsigned* p, unsigned v) { return __hip_atomic_fetch_add(p, v, __ATOMIC_RELAXED, __HIP_MEMORY_SCOPE_AGENT); }
__device__ __forceinline__ unsigned xb_xcc_id() { return (unsigned)__builtin_amdgcn_s_getreg((3 << 11) | 20) & 0xFu; }
#define XB_SPIN(cond, bar) do { unsigned _sp = 0; while (cond) { __builtin_amdgcn_s_sleep(1); \
    if ((++_sp & 255u) == 0u) { if (xb_ld(&(bar)[XB_TMO])) break; if (_sp > XB_SPIN_CAP) { atomicAdd(&(bar)[XB_TMO], 1u); break; } } } } while (0)

struct XcdBarrier {
    unsigned* bar; unsigned x;
    volatile LAS unsigned* st;
};

__device__ __forceinline__ XcdBarrier xcd_barrier_post(unsigned* bar, volatile LAS unsigned* st, bool leader) {
    XcdBarrier b; b.bar = bar; b.x = xb_xcc_id(); b.st = st;
    if (leader) (void)xb_add(&bar[XB_XCNT(b.x)], 1u);
    return b;
}
__device__ __forceinline__ void xcd_barrier_complete(unsigned* bar, unsigned x, unsigned& nloc, unsigned& nx) {
    const unsigned G = gridDim.x * gridDim.y * gridDim.z;
    unsigned sum, cnt, mine, sp = 0u;
    for (;;) {
        sum = 0u; cnt = 0u; mine = 0u;
#pragma unroll
        for (unsigned j = 0; j < 16; ++j) { const unsigned c = xb_ld(&bar[XB_XCNT(j)]); sum += c; cnt += (c > 0u) ? 1u : 0u; mine = (j == x) ? c : mine; }
        if (sum == G) break;
        __builtin_amdgcn_s_sleep(1);
        if ((++sp & 255u) == 0u) { if (xb_ld(&bar[XB_TMO])) break; if (sp > XB_SPIN_CAP) { atomicAdd(&bar[XB_TMO], 1u); break; } }
    }
    nloc = mine > 0u ? mine : 1u; nx = cnt > 0u ? cnt : 1u;
}

__device__ __forceinline__ void xcd_barrier(const XcdBarrier& b, bool leader) {
    asm volatile("s_waitcnt vmcnt(0)" ::: "memory");
    __syncthreads();
    if (leader) {
        unsigned* bar = b.bar;
        __builtin_amdgcn_s_waitcnt(0);
        unsigned nloc = b.st[0], nx = b.st[1];
        if (nloc == 0u) { xcd_barrier_complete(bar, b.x, nloc, nx); b.st[0] = nloc; b.st[1] = nx; }
        const unsigned old = xb_add(&bar[XB_XSUB(b.x)], 1u);
        const unsigned gen = old / nloc;
        if (old + 1u == (gen + 1u) * nloc) {
            __builtin_amdgcn_fence(__ATOMIC_RELEASE, "agent");
            asm volatile("s_waitcnt vmcnt(0)" ::: "memory");
            const unsigned og = xb_add(&bar[XB_TOP], 1u);
            const unsigned tg = og / nx;
            if (og + 1u == (tg + 1u) * nx) xb_add(&bar[XB_TOPGEN], 1u);
            else XB_SPIN(xb_ld(&bar[XB_TOPGEN]) == tg, bar);
            __builtin_amdgcn_fence(__ATOMIC_ACQUIRE, "agent");
            xb_add(&bar[XB_XGEN(b.x)], 1u);
            asm volatile("s_waitcnt vmcnt(0)" ::: "memory");
        } else {
            XB_SPIN(xb_ld(&bar[XB_XGEN(b.x)]) == gen, bar);
            __builtin_amdgcn_fence(__ATOMIC_ACQUIRE, "agent");
            asm volatile("s_waitcnt vmcnt(0)" ::: "memory");
        }
    }
    __syncthreads();
}

__device__ __forceinline__ void attn_phase_dyn(const CAS Args* A, char* lds, unsigned* ctr, int tid, bool leader) {
    using attn_body::bf16;
    bf16* Q = (bf16*)(A->ws + WS_MIX) + 512; const bf16* K = (const bf16*)(A->ws + WS_KV); const bf16* V = K + 128;
    const int h0 = (int)(xb_xcc_id() & 7u);
    volatile LAS unsigned* slot = (volatile LAS unsigned*)((LAS unsigned char*)lds + 154368 + 64);
#pragma nounroll
    for (int qi = 0; qi < 8; ++qi) {
        const int h = (h0 + qi) & 7;
        for (;;) {
            if (leader) *slot = atomicAdd(ctr + h * 64, 1u);
            __syncthreads();
            const int k = (int)__builtin_amdgcn_readfirstlane((int)*slot);
            __syncthreads();
            if (k >= 320) break;
            if (k < 64) attn_body::attn_unit<8>(0, MP, h, k, Q, K, V, Q, lds, tid);
            else { const int ks = k - 64; attn_body::attn_unit<8>((long)MP + (long)(ks >> 4) * TSAMP, TSAMP, h, ks & 15, Q, K, V, Q, lds, tid); }
        }
    }
}
#ifndef STOP_AFTER
#define STOP_AFTER 99
#endif
__device__ __forceinline__ int fresh(int v) { asm volatile("" : "+s"(v)); return v; }
__device__ __forceinline__ int freshv(int v) { asm volatile("" : "+v"(v)); return v; }
__device__ __forceinline__ const CAS Args* get_args() { unsigned long long v = (unsigned long long)(uintptr_t)__builtin_amdgcn_kernarg_segment_ptr(); asm volatile("" : "+s"(v)); return (const CAS Args*)v; }
__global__ void __launch_bounds__(NWAVES * 64, 2) hymba_fwd(Args args_unused) {
    extern __shared__ __attribute__((aligned(16))) unsigned char lds[];
    cg::grid_group grid = cg::this_grid();
    const int wave = __builtin_amdgcn_readfirstlane((int)threadIdx.x >> 6), G = gridDim.x;
#define LANE_() ({ int z_ = 0; asm volatile("" : "+s"(z_)); (int)__builtin_amdgcn_mbcnt_hi(~0u, __builtin_amdgcn_mbcnt_lo(~0u, (unsigned)z_)); })
#define lane LANE_()
#define tid (wave * 64 + LANE_())
    LAS unsigned char* l3 = (LAS unsigned char*)lds;
    volatile LAS unsigned* xmisc = (volatile LAS unsigned*)(l3 + 154368);
    if (wave == 0 && LANE_() == 0) { xmisc[0] = 0u; xmisc[1] = 0u; }
    __syncthreads();
    (void)xcd_barrier_post((unsigned*)(get_args()->ws + WS_CTL), xmisc, wave == 0 && LANE_() == 0);
#ifdef USE_CG_SYNC
#define GSYNC() do { grid.sync(); } while (0)
#else
#define GSYNC() do { XcdBarrier b_; b_.bar = (unsigned*)(get_args()->ws + WS_CTL); b_.x = xb_xcc_id(); b_.st = (volatile LAS unsigned*)((LAS unsigned char*)lds + 154368); xcd_barrier(b_, fresh(wave) == 0 && LANE_() == 0); } while (0)
#endif
#ifdef EXP_READOUT
    { const CAS Args* a = get_args(); if (blockIdx.x == 0 && tid == 0) { const float v = a->out[EXP_READOUT]; if (v == 123.456f) ((float*)(a->ws + WS_MOD))[0] = v; } }
#ifdef EXP_READALL
    { const CAS Args* a = get_args(); float acc = 0.f; for (size_t i = (size_t)blockIdx.x * 512 + tid; i < (size_t)MT * D; i += (size_t)gridDim.x * 512) acc += a->out[i]; if (acc == 123.456f) ((float*)(a->ws + WS_MOD))[1] = acc; }
#endif
#endif
    { const CAS Args* a = get_args(); p0_mod(a, l3, tid); p0_prologue(a, l3, wave, freshv(lane), fresh(G)); }
#ifdef DUP_P0
    __syncthreads(); { const CAS Args* a = get_args(); p0_mod(a, l3, tid); p0_prologue(a, l3, wave, freshv(lane), fresh(G)); }
#endif
    GSYNC(); if (STOP_AFTER == 0) return;
#pragma nounroll
    for (int l0 = 0; l0 < DEPTH; ++l0) {
        int l = l0; asm volatile("" : "+s"(l));
        { const CAS Args* a = get_args(); unsigned char* ws = a->ws; float* out = a->out;
          const float* xp = l == 0 ? a->in[0] : out; const float* xs = l == 0 ? a->in[1] : out + (size_t)MP * D;
          norm_phase(xp, xs, a->in[6] + l * D, (const float*)(ws + WS_MOD) + (size_t)l * 6144, (bf16*)(ws + WS_XN), wave, freshv(lane), fresh(G));
#ifdef DUP_NORM
          norm_phase(xp, xs, a->in[6] + l * D, (const float*)(ws + WS_MOD) + (size_t)l * 6144, (bf16*)(ws + WS_XN), wave, freshv(lane), fresh(G));
#endif
        }
        GSYNC(); if (STOP_AFTER == 1) return;
        { const CAS Args* a = get_args(); unsigned char* ws = a->ws;
          pg8::Gemm g{(const bf16*)(ws + WS_XN), (const bf16*)(ws + WS_WIN) + (size_t)l * NINP * D, MT, NINP, D}; pg8::StaticOrder S; S.init(MT, NINP, fresh(G), fresh((int)blockIdx.x));
          pg8::EpiInProj E{(bf16*)(ws + WS_PROJ), (bf16*)(ws + WS_MIX), (bf16*)(ws + WS_KV)};
          pg8::gemm_phase<pg8::EpiInProj, pg8::StaticOrder, PG8_ALIGN, PG8_SP2>(l3, g, S, E, tid);
#ifdef DUP_GEMM
          __syncthreads(); pg8::gemm_phase<pg8::EpiInProj, pg8::StaticOrder, PG8_ALIGN, PG8_SP2>(l3, g, S, E, tid);
#endif
        }
        GSYNC(); if (STOP_AFTER == 2) return;
        { const CAS Args* a = get_args(); unsigned char* ws = a->ws;
          qk_prep_phase((bf16*)(ws + WS_MIX), (bf16*)(ws + WS_KV), a->in[20] + l * 64, a->in[21] + l * 64, wave, freshv(lane), fresh(G)); }
#ifndef NO_SCANA
        scan_phase<false>(get_args(), l3, l, wave, freshv(lane), fresh(G));
#endif
#ifdef DUP_SCANA
        scan_phase<false>(get_args(), l3, l, wave, freshv(lane), fresh(G));
#endif
        GSYNC(); if (STOP_AFTER == 3) return;
#ifndef NO_SCANB
        scanB_phase(get_args(), l3, wave, freshv(lane), fresh(G));
#endif
        __syncthreads();
        { const CAS Args* a = get_args(); attn_phase_dyn(a, (char*)lds, (unsigned*)(a->ws + WS_CTL) + 4096 + l * 1024, tid, fresh(wave) == 0 && LANE_() == 0); }
        GSYNC(); if (STOP_AFTER == 4) return;

#ifdef EXP_SLOAD
        probe_sload(get_args(), wave, freshv(lane), fresh(G));
#endif
#ifndef NO_SCANC
        scan_phase<true>(get_args(), l3, l, wave, freshv(lane), fresh(G));
#endif
#ifdef DUP_SCANC
        scan_phase<true>(get_args(), l3, l, wave, freshv(lane), fresh(G));
#endif
        GSYNC(); if (STOP_AFTER == 5) return;
#ifndef NO_POST
        post_phase(get_args(), l, wave, freshv(lane), fresh(G));
#endif
#ifdef DUP_POST
        post_phase(get_args(), l, wave, freshv(lane), fresh(G));
#endif
        GSYNC(); if (STOP_AFTER == 6) return;
#ifndef NO_P7
        { const CAS Args* a = get_args(); unsigned char* ws = a->ws; float* out = a->out;
          const float* xp = l == 0 ? a->in[0] : out; const float* xs = l == 0 ? a->in[1] : out + (size_t)MP * D;
          pg8::Gemm g{(const bf16*)(ws + WS_MIX), (const bf16*)(ws + WS_WOUT) + (size_t)l * D * D, MT, D, D}; pg8::StaticOrder S; S.init(MT, D, fresh(G), fresh((int)blockIdx.x));
          pg8::EpiResid E{xp, xs, out, (const float*)(ws + WS_MOD) + (size_t)l * 6144 + 2048};
          pg8::gemm_phase<pg8::EpiResid, pg8::StaticOrder, PG8_ALIGN, PG8_SP2>(l3, g, S, E, tid); }
#endif
        GSYNC(); if (STOP_AFTER == 7) return;
        { const CAS Args* a = get_args(); unsigned char* ws = a->ws; float* out = a->out;
          norm_phase(out, out + (size_t)MP * D, a->in[7] + l * D, (const float*)(ws + WS_MOD) + (size_t)l * 6144 + 3072, (bf16*)(ws + WS_XN), wave, freshv(lane), fresh(G)); }
        GSYNC(); if (STOP_AFTER == 8) return;
        { const CAS Args* a = get_args(); unsigned char* ws = a->ws;
          pg8::Gemm g{(const bf16*)(ws + WS_XN), (const bf16*)(ws + WS_WFFI) + (size_t)l * 2 * DFF * D, MT, 2 * DFF, D}; pg8::StaticOrder S; S.init(MT, 2 * DFF, fresh(G), fresh((int)blockIdx.x));
          pg8::EpiSwiGLU E{(bf16*)(ws + WS_ACT)};
          pg8::gemm_phase<pg8::EpiSwiGLU, pg8::StaticOrder, PG8_ALIGN, PG8_SP2>(l3, g, S, E, tid);
#ifdef DUP_GEMM
          __syncthreads(); pg8::gemm_phase<pg8::EpiSwiGLU, pg8::StaticOrder, PG8_ALIGN, PG8_SP2>(l3, g, S, E, tid);
#endif
        }
        GSYNC(); if (STOP_AFTER == 9) return;
        { const CAS Args* a = get_args(); unsigned char* ws = a->ws; float* out = a->out;
          pg8::Gemm g{(const bf16*)(ws + WS_ACT), (const bf16*)(ws + WS_WFFO) + (size_t)l * D * DFF, MT, D, DFF}; pg8::StaticOrder S; S.init(MT, D, fresh(G), fresh((int)blockIdx.x));
          pg8::EpiResid E{out, out + (size_t)MP * D, out, (const float*)(ws + WS_MOD) + (size_t)l * 6144 + 5120};
          pg8::gemm_phase<pg8::EpiResid, pg8::StaticOrder, PG8_ALIGN, PG8_SP2>(l3, g, S, E, tid); }
        if (l0 + 1 < DEPTH) GSYNC();
    }
}

extern "C" void kernel_launch(void* const* d_in, const int* in_sizes, int n_in, void* d_out, int out_size, void* d_ws, size_t ws_size, hipStream_t stream) {
    static int grid = 0;
    if (grid == 0) {
        if (n_in != 25 || ws_size < WS_END) { fprintf(stderr, "kernel_launch: unexpected n_in %d / ws %zu\n", n_in, ws_size); grid = -1; return; }
        int dev = 0, cus = 0, per_cu = 0;
        hipGetDevice(&dev); hipDeviceGetAttribute(&cus, hipDeviceAttributeMultiprocessorCount, dev);
        if (hipFuncSetAttribute((const void*)hymba_fwd, hipFuncAttributeMaxDynamicSharedMemorySize, LDS_BYTES) != hipSuccess) { fprintf(stderr, "kernel_launch: hipFuncSetAttribute failed\n"); grid = -1; return; }
        if (hipOccupancyMaxActiveBlocksPerMultiprocessor(&per_cu, (const void*)hymba_fwd, NWAVES * 64, LDS_BYTES) != hipSuccess || per_cu < 1) { fprintf(stderr, "kernel_launch: occupancy query says %d\n", per_cu); per_cu = 1; }
        (void)hipGetLastError();
        grid = cus * 1;
    }
    if (grid < 0) return;
    if (hipMemsetAsync((char*)d_ws + WS_CTL, 0, 32768, stream) != hipSuccess) { fprintf(stderr, "kernel_launch: memset failed\n"); return; }
    Args a{};
    for (int i = 0; i < 25; ++i) a.in[i] = (const float*)d_in[i];
    a.out = (float*)d_out; a.ws = (unsigned char*)d_ws;
    void* kargs[] = {&a};
    hipError_t e = hipLaunchCooperativeKernel((const void*)hymba_fwd, dim3(grid), dim3(NWAVES * 64), kargs, LDS_BYTES, stream);
    if (e != hipSuccess) fprintf(stderr, "cooperative launch failed: %s (grid %d)\n", hipGetErrorString(e), grid);
}
```

```cpp
#include <hip/hip_runtime.h>
#include <hip/hip_cooperative_groups.h>
#include <cstdio>
#include <cstdint>
namespace pg8 {
#define PG8_LAS __attribute__((address_space(3)))
typedef unsigned short bf16_t;
typedef short bf16x8 __attribute__((ext_vector_type(8)));
typedef float f32x4 __attribute__((ext_vector_type(4)));
typedef unsigned u32x4 __attribute__((ext_vector_type(4)));
constexpr int BM = 256, BK = 64, HALF = 128, HTB = HALF * BK * 2  , STAGE_BYTES = 8 * HTB, NXCD = 8, WGM = 8;

__host__ __device__ __forceinline__ int lds_byte(int r, int c) { const int st = (r >> 4) * 2 + (c >> 5), rr = r & 15, cc = c & 31, ob = rr * 64 + cc * 2; return st * 1024 + (ob ^ (((ob >> 9) & 1) << 5)); }
__host__ __device__ __forceinline__ void stage_rc(int b, int& R, int& C) { const int st = b / 1024, sb = b % 1024, swz = sb ^ (((sb >> 9) & 1) << 5); R = (st >> 1) * 16 + swz / 64; C = (st & 1) * 32 + (swz % 64) / 2; }
__host__ __device__ __forceinline__ int perm32(int rho) { const int n = rho >> 4, i = rho & 15; return 8 * (i >> 2) + 4 * n + (i & 3); }

struct Unit { int pm, pn; };
struct Gemm { const bf16_t* A; const bf16_t* Bt; int M, N, K; };

struct StaticOrder {
    int nM, nN, nwg, G, c;
    __host__ __device__ void init(int M, int N, int G_, int c_) { nM = M / BM; nN = N / BM; nwg = nM * nN; G = G_; c = c_; }
    __host__ __device__ bool next(int i, Unit& u) const {
        const int L = i * G + c; if (L >= nwg) return false;
        int wgid = (int)L; { const int q = nwg / NXCD, r = nwg % NXCD, xcd = wgid % NXCD, off = wgid / NXCD; wgid = (xcd < r ? xcd * (q + 1) : r * (q + 1) + (xcd - r) * q) + off; }
        const int nig = WGM * nN, gid = wgid / nig, fm = gid * WGM, gsz = (nM - fm) < WGM ? (nM - fm) : WGM;
        u.pm = fm + ((wgid % nig) % gsz); u.pn = (wgid % nig) / gsz; return true;
    }
    __device__ __forceinline__ void a_ready(const Unit&) const {}
    __device__ __forceinline__ void done(const Unit&) const {}
};

__device__ __forceinline__ unsigned cvt_pk_bf16(float lo, float hi) { unsigned r; asm volatile("v_cvt_pk_bf16_f32 %0, %1, %2" : "=v"(r) : "v"(lo), "v"(hi)); return r; }
struct EpiInProj {
    static constexpr bool PERM = true, AFTER_DRAIN = false;
    bf16_t* projR; bf16_t* mixin; bf16_t* kv;
    __device__ __forceinline__ void operator()(const f32x4 (&acc)[2][2][4][2], const Unit& u, int wr, int wc, int fr, int fq) const {
        const int pn = u.pn; bf16_t* base; int ldc, colt;
        if (pn < 6) { base = projR; ldc = 2048; colt = pn * 256; }
        else if (pn < 8) { base = mixin; ldc = 1024; colt = 512 + (pn - 6) * 256; }
        else if (pn == 8) { base = kv; ldc = 256; colt = 0; }
        else { base = projR; ldc = 2048; colt = 1536 + (pn - 9) * 256; }
        const int row0 = u.pm * BM + wr * 64 + fr, col0 = colt + wc * 32 + 8 * fq;
#pragma unroll
        for (int ai = 0; ai < 2; ++ai)
#pragma unroll
            for (int m = 0; m < 4; ++m) { bf16_t* rowp = base + (size_t)(row0 + ai * HALF + m * 16) * ldc + col0;
#pragma unroll
                for (int bj = 0; bj < 2; ++bj) { const f32x4 v0 = acc[ai][bj][m][0], v1 = acc[ai][bj][m][1];
                    u32x4 w; w.x = cvt_pk_bf16(v0[0], v0[1]); w.y = cvt_pk_bf16(v0[2], v0[3]); w.z = cvt_pk_bf16(v1[0], v1[1]); w.w = cvt_pk_bf16(v1[2], v1[3]);
                    *(u32x4*)(rowp + bj * HALF) = w; } }
    }
};
struct EpiResid {
    static constexpr bool PERM = false, AFTER_DRAIN = false;
    const float* xp; const float* xs; float* out; const float* gate;
    __device__ __forceinline__ void operator()(const f32x4 (&acc)[2][2][4][2], const Unit& u, int wr, int wc, int fr, int fq) const {
        const int seq = u.pm < 64 ? 0 : 1 + ((u.pm - 64) >> 4);
        const float* gp = gate + (size_t)seq * 12288;
        const int col0 = u.pn * BM + wc * 32 + 4 * fq;
        f32x4 gv[2][2];
#pragma unroll
        for (int bj = 0; bj < 2; ++bj)
#pragma unroll
            for (int n = 0; n < 2; ++n) gv[bj][n] = *(const f32x4*)(gp + col0 + bj * HALF + n * 16);

#ifdef EXP_XOUT
        const float* xb = out;
#else
        const float* xb = u.pm < 64 ? xp : xs - (size_t)16384 * 1024;
#endif

#pragma unroll
        for (int ai = 0; ai < 2; ++ai) {
            f32x4 bsv[4][2][2];
#pragma unroll
            for (int m = 0; m < 4; ++m) { const size_t off = (size_t)(u.pm * BM + ai * HALF + wr * 64 + m * 16 + fr) * 1024 + col0;
#pragma unroll
                for (int bj = 0; bj < 2; ++bj)
#pragma unroll
                    for (int n = 0; n < 2; ++n) bsv[m][bj][n] = *(const f32x4*)(xb + off + bj * HALF + n * 16); }
            asm volatile("" ::: "memory");
#pragma unroll
            for (int m = 0; m < 4; ++m) { const size_t off = (size_t)(u.pm * BM + ai * HALF + wr * 64 + m * 16 + fr) * 1024 + col0;
#pragma unroll
                for (int bj = 0; bj < 2; ++bj)
#pragma unroll
                    for (int n = 0; n < 2; ++n) *(f32x4*)(out + off + bj * HALF + n * 16) = bsv[m][bj][n] + gv[bj][n] * acc[ai][bj][m][n]; }
            asm volatile("" ::: "memory");
        }
    }
};
struct EpiSwiGLU {
    static constexpr bool PERM = true, AFTER_DRAIN = false;
    bf16_t* act;
    __device__ __forceinline__ void operator()(const f32x4 (&acc)[2][2][4][2], const Unit& u, int wr, int wc, int fr, int fq) const {
        const int row0 = u.pm * BM + wr * 64 + fr, col0 = u.pn * 128 + wc * 32 + 8 * fq;
#pragma unroll
        for (int ai = 0; ai < 2; ++ai)
#pragma unroll
            for (int m = 0; m < 4; ++m) { bf16_t* rowp = act + (size_t)(row0 + ai * HALF + m * 16) * 2816 + col0;
                float o[8];
#pragma unroll
                for (int n = 0; n < 2; ++n)
#pragma unroll
                    for (int i = 0; i < 4; ++i) { const float g = acc[ai][0][m][n][i], up = acc[ai][1][m][n][i];
                        o[n * 4 + i] = g * __builtin_amdgcn_rcpf(1.0f + __builtin_amdgcn_exp2f(-1.4426950408889634f * g)) * up; }
                u32x4 w; w.x = cvt_pk_bf16(o[0], o[1]); w.y = cvt_pk_bf16(o[2], o[3]); w.z = cvt_pk_bf16(o[4], o[5]); w.w = cvt_pk_bf16(o[6], o[7]);
                *(u32x4*)rowp = w; }
    }
};
template <class Epi, class Sched, bool ALIGN_EPI = false, bool SP2 = false>
__device__ __forceinline__ void gemm_phase(PG8_LAS unsigned char* lds, const Gemm g, const Sched& S, const Epi& E, int tid_in) {
    int tid_ = tid_in; asm volatile("" : "+v"(tid_)); const int tid = tid_, wid = __builtin_amdgcn_readfirstlane(tid >> 6), lane = tid & 63, wr = wid >> 2, wc = wid & 3, fr = lane & 15, fq = lane >> 4;
    const int K = g.K, nt = K / BK;
    unsigned voffA[2], voffB[2];
#pragma unroll
    for (int i = 0; i < 2; ++i) { int R, C; stage_rc(tid * 16 + i * 8192, R, C); const int Rb = Epi::PERM ? ((R & ~31) + perm32(R & 31)) : R;
        voffA[i] = (unsigned)(R * K + C) * 2u; voffB[i] = (unsigned)(Rb * K + C) * 2u; }
    const size_t kstep = (size_t)(BK * 2);
    const size_t hstep = (size_t)HALF * K * 2;
    const size_t tstep = 2 * hstep;
    const unsigned ldsw = (unsigned)wid * 1024u;
    const int aoff = lds_byte(wr * 64 + fr, fq * 8), boff = lds_byte(wc * 32 + fr, fq * 8);
#define PG8_SA(b, h) (((b) * 2 + (h)) * HTB)
#define PG8_SB(b, h) ((4 + (b) * 2 + (h)) * HTB)
#define PG8_STAGE(bufoff, gbase, voff) do { _Pragma("unroll") for (int _i = 0; _i < 2; ++_i) \
        __builtin_amdgcn_global_load_lds((const unsigned*)((const char*)(gbase) + (voff)[_i]), (PG8_LAS unsigned*)(lds + (bufoff) + ldsw + _i * 8192), 16, 0, 0); } while (0)
#define PG8_LDA(dst, b, h) do { _Pragma("unroll") for (int m = 0; m < 4; ++m) _Pragma("unroll") for (int k = 0; k < 2; ++k) dst[m][k] = *(const PG8_LAS bf16x8*)(lds + PG8_SA(b, h) + aoff + m * 2048 + k * 1024); } while (0)
#define PG8_LDB(dst, b, h) do { _Pragma("unroll") for (int n = 0; n < 2; ++n) _Pragma("unroll") for (int k = 0; k < 2; ++k) dst[n][k] = *(const PG8_LAS bf16x8*)(lds + PG8_SB(b, h) + boff + n * 2048 + k * 1024); } while (0)
#define PG8_MMA(ai, bj, At, Bt) do { __builtin_amdgcn_s_setprio(1); _Pragma("unroll") for (int m = 0; m < 4; ++m) _Pragma("unroll") for (int n = 0; n < 2; ++n) _Pragma("unroll") for (int k = 0; k < 2; ++k) \
        acc[ai][bj][m][n] = __builtin_amdgcn_mfma_f32_16x16x32_bf16(Bt[n][k], At[m][k], acc[ai][bj][m][n], 0, 0, 0); __builtin_amdgcn_s_setprio(0); } while (0)
#define PG8_WAIT_V(n) asm volatile("s_waitcnt vmcnt(" #n ")" ::: "memory")
#define PG8_WAIT_L(n) asm volatile("s_waitcnt lgkmcnt(" #n ")" ::: "memory")
#define PG8_BAR __builtin_amdgcn_s_barrier()
#define PG8_SCHED __builtin_amdgcn_sched_barrier(0)
    Unit cur, nxt; int ui = 0;
    if (!S.next(0, cur)) return;
    f32x4 acc[2][2][4][2];
#pragma unroll
    for (int a = 0; a < 2; ++a)
#pragma unroll
        for (int b = 0; b < 2; ++b)
#pragma unroll
            for (int m = 0; m < 4; ++m)
#pragma unroll
                for (int n = 0; n < 2; ++n) acc[a][b][m][n] = (f32x4){0.f, 0.f, 0.f, 0.f};
    bf16x8 At[4][2], B0[2][2], B1[2][2];
    const char* cA = (const char*)g.A + (size_t)cur.pm * tstep; const char* cB = (const char*)g.Bt + (size_t)cur.pn * tstep;
    S.a_ready(cur);
    if constexpr (SP2) {
        PG8_STAGE(PG8_SB(0, 0), cB, voffB); PG8_STAGE(PG8_SB(0, 1), cB + hstep, voffB); PG8_STAGE(PG8_SA(0, 0), cA, voffA); PG8_STAGE(PG8_SA(0, 1), cA + hstep, voffA);
        if (wr == 1) PG8_BAR;
        PG8_WAIT_V(2); PG8_BAR;
        PG8_STAGE(PG8_SB(1, 0), cB + kstep, voffB); PG8_STAGE(PG8_SA(1, 0), cA + kstep, voffA); PG8_STAGE(PG8_SB(1, 1), cB + hstep + kstep, voffB);
        PG8_WAIT_V(6); PG8_BAR;
    } else {
        PG8_STAGE(PG8_SB(0, 0), cB, voffB); PG8_STAGE(PG8_SA(0, 0), cA, voffA); PG8_STAGE(PG8_SB(0, 1), cB + hstep, voffB); PG8_STAGE(PG8_SA(0, 1), cA + hstep, voffA);
        if (wr == 1) PG8_BAR;
        PG8_WAIT_V(4); PG8_BAR;
        PG8_STAGE(PG8_SB(1, 0), cB + kstep, voffB); PG8_STAGE(PG8_SA(1, 0), cA + kstep, voffA); PG8_STAGE(PG8_SB(1, 1), cB + hstep + kstep, voffB);
        PG8_WAIT_V(6); PG8_BAR;
    }
    for (;;) {
        const bool has_next = S.next(ui + 1, nxt);
        const char* nA = has_next ? (const char*)g.A + (size_t)nxt.pm * tstep : cA; const char* nB = has_next ? (const char*)g.Bt + (size_t)nxt.pn * tstep : cB;
        for (int t = 0; t < nt; t += 2) {
            const bool last = (t == nt - 2);
            const char* a1 = cA + (size_t)(t + 1) * kstep;
            const char* a2 = last ? nA : cA + (size_t)(t + 2) * kstep; const char* b2 = last ? nB : cB + (size_t)(t + 2) * kstep;
            const char* a3 = a2 + kstep; const char* b3 = b2 + kstep;
            if (last && has_next) S.a_ready(nxt);
            if constexpr (SP2) {
            PG8_LDB(B0, 0, 0); PG8_LDB(B1, 0, 1); PG8_SCHED; PG8_LDA(At, 0, 0); PG8_STAGE(PG8_SA(1, 1), a1 + hstep, voffA);
            PG8_WAIT_V(8); PG8_WAIT_L(0); PG8_BAR; PG8_MMA(0, 0, At, B0); PG8_MMA(0, 1, At, B1); PG8_BAR; PG8_SCHED;
            PG8_LDA(At, 0, 1); PG8_STAGE(PG8_SB(0, 0), b2, voffB); PG8_STAGE(PG8_SB(0, 1), b2 + hstep, voffB); PG8_STAGE(PG8_SA(0, 0), a2, voffA);
            PG8_WAIT_V(8); PG8_WAIT_L(0); PG8_BAR; PG8_MMA(1, 0, At, B0); PG8_MMA(1, 1, At, B1); PG8_BAR; PG8_SCHED;
            PG8_LDB(B0, 1, 0); PG8_LDB(B1, 1, 1); PG8_SCHED; PG8_LDA(At, 1, 0); PG8_STAGE(PG8_SA(0, 1), a2 + hstep, voffA);
            PG8_WAIT_V(8); PG8_WAIT_L(0); PG8_BAR; PG8_MMA(0, 0, At, B0); PG8_MMA(0, 1, At, B1); PG8_BAR; PG8_SCHED;
            PG8_LDA(At, 1, 1); PG8_STAGE(PG8_SB(1, 0), b3, voffB); PG8_STAGE(PG8_SB(1, 1), b3 + hstep, voffB); PG8_STAGE(PG8_SA(1, 0), a3, voffA);
            PG8_WAIT_V(8); PG8_WAIT_L(0); PG8_BAR; PG8_MMA(1, 0, At, B0); PG8_MMA(1, 1, At, B1); PG8_BAR; PG8_SCHED;
            } else {
            PG8_LDB(B0, 0, 0); PG8_SCHED; PG8_LDA(At, 0, 0); PG8_STAGE(PG8_SA(1, 1), a1 + hstep, voffA);
            PG8_WAIT_L(8); PG8_BAR; PG8_WAIT_L(0); PG8_MMA(0, 0, At, B0); PG8_BAR; PG8_SCHED;
            PG8_LDB(B1, 0, 1); PG8_STAGE(PG8_SB(0, 0), b2, voffB);
            PG8_BAR; PG8_WAIT_L(0); PG8_MMA(0, 1, At, B1); PG8_BAR;
            PG8_LDA(At, 0, 1); PG8_STAGE(PG8_SA(0, 0), a2, voffA);
            PG8_BAR; PG8_WAIT_L(0); PG8_MMA(1, 0, At, B0); PG8_BAR; PG8_SCHED;
            PG8_STAGE(PG8_SB(0, 1), b2 + hstep, voffB);
            PG8_WAIT_V(6); PG8_BAR; PG8_MMA(1, 1, At, B1); PG8_BAR;
            PG8_LDB(B0, 1, 0); PG8_SCHED; PG8_LDA(At, 1, 0); PG8_STAGE(PG8_SA(0, 1), a2 + hstep, voffA);
            PG8_WAIT_L(8); PG8_BAR; PG8_WAIT_L(0); PG8_MMA(0, 0, At, B0); PG8_BAR; PG8_SCHED;
            PG8_LDB(B1, 1, 1); PG8_STAGE(PG8_SB(1, 0), b3, voffB);
            PG8_BAR; PG8_WAIT_L(0); PG8_MMA(0, 1, At, B1); PG8_BAR;
            PG8_LDA(At, 1, 1); PG8_STAGE(PG8_SA(1, 0), a3, voffA);
            PG8_BAR; PG8_WAIT_L(0); PG8_MMA(1, 0, At, B0); PG8_BAR; PG8_SCHED;
            PG8_STAGE(PG8_SB(1, 1), b3 + hstep, voffB);
            PG8_WAIT_V(6); PG8_BAR; PG8_MMA(1, 1, At, B1); PG8_BAR;
            }
        }
        if constexpr (ALIGN_EPI) { if (wr == 0) PG8_BAR; }
        if constexpr (!Epi::AFTER_DRAIN) { E(acc, cur, wr, wc, fr, fq); S.done(cur); }
        if (!has_next) break;
#pragma unroll
        for (int a = 0; a < 2; ++a)
#pragma unroll
            for (int b = 0; b < 2; ++b)
#pragma unroll
                for (int m = 0; m < 4; ++m)
#pragma unroll
                    for (int n = 0; n < 2; ++n) acc[a][b][m][n] = (f32x4){0.f, 0.f, 0.f, 0.f};
        cur = nxt; cA = nA; cB = nB; ++ui;
        if constexpr (ALIGN_EPI) { if (wr == 1) PG8_BAR; }
    }
    PG8_WAIT_V(0);
    if constexpr (!ALIGN_EPI) { if (wr == 0) PG8_BAR; }
    PG8_BAR;
    if constexpr (Epi::AFTER_DRAIN) { E.fused(acc, cur, wr, wc, fr, fq, lds, wid, lane); S.done(cur); }
#undef PG8_SA
#undef PG8_SB
#undef PG8_STAGE
#undef PG8_LDA
#undef PG8_LDB
#undef PG8_MMA
#undef PG8_WAIT_V
#undef PG8_WAIT_L
#undef PG8_BAR
#undef PG8_SCHED
}
}

#ifndef PG8_SP2
#define PG8_SP2 true
#endif
#ifndef PG8_ALIGN
#define PG8_ALIGN true
#endif
#include <hip/hip_bf16.h>
#include <cmath>
namespace attn_body {
using bf16=__hip_bfloat16;
using bf16x8=__attribute__((ext_vector_type(8)))short;
using s16x4=__attribute__((ext_vector_type(4)))short;
using f32x16=__attribute__((ext_vector_type(16)))float;
using u32x4=__attribute__((ext_vector_type(4)))unsigned;
constexpr int D=64,QP=1024,KVP=256;
constexpr int NW=8,QBLK=32,QB=QBLK*NW,KVBLK=64;
constexpr int ATTN_UNIT_ROWS=QB;
__device__ __forceinline__ int crow(int r,int hi){return (r&3)+8*(r>>2)+4*hi;}
#define SBAR() __builtin_amdgcn_sched_barrier(0)
__device__ __forceinline__ void cmask(f32x16&p0,f32x16&p1,int jb,int qrel,int hi){
  const float NEG=-INFINITY; int kb=64*jb+4*hi;
  #pragma unroll
  for(int r=0;r<16;++r){int kv=kb+(r&3)+8*(r>>2); if(kv>qrel)p0[r]=NEG; if(kv+32>qrel)p1[r]=NEG;}
}

constexpr int NSLOT=3, SLOTB=8192;
constexpr int LDS_K=0, LDS_V=NSLOT*SLOTB, LDS_WS=2*NSLOT*SLOTB, LDS_OST=LDS_WS+NW*64*4, LDS_BYTES=LDS_OST+NW*4096;
constexpr float C2=0.125f*1.4426950408889634f;
__device__ __forceinline__ void glds16(const void*gsrc,unsigned lds_dst){unsigned keep;
  asm volatile("s_mov_b32 %0, m0\n\ts_mov_b32 m0, %2\n\ts_nop 0\n\tglobal_load_lds_dwordx4 %1, off\n\ts_mov_b32 m0, %0":"=&s"(keep):"v"(gsrc),"s"(lds_dst):"memory");}
__device__ __forceinline__ float max3f(float a,float b,float c){float r;asm("v_max3_f32 %0, %1, %2, %3":"=v"(r):"v"(a),"v"(b),"v"(c));return r;}
__device__ __forceinline__ float max2f(float a,float b){float r;asm("v_max_f32_e32 %0, %1, %2":"=v"(r):"v"(a),"v"(b));return r;}
__device__ __forceinline__ float fadd_s(float a,float b){float r;asm("v_add_f32_e32 %0, %1, %2":"=v"(r):"v"(a),"v"(b));return r;}
__device__ __forceinline__ float fsub_s(float a,float b){float r;asm("v_sub_f32_e32 %0, %1, %2":"=v"(r):"v"(a),"v"(b));return r;}
typedef float f32x2_t __attribute__((ext_vector_type(2))); typedef __bf16 bf16x2_t __attribute__((ext_vector_type(2)));
__device__ __forceinline__ unsigned cvtpk_s(float lo,float hi){f32x2_t v={lo,hi};bf16x2_t b=__builtin_convertvector(v,bf16x2_t);return __builtin_bit_cast(unsigned,b);}
#define WAIT_BAR(N) asm volatile("s_waitcnt vmcnt(" #N ") lgkmcnt(0)\n\ts_barrier":::"memory")

__device__ __forceinline__ void qkt(f32x16&p0,f32x16&p1,const char*Kslot,const bf16x8*qr,const f32x16&negm,int r32,int hi){
  const char*kb=Kslot+hi*1024+r32*16;
  #pragma unroll
  for(int d0=0;d0<4;++d0){
    const bf16x8 b0=*reinterpret_cast<const bf16x8*>(kb+d0*2048);
    const bf16x8 b1=*reinterpret_cast<const bf16x8*>(kb+d0*2048+512);
    if(d0==0){p0=__builtin_amdgcn_mfma_f32_32x32x16_bf16(b0,qr[0],negm,0,0,0);p1=__builtin_amdgcn_mfma_f32_32x32x16_bf16(b1,qr[0],negm,0,0,0);}
    else{p0=__builtin_amdgcn_mfma_f32_32x32x16_bf16(b0,qr[d0],p0,0,0,0);p1=__builtin_amdgcn_mfma_f32_32x32x16_bf16(b1,qr[d0],p1,0,0,0);}}
}
typedef __attribute__((address_space(3))) const char* lds_cptr;
typedef short v4i16_t __attribute__((ext_vector_type(4)));
__device__ __forceinline__ void kload8(bf16x8*kf,lds_cptr kp){
  kf[0]=*(const __attribute__((address_space(3))) bf16x8*)(kp);      kf[1]=*(const __attribute__((address_space(3))) bf16x8*)(kp+512);
  kf[2]=*(const __attribute__((address_space(3))) bf16x8*)(kp+2048); kf[3]=*(const __attribute__((address_space(3))) bf16x8*)(kp+2560);
  kf[4]=*(const __attribute__((address_space(3))) bf16x8*)(kp+4096); kf[5]=*(const __attribute__((address_space(3))) bf16x8*)(kp+4608);
  kf[6]=*(const __attribute__((address_space(3))) bf16x8*)(kp+6144); kf[7]=*(const __attribute__((address_space(3))) bf16x8*)(kp+6656);
}
__device__ __forceinline__ void kload2(bf16x8*kf,lds_cptr kp,int j){ kf[2*j]=*(const __attribute__((address_space(3))) bf16x8*)(kp+j*2048); kf[2*j+1]=*(const __attribute__((address_space(3))) bf16x8*)(kp+j*2048+512); }
__device__ __forceinline__ s16x4 vtr(lds_cptr p){ return __builtin_bit_cast(s16x4,__builtin_amdgcn_ds_read_tr16_b64_v4i16((__attribute__((address_space(3))) v4i16_t*)p)); }
__device__ __forceinline__ float rowmax(const f32x16&p0,const f32x16&p1){
  float a=max3f(p0[0],p0[1],p1[0]),b=max3f(p0[2],p0[3],p1[1]);a=max3f(a,p1[2],p1[3]);
  #pragma unroll
  for(int r=4;r<16;r+=4){a=max3f(a,p0[r],p0[r+1]);b=max3f(b,p0[r+2],p0[r+3]);a=max3f(a,p1[r],p1[r+1]);b=max3f(b,p1[r+2],p1[r+3]);}
  const float m=max2f(a,b);
  auto rr=__builtin_amdgcn_permlane32_swap(__float_as_uint(m),__float_as_uint(m),false,false);
  return max2f(__uint_as_float(rr[0]),__uint_as_float(rr[1]));
}
__device__ __forceinline__ void pv(f32x16*o,int vb,bf16x8 pa0,bf16x8 pa1,bf16x8 pa2,bf16x8 pa3){
  #pragma unroll
  for(int d0=0;d0<2;++d0){s16x4 lo[4],hi[4];
    #pragma unroll
    for(int ks=0;ks<4;++ks){
      asm volatile("ds_read_b64_tr_b16 %0,%1 offset:%c2":"=&v"(lo[ks]):"v"(vb),"i"(d0*4096+ks*1024):"memory");
      asm volatile("ds_read_b64_tr_b16 %0,%1 offset:%c2":"=&v"(hi[ks]):"v"(vb),"i"(d0*4096+ks*1024+512):"memory");}
    asm volatile("s_waitcnt lgkmcnt(0)":::"memory");SBAR();
    #define PK(k) (bf16x8){lo[k][0],lo[k][1],lo[k][2],lo[k][3],hi[k][0],hi[k][1],hi[k][2],hi[k][3]}
    o[d0]=__builtin_amdgcn_mfma_f32_32x32x16_bf16(pa0,PK(0),o[d0],0,0,0);
    o[d0]=__builtin_amdgcn_mfma_f32_32x32x16_bf16(pa1,PK(1),o[d0],0,0,0);
    o[d0]=__builtin_amdgcn_mfma_f32_32x32x16_bf16(pa2,PK(2),o[d0],0,0,0);
    o[d0]=__builtin_amdgcn_mfma_f32_32x32x16_bf16(pa3,PK(3),o[d0],0,0,0);
    #undef PK
  }
}

#ifndef ATTN_STORE16
#define ATTN_STORE16(p,v) (*(u32x4*)(p)=(v))
#endif
template<int THRL> __device__ __forceinline__ void attn_unit(long rowbase,int T,int h,int qb,const bf16*Q,const bf16*K,const bf16*V,bf16*O,char*shm,int tid_in){
  int tid_=tid_in; asm volatile("":"+v"(tid_)); const int tid=tid_,lane=tid&63,r32=lane&31,hi=lane>>5; const int wid=__builtin_amdgcn_readfirstlane(tid>>6);
  const int q0=qb*QB;
  const bf16*Qw=Q+(rowbase+q0+wid*QBLK)*QP+h*D;
  const bf16*Kh=K+rowbase*KVP+(h>>2)*D,*Vh=V+rowbase*KVP+(h>>2)*D;
  const unsigned lds0=(unsigned)(uintptr_t)shm;
  float*wsf=(float*)(shm+LDS_WS)+wid*64;
  const bf16*ksrc=Kh+(long)lane*KVP+wid*8;
  const bf16*vsrc=Vh+(long)(16*(wid&3)+(lane>>2))*KVP+(wid>>2)*32+(lane&3)*8;
  const unsigned kdst=lds0+LDS_K+wid*1024, vdst=lds0+LDS_V+wid*1024;
  #define DMA_K(t,slot) glds16(ksrc+(long)(t)*KVBLK*KVP,(unsigned)__builtin_amdgcn_readfirstlane(kdst+(slot)))
  #define DMA_V(t,slot) glds16(vsrc+(long)(t)*KVBLK*KVP,(unsigned)__builtin_amdgcn_readfirstlane(vdst+(slot)))
  const int vb0=(int)(lds0+LDS_V)+((lane>>4)&1)*32+(lane&3)*8+(4*hi+((lane&15)>>2))*64;
  const char*Kbase=shm+LDS_K; bf16x8 kf[8];
  const lds_cptr shm3=(lds_cptr)shm; const lds_cptr kp0=shm3+LDS_K+hi*1024+r32*16; const lds_cptr vp0=shm3+LDS_V+((lane>>4)&1)*32+(lane&3)*8+(4*hi+((lane&15)>>2))*64;
  const int NT=T/KVBLK;
  DMA_K(0,0);DMA_V(0,0);DMA_K(1,SLOTB);
  bf16x8 qr[4];
  #pragma unroll
  for(int d0=0;d0<4;++d0)qr[d0]=*reinterpret_cast<const bf16x8*>(&Qw[(long)r32*QP+d0*16+hi*8]);
  float mhat=0.f,l_reg=0.f;f32x16 o[2];o[0]=f32x16{};o[1]=f32x16{};f32x16 negm=f32x16{};asm volatile("":"+v"(negm));

  #define CMASK(P0,P1,t) do{}while(0)
  bool resc=false;
  #define START(P0,P1) do{ const float rm=rowmax(P0,P1); resc=false; \
    { const float dl=rm; mhat=fadd_s(mhat,dl); \
      _Pragma("unroll") for(int r=0;r<16;++r){P0[r]=fsub_s(P0[r],dl);P1[r]=fsub_s(P1[r],dl);} \
      _Pragma("unroll") for(int r=0;r<16;++r)negm[r]=-mhat; asm volatile("":"+v"(negm)); } \
    _Pragma("unroll") for(int r=0;r<16;++r)P0[r]=__builtin_amdgcn_exp2f(P0[r]); }while(0)
  #define RESC() do{ if(resc){ asm volatile("s_waitcnt lgkmcnt(0)":::"memory"); \
      _Pragma("unroll") for(int d_=0;d_<2;++d_) _Pragma("unroll") for(int r=0;r<16;++r)o[d_][r]*=wsf[crow(r,hi)]; } }while(0)
  f32x16 pA0,pA1,pB0,pB1;
  int sl_prev=0,sl_cur=0,sl_next=SLOTB;
  #define ROT() do{sl_prev=sl_cur;sl_cur=sl_next;sl_next=(sl_next==(NSLOT-1)*SLOTB)?0:sl_next+SLOTB;}while(0)
  DMA_K(2,2*SLOTB);
  WAIT_BAR(3);
  qkt(pA0,pA1,Kbase,qr,negm,r32,hi);asm volatile("s_nop 15\n\ts_nop 7":"+v"(pA0),"+v"(pA1));CMASK(pA0,pA1,0);
  START(pA0,pA1);
  _Pragma("unroll") for(int r=0;r<16;++r)pA1[r]=__builtin_amdgcn_exp2f(pA1[r]);
  WAIT_BAR(0);
  DMA_K(3,0);DMA_V(1,SLOTB);
  ROT();
  kload8(kf,kp0+sl_cur);
  WAIT_BAR(2);
  s16x4 vlo[8],vhi[8]; u32x4 pw0,pw1,pw2,pw3;
  #define PKW(P,B) cvtpk_s(P[B],P[B+1])
  #define PAF(k) __builtin_bit_cast(bf16x8,pw##k)
  #define VFR(i) (bf16x8){vlo[i][0],vlo[i][1],vlo[i][2],vlo[i][3],vhi[i][0],vhi[i][1],vhi[i][2],vhi[i][3]}
  #define PIN(x) asm volatile("":"+v"(x))
  #define MX3(a,b,c) __builtin_fmaxf(__builtin_fmaxf((a),(b)),(c))
  #define GAPA(MF,A0,A1,A2,A3,W0,W1,PW) do{ MF; sacc+=A0; sacc+=A1; sacc+=A2; sacc+=A3; PIN(sacc); W0; W1; PIN(PW); SBAR(); }while(0)
  #define EX(v) __builtin_amdgcn_exp2f(v)
  #define GAPB(MF,X,B) do{ MF; X[B]=EX(X[B]); X[B+1]=EX(X[B+1]); X[B+2]=EX(X[B+2]); X[B+3]=EX(X[B+3]); PIN(X); SBAR(); }while(0)
  #define VRD(i) do{ vlo[i]=vtr(vp_+(((i)>>2)*4096+((i)&3)*1024)); vhi[i]=vtr(vp_+(((i)>>2)*4096+((i)&3)*1024+512)); }while(0)
  #define KRD(G,j) do{ if(G){ kload2(kf,kp0+sl_next,j); SBAR(); } }while(0)
  #define STEP(C0,C1,P0,P1,t,GK,GV,GL) do{ SBAR(); \
    const lds_cptr vp_=vp0+sl_prev; \
    VRD(0); SBAR(); float sacc=(P0[0]+P0[1]); \
    GAPA(C0=__builtin_amdgcn_mfma_f32_32x32x16_bf16(kf[0],qr[0],negm,0,0,0), P0[2],P0[3],P0[4],P0[5],     pw0[0]=PKW(P0,0), pw0[1]=PKW(P0,2), pw0); \
    VRD(4); SBAR(); GAPA(C1=__builtin_amdgcn_mfma_f32_32x32x16_bf16(kf[1],qr[0],negm,0,0,0), P0[6],P0[7],P0[8],P0[9],     pw0[2]=PKW(P0,4), pw0[3]=PKW(P0,6), pw0); \
    VRD(1); SBAR(); GAPA(C0=__builtin_amdgcn_mfma_f32_32x32x16_bf16(kf[2],qr[1],C0,0,0,0),   P0[10],P0[11],P0[12],P0[13], pw1[0]=PKW(P0,8), pw1[1]=PKW(P0,10), pw1); \
    VRD(5); SBAR(); GAPA(C1=__builtin_amdgcn_mfma_f32_32x32x16_bf16(kf[3],qr[1],C1,0,0,0),   P0[14],P0[15],P1[0],P1[1],   pw1[2]=PKW(P0,12),pw1[3]=PKW(P0,14), pw1); \
    VRD(2); SBAR(); GAPA(C0=__builtin_amdgcn_mfma_f32_32x32x16_bf16(kf[4],qr[2],C0,0,0,0),   P1[2],P1[3],P1[4],P1[5],     pw2[0]=PKW(P1,0), pw2[1]=PKW(P1,2), pw2); \
    VRD(6); SBAR(); GAPA(C1=__builtin_amdgcn_mfma_f32_32x32x16_bf16(kf[5],qr[2],C1,0,0,0),   P1[6],P1[7],P1[8],P1[9],     pw2[2]=PKW(P1,4), pw2[3]=PKW(P1,6), pw2); \
    VRD(3); SBAR(); GAPA(C0=__builtin_amdgcn_mfma_f32_32x32x16_bf16(kf[6],qr[3],C0,0,0,0),   P1[10],P1[11],P1[12],P1[13], pw3[0]=PKW(P1,8), pw3[1]=PKW(P1,10), pw3); \
    VRD(7); SBAR(); GAPA(C1=__builtin_amdgcn_mfma_f32_32x32x16_bf16(kf[7],qr[3],C1,0,0,0),   P1[14],P1[15],0.f,0.f,       pw3[2]=PKW(P1,12),pw3[3]=PKW(P1,14), pw3); \
    l_reg+=sacc; \
    if(GK){DMA_K((t)+3,sl_cur);} if(GV){DMA_V((t)+1,sl_next);} \
    CMASK(C0,C1,t); \
    { float a=MX3(C0[0],C0[1],C1[0]),b=MX3(C0[2],C0[3],C1[1]); a=MX3(a,C1[2],C1[3]); \
      _Pragma("unroll") for(int r=4;r<16;r+=4){a=MX3(a,C0[r],C0[r+1]);b=MX3(b,C0[r+2],C0[r+3]);a=MX3(a,C1[r],C1[r+1]);b=MX3(b,C1[r+2],C1[r+3]);} \
      float rm=__builtin_fmaxf(a,b); { auto rr=__builtin_amdgcn_permlane32_swap(__float_as_uint(rm),__float_as_uint(rm),false,false); rm=__builtin_fmaxf(__uint_as_float(rr[0]),__uint_as_float(rr[1])); } \
      resc=false; \
      if(__builtin_expect(__any(rm>(float)THRL),0)){ const float dl=__builtin_fmaxf(rm,0.f); mhat+=dl; \
        _Pragma("unroll") for(int r=0;r<16;++r){C0[r]-=dl;C1[r]-=dl;} \
        _Pragma("unroll") for(int r=0;r<16;++r)negm[r]=-mhat; asm volatile("":"+v"(negm)); \
        const float f=__builtin_amdgcn_exp2f(-dl); l_reg*=f; if(hi==0)wsf[r32]=f; resc=true; } } \
    SBAR(); \
    GAPB(o[0]=__builtin_amdgcn_mfma_f32_32x32x16_bf16(PAF(0),VFR(0),o[0],0,0,0), C0,0); \
    GAPB(o[1]=__builtin_amdgcn_mfma_f32_32x32x16_bf16(PAF(0),VFR(4),o[1],0,0,0), C0,4); \
    KRD(GL,0); GAPB(o[0]=__builtin_amdgcn_mfma_f32_32x32x16_bf16(PAF(1),VFR(1),o[0],0,0,0), C0,8); \
    KRD(GL,1); GAPB(o[1]=__builtin_amdgcn_mfma_f32_32x32x16_bf16(PAF(1),VFR(5),o[1],0,0,0), C0,12); \
    KRD(GL,2); GAPB(o[0]=__builtin_amdgcn_mfma_f32_32x32x16_bf16(PAF(2),VFR(2),o[0],0,0,0), C1,0); \
    KRD(GL,3); GAPB(o[1]=__builtin_amdgcn_mfma_f32_32x32x16_bf16(PAF(2),VFR(6),o[1],0,0,0), C1,4); \
    GAPB(o[0]=__builtin_amdgcn_mfma_f32_32x32x16_bf16(PAF(3),VFR(3),o[0],0,0,0), C1,8); \
    GAPB(o[1]=__builtin_amdgcn_mfma_f32_32x32x16_bf16(PAF(3),VFR(7),o[1],0,0,0), C1,12); \
    }while(0)
  int t=1;
  #undef CMASK
  #define CMASK(P0,P1,t) do{}while(0)
  for(;t+5<NT;t+=2){
    STEP(pB0,pB1,pA0,pA1,t,true,true,true);     WAIT_BAR(2); RESC(); ROT();
    STEP(pA0,pA1,pB0,pB1,t+1,true,true,true);   WAIT_BAR(2); RESC(); ROT();
  }
  #undef CMASK
  #define CMASK(P0,P1,t) do{}while(0)
  #define ENDW(tt) do{ if((tt)+3<NT){WAIT_BAR(2);} else if((tt)+2<NT){WAIT_BAR(1);} else {WAIT_BAR(0);} }while(0)
  for(;t+1<NT;t+=2){
    STEP(pB0,pB1,pA0,pA1,t,(t+3<NT),(t+1<NT),(t+1<NT));       ENDW(t);   RESC(); ROT();
    STEP(pA0,pA1,pB0,pB1,t+1,(t+4<NT),(t+2<NT),(t+2<NT));     ENDW(t+1); RESC(); ROT();
  }
  STEP(pB0,pB1,pA0,pA1,NT-1,false,false,false); RESC();
  { float sacc=pB0[0]+pB0[1]; _Pragma("unroll") for(int r=2;r<16;++r)sacc+=pB0[r]; _Pragma("unroll") for(int r=0;r<16;++r)sacc+=pB1[r]; l_reg+=sacc;
    pw0=(u32x4){PKW(pB0,0),PKW(pB0,2),PKW(pB0,4),PKW(pB0,6)};pw1=(u32x4){PKW(pB0,8),PKW(pB0,10),PKW(pB0,12),PKW(pB0,14)};pw2=(u32x4){PKW(pB1,0),PKW(pB1,2),PKW(pB1,4),PKW(pB1,6)};pw3=(u32x4){PKW(pB1,8),PKW(pB1,10),PKW(pB1,12),PKW(pB1,14)};
    SBAR(); pv(o,vb0+sl_cur,PAF(0),PAF(1),PAF(2),PAF(3)); }
  #undef PKW
  #undef PAF
  #undef VFR
  #undef PIN
  #undef MX3
  #undef GAPA
  #undef GAPB
  #undef EX
  #undef VRD
  #undef KRD
  #undef STEP
  #undef ENDW
  {auto rr=__builtin_amdgcn_permlane32_swap(__float_as_uint(l_reg),__float_as_uint(l_reg),false,false);l_reg=__uint_as_float(rr[0])+__uint_as_float(rr[1]);}
  if(hi==0)wsf[32+r32]=l_reg;asm volatile("s_waitcnt lgkmcnt(0)":::"memory");
  float rli[16];
  #pragma unroll
  for(int r=0;r<16;++r)rli[r]=__builtin_amdgcn_rcpf(wsf[32+crow(r,hi)]);
  bf16*Ow=O+(rowbase+q0+wid*QBLK)*QP+h*D;
  { bf16*stg=(bf16*)(shm+LDS_OST)+wid*2048;
    #pragma unroll
    for(int r=0;r<16;++r){const int orow=crow(r,hi);
      #pragma unroll
      for(int d0=0;d0<2;++d0)stg[orow*64+d0*32+r32]=__float2bfloat16(o[d0][r]*rli[r]);}
    asm volatile("s_waitcnt lgkmcnt(0)":::"memory");
    #pragma unroll
    for(int i=0;i<4;++i){const int row=i*8+(lane>>3),ch=lane&7; const u32x4 v=*(const u32x4*)(stg+row*64+ch*8); ATTN_STORE16(Ow+(long)row*QP+ch*8,v);} }
  asm volatile("s_waitcnt lgkmcnt(0)\n\ts_barrier":::"memory");
  #undef DMA_K
  #undef DMA_V
  #undef CMASK
  #undef START
  #undef RESC
  #undef ROT
}
constexpr int ATTN_LDS_BYTES=LDS_BYTES;
#undef SBAR
#undef WAIT_BAR
}
namespace cg = cooperative_groups;
#define GAS __attribute__((address_space(1)))
#define LAS __attribute__((address_space(3)))
#define CAS __attribute__((address_space(4)))
typedef unsigned short bf16;
typedef unsigned v4u __attribute__((ext_vector_type(4)));
typedef unsigned v2u __attribute__((ext_vector_type(2)));
typedef float f32x4 __attribute__((ext_vector_type(4)));
typedef float f2 __attribute__((ext_vector_type(2)));
typedef short bf16x8 __attribute__((ext_vector_type(8)));
constexpr int NWAVES = 8;
constexpr int D = 1024, MP = 16384, MT = 81920, TSAMP = 4096, NSEQ = 17, DEPTH = 2;
constexpr int NINP = 2816, NINSRC = 2688, DFF = 2816, PRP = 2048, KVP = 256;
constexpr int NITEM_SCAN = 6144;
constexpr float NORM_EPS = 1e-6f, QK_EPS = 1e-6f, GN_EPS = 64e-5f, DECAY_SCALE = 0.6065306597126334f;
constexpr size_t MiB = 1u << 20;
constexpr size_t WS_MOD = 0;
constexpr size_t WS_CTL = 896 * 1024;
constexpr size_t WS_BON = 1 * MiB;
constexpr size_t WS_WSM = 7 * MiB;
constexpr size_t WS_WIN = 8 * MiB, WS_WOUT = 19 * MiB, WS_WFFI = 23 * MiB, WS_WFFO = 45 * MiB;
constexpr size_t WS_XN = 56 * MiB;
constexpr size_t WS_MIX = 216 * MiB;
constexpr size_t WS_PROJ = 376 * MiB;
constexpr size_t WS_KV = 696 * MiB;
constexpr size_t WS_P = 736 * MiB, WS_QS = 832 * MiB;
constexpr size_t WS_SLAB = 928 * MiB;
constexpr size_t WS_ACT = 376 * MiB;
constexpr size_t WS_END = 976 * MiB;
constexpr int LDS_BYTES = 163840;

__device__ __forceinline__ int bid_() { int v = (int)blockIdx.x; asm volatile("" : "+s"(v)); return v; }
typedef __bf16 bf16x2_hw __attribute__((ext_vector_type(2)));
__device__ __forceinline__ unsigned pk2(float lo, float hi) { const f2 v = {lo, hi}; return __builtin_bit_cast(unsigned, __builtin_convertvector(v, bf16x2_hw)); }
__device__ __forceinline__ unsigned f2bf(float f) { return pk2(f, f) & 0xffffu; }
__device__ __forceinline__ float bflo(unsigned u) { return __builtin_bit_cast(float, u << 16); }
__device__ __forceinline__ float bfhi(unsigned u) { return __builtin_bit_cast(float, u & 0xffff0000u); }
__device__ __forceinline__ f32x4 ld4bf(const bf16* p) { const v2u u = *(const v2u*)p; return (f32x4){bflo(u.x), bfhi(u.x), bflo(u.y), bfhi(u.y)}; }
__device__ __forceinline__ float sigmoidf_(float x) { return __builtin_amdgcn_rcpf(1.0f + __builtin_amdgcn_exp2f(-1.4426950408889634f * x)); }
__device__ __forceinline__ float tanhf_(float x) { return 1.0f - 2.0f * __builtin_amdgcn_rcpf(1.0f + __builtin_amdgcn_exp2f(2.8853900817779268f * x)); }
__device__ __forceinline__ float shx(float v, int o, int lane) { return __builtin_bit_cast(float, __builtin_amdgcn_ds_bpermute((lane ^ o) << 2, __builtin_bit_cast(int, v))); }
__device__ __forceinline__ float wave_sum(float v, int lane) {
#pragma unroll
    for (int o = 1; o < 64; o <<= 1) v += shx(v, o, lane);
    return v;
}
#define LDS_WAIT() asm volatile("s_waitcnt lgkmcnt(0)" ::: "memory")

struct Args { const float* in[25]; float* out; unsigned char* ws; };

__device__ __forceinline__ void p0_transpose_item(const float* W, int K, int N, bf16* WT, int k0, int src_n0, int dst_n0, bool zero, LAS float* scr, int lane) {
    if (!zero) {
#pragma unroll 8
        for (int i = 0; i < 32; ++i) { const int kk = 2 * i + (lane >> 5); scr[kk * 33 + (lane & 31)] = W[(size_t)(k0 + kk) * N + src_n0 + (lane & 31)]; }
    } else {
#pragma unroll 8
        for (int i = 0; i < 32; ++i) { const int kk = 2 * i + (lane >> 5); scr[kk * 33 + (lane & 31)] = 0.f; }
    }
    LDS_WAIT(); asm volatile("" ::: "memory");
    const int c = lane & 7;
#pragma unroll
    for (int j = 0; j < 4; ++j) { const int n = (lane >> 3) + 8 * j; const LAS float* s = scr + (8 * c) * 33 + n;
        v4u o; o.x = pk2(s[0 * 33], s[1 * 33]); o.y = pk2(s[2 * 33], s[3 * 33]); o.z = pk2(s[4 * 33], s[5 * 33]); o.w = pk2(s[6 * 33], s[7 * 33]);
        *(v4u*)(WT + (size_t)(dst_n0 + n) * K + k0 + 8 * c) = o; }
    LDS_WAIT(); asm volatile("" ::: "memory");
}
__device__ __forceinline__ void p0_prologue(const CAS Args* A, LAS unsigned char* lds, int wave, int lane, int G) {
    LAS float* scr = (LAS float*)(lds + wave * 16384);
    const int gw = bid_() * NWAVES + wave, NGW = G * NWAVES;
    constexpr int I_IN = 16 * 88, I_OUT = 16 * 32, I_FFI = 16 * 176, I_FFO = 44 * 32, I_LORA = 16 * 2, I_GATE = 2 * 16;
    constexpr int PER_L = I_IN + I_OUT + I_FFI + I_FFO + 2 * I_LORA + I_GATE;
    unsigned char* ws = A->ws;
    for (int it = gw; it < 2 * PER_L; it += NGW) {
        const int l = it / PER_L; int r = it % PER_L;
        if (r < I_IN) { const int kb = r / 88, nb = r % 88; const bool z = nb * 32 >= NINSRC;
            p0_transpose_item(A->in[8] + (size_t)l * D * NINSRC, D, NINSRC, (bf16*)(ws + WS_WIN) + (size_t)l * NINP * D, kb * 64, nb * 32, nb * 32, z, scr, lane); continue; } r -= I_IN;
        if (r < I_OUT) { const int kb = r / 32, nb = r % 32;
            p0_transpose_item(A->in[22] + (size_t)l * D * D, D, D, (bf16*)(ws + WS_WOUT) + (size_t)l * D * D, kb * 64, nb * 32, nb * 32, false, scr, lane); continue; } r -= I_OUT;
        if (r < I_FFI) { const int kb = r / 176, nb = r % 176; const int dn = nb * 32, pn = dn >> 8, rr = dn & 255; const int sn = rr < 128 ? pn * 128 + rr : DFF + pn * 128 + (rr - 128);
            p0_transpose_item(A->in[23] + (size_t)l * D * 2 * DFF, D, 2 * DFF, (bf16*)(ws + WS_WFFI) + (size_t)l * 2 * DFF * D, kb * 64, sn, dn, false, scr, lane); continue; } r -= I_FFI;
        if (r < I_FFO) { const int kb = r / 32, nb = r % 32;
            p0_transpose_item(A->in[24] + (size_t)l * DFF * D, DFF, D, (bf16*)(ws + WS_WFFO) + (size_t)l * D * DFF, kb * 64, nb * 32, nb * 32, false, scr, lane); continue; } r -= I_FFO;
        if (r < I_LORA) { const int d = r / 16, nb = r % 16;
            p0_transpose_item(A->in[11] + (size_t)(l * 2 + d) * 64 * 512, 64, 512, (bf16*)(ws + WS_WSM) + (size_t)(l * 2 + d) * 512 * 64, 0, nb * 32, nb * 32, false, scr, lane); continue; } r -= I_LORA;
        if (r < I_LORA) { const int d = r / 16, nb = r % 16;
            p0_transpose_item(A->in[13] + (size_t)(l * 2 + d) * 64 * 512, 64, 512, (bf16*)(ws + WS_WSM) + 131072 + (size_t)(l * 2 + d) * 512 * 64, 0, nb * 32, nb * 32, false, scr, lane); continue; } r -= I_LORA;
        { const int kb = r / 16, nb = r % 16;
            p0_transpose_item(A->in[14] + (size_t)l * 128 * 512, 128, 512, (bf16*)(ws + WS_WSM) + 262144 + (size_t)l * 512 * 128, kb * 64, nb * 32, nb * 32, false, scr, lane); }
    }
}
__device__ __forceinline__ void p0_mod(const CAS Args* A, LAS unsigned char* lds, int tid) {
    const int item = bid_(); if (item >= 192) return;
    LAS float* cs = (LAS float*)lds;
    LAS float* red = (LAS float*)(lds + 81920);
    for (int e = tid; e < NSEQ * 1024; e += 512) { const int s = e >> 10, k = e & 1023; const float c = s == 0 ? A->in[2][k] : A->in[3][(s - 1) * 1024 + k];
        cs[k * 20 + s] = c * sigmoidf_(c); }
    __syncthreads();
    const int l = item / 96, col0 = (item % 96) * 64, kq = tid >> 6, col = tid & 63;
    const float* w = A->in[4] + (size_t)l * 1024 * 6144 + col0 + col;
    float acc[NSEQ];
#pragma unroll
    for (int s = 0; s < NSEQ; ++s) acc[s] = 0.f;
#pragma unroll 4
    for (int k = kq * 128; k < kq * 128 + 128; ++k) { const float wv = w[(size_t)k * 6144];
        const LAS f32x4* c4 = (const LAS f32x4*)(cs + k * 20);
        const f32x4 c0 = c4[0], c1 = c4[1], c2 = c4[2], c3 = c4[3]; const float c16 = cs[k * 20 + 16];
#pragma unroll
        for (int i = 0; i < 4; ++i) { acc[i] += wv * c0[i]; acc[4 + i] += wv * c1[i]; acc[8 + i] += wv * c2[i]; acc[12 + i] += wv * c3[i]; }
        acc[16] += wv * c16; }
#pragma unroll
    for (int s = 0; s < NSEQ; ++s) red[(kq * NSEQ + s) * 64 + col] = acc[s];
    __syncthreads();
    float* mod = (float*)(A->ws + WS_MOD);
    for (int e = tid; e < NSEQ * 64; e += 512) { const int s = e >> 6, c = e & 63; float v = A->in[5][l * 6144 + col0 + c];
#pragma unroll
        for (int q = 0; q < 8; ++q) v += red[(q * NSEQ + s) * 64 + c];
        mod[(size_t)(s * 2 + l) * 6144 + col0 + c] = v; }
    __syncthreads();
}
__device__ __forceinline__ int seq_of(int m) { return m < MP ? 0 : 1 + ((m - MP) >> 12); }
__device__ __forceinline__ void norm_phase(const float* xp, const float* xs, const float* g, const float* modl  , bf16* XN, int wave, int lane, int G) {
    const int gw = bid_() * NWAVES + wave, NGW = G * NWAVES;
    f32x4 gv[4];
#pragma unroll
    for (int j = 0; j < 4; ++j) gv[j] = ((const f32x4*)g)[64 * j + lane];
    for (int m = gw; m < MT; m += NGW) {
        const float* xrow = m < MP ? xp + (size_t)m * D : xs + (size_t)(m - MP) * D;
        const f32x4* xr = (const f32x4*)xrow + lane;
        f32x4 v[4]; float s = 0.f;
#pragma unroll
        for (int j = 0; j < 4; ++j) { v[j] = xr[64 * j]; s += (v[j].x * v[j].x + v[j].y * v[j].y) + (v[j].z * v[j].z + v[j].w * v[j].w); }
        const float rstd = __builtin_amdgcn_rsqf(wave_sum(s, lane) * (1.f / D) + NORM_EPS);
        const float* mp = modl + (size_t)seq_of(m) * 12288;
        unsigned long long* o8 = (unsigned long long*)(XN + (size_t)m * D) + lane;
#pragma unroll
        for (int j = 0; j < 4; ++j) { const f32x4 sh = ((const f32x4*)mp)[64 * j + lane], sc = ((const f32x4*)(mp + 1024))[64 * j + lane];
            const f32x4 y = v[j] * rstd * gv[j] * (1.0f + sc) + sh;
            o8[64 * j] = (unsigned long long)pk2(y.x, y.y) | ((unsigned long long)pk2(y.z, y.w) << 32); }
    }
}
__device__ __forceinline__ void qk_prep_phase(bf16* mix, bf16* kv, const float* qg, const float* kg, int wave, int lane, int G) {
    const int gw = bid_() * NWAVES + wave, NGW = G * NWAVES;
    const int hsel = lane >> 5, li = lane & 31, half = li >> 4, i = li & 15, d1 = half * 32 + i, d2 = d1 + 16;
    const float freq = __builtin_amdgcn_exp2f(-(float)i * (13.287712379549449f / 16.0f));
    const float q1 = qg[d1], q2 = qg[d2], k1 = kg[d1], k2 = kg[d2];
    for (int m = gw; m < MT; m += NGW) {
        const int t = m < MP ? m : (m - MP) & (TSAMP - 1);
        const float pos = (float)(half ? (t & 63) : (t >> 6));
        const float rev = pos * freq * 0.15915494309189535f; const float sn = __builtin_amdgcn_sinf(rev), cn = __builtin_amdgcn_cosf(rev);
        bf16* pp[5]; float x1[5], x2[5];
#pragma unroll
        for (int it = 0; it < 5; ++it) { const int hh = it * 2 + hsel;
            pp[it] = hh < 8 ? mix + (size_t)m * 1024 + 512 + hh * 64 : kv + (size_t)m * KVP + (hh - 8) * 64;
            x1[it] = bflo(pp[it][d1]); x2[it] = bflo(pp[it][d2]); }
        asm volatile("" ::: "memory");
        unsigned short r1[5], r2[5];
#pragma unroll
        for (int it = 0; it < 5; ++it) { const int hh = it * 2 + hsel;
            float ss = x1[it] * x1[it] + x2[it] * x2[it];
#pragma unroll
            for (int o = 1; o < 32; o <<= 1) ss += shx(ss, o, lane);
            const float rstd = __builtin_amdgcn_rsqf(ss * (1.f / 64.f) + QK_EPS);
            const float y1 = x1[it] * rstd * (hh < 8 ? q1 : k1), y2 = x2[it] * rstd * (hh < 8 ? q2 : k2);
            float o1 = y1 * cn - y2 * sn, o2 = y2 * cn + y1 * sn;
            if (hh < 8) { o1 *= attn_body::C2; o2 *= attn_body::C2; }
            r1[it] = (unsigned short)f2bf(o1); r2[it] = (unsigned short)f2bf(o2); }
#pragma unroll
        for (int it = 0; it < 5; ++it) { pp[it][d1] = r1[it]; pp[it][d2] = r2[it]; }
    }
}
struct ScanP { const bf16* proj; const float* conv_w; const float* w0; const float* a0; const float* k_k; const float* k_a; const float* r_k; const bf16* upw; const bf16* upa; };
__device__ __forceinline__ f32x4 conv4(const bf16* proj, const float* cw, int m, int col, bool hp, bool hn) {
    const bf16* p = proj + (size_t)m * PRP + col;
    const f32x4 c0 = *(const f32x4*)(cw + col), c1 = *(const f32x4*)(cw + 1536 + col), c2 = *(const f32x4*)(cw + 3072 + col);
    f32x4 r = c1 * ld4bf(p);
    if (hp) r += c0 * ld4bf(p - PRP);
    if (hn) r += c2 * ld4bf(p + PRP);
    return r;
}
template <int MODE>
__device__ __forceinline__ void scan_prologue(const ScanP& P, int m0, int seqbase, int T, int h, int d, float* slab, LAS float* lw, float* bon, int lane) {
    const int fr = lane & 15, fq = lane >> 4, m = m0 + fr, pos = m - seqbase; const bool hp = pos > 0, hn = pos < T - 1;
    float* srow = slab + fr * 384;
    f32x4 k4[4], kk4[4], r4[4]; float ss = 0.f;
    v2u pk_[4][3], pv_[4][3], pr_[4][3];
    const int offp_ = hp ? -PRP : 0, offn_ = hn ? PRP : 0; const unsigned mp_ = hp ? 0xffffffffu : 0u, mn_ = hn ? 0xffffffffu : 0u;
#pragma unroll
    for (int n = 0; n < 4; ++n) { const bf16* p = P.proj + (size_t)m * PRP + h * 64 + 16 * n + 4 * fq;
        { v2u t; pk_[n][1] = *(const v2u*)(p + 512);
          t = *(const v2u*)(p + 512 + offp_); pk_[n][0] = (v2u){t.x & mp_, t.y & mp_};
          t = *(const v2u*)(p + 512 + offn_); pk_[n][2] = (v2u){t.x & mn_, t.y & mn_};
          if (MODE != 1) { pv_[n][1] = *(const v2u*)(p + 1024);
            t = *(const v2u*)(p + 1024 + offp_); pv_[n][0] = (v2u){t.x & mp_, t.y & mp_};
            t = *(const v2u*)(p + 1024 + offn_); pv_[n][2] = (v2u){t.x & mn_, t.y & mn_}; }
          if (MODE == 2) { pr_[n][1] = *(const v2u*)(p);
            t = *(const v2u*)(p + offp_); pr_[n][0] = (v2u){t.x & mp_, t.y & mp_};
            t = *(const v2u*)(p + offn_); pr_[n][2] = (v2u){t.x & mn_, t.y & mn_}; } } }
    v4u xw_[2]; bf16x8 xa_[2];
#pragma unroll
    for (int ks = 0; ks < 2; ++ks) { xw_[ks] = *(const v4u*)(P.proj + (size_t)m * PRP + 1536 + d * 64 + ks * 32 + 8 * fq); xa_[ks] = *(const bf16x8*)(P.proj + (size_t)m * PRP + 1664 + d * 64 + ks * 32 + 8 * fq); }
    asm volatile("" ::: "memory");
#define CONV3_(arr, which) ({ const float* cw_ = P.conv_w + (which) * 512 + col; const f32x4 c0 = *(const f32x4*)cw_, c1 = *(const f32x4*)(cw_ + 1536), c2 = *(const f32x4*)(cw_ + 3072); \
        const v2u u0 = arr[n][0], u1 = arr[n][1], u2 = arr[n][2]; \
        c0 * (f32x4){bflo(u0.x), bfhi(u0.x), bflo(u0.y), bfhi(u0.y)} + c1 * (f32x4){bflo(u1.x), bfhi(u1.x), bflo(u1.y), bfhi(u1.y)} + c2 * (f32x4){bflo(u2.x), bfhi(u2.x), bflo(u2.y), bfhi(u2.y)}; })
#pragma unroll
    for (int n = 0; n < 4; ++n) { const int c = 16 * n + 4 * fq, col = h * 64 + c;
        k4[n] = CONV3_(pk_, 1);
        if (MODE != 1) { const f32x4 v4 = CONV3_(pv_, 2); *(f32x4*)(srow + 320 + c) = v4; LAS float* xsel = (fr == (d ? 15 : 0)) ? lw + 2048 + c : lw + 2304 + lane * 4; *(LAS f32x4*)(xsel + 192) = v4; }
        if (MODE == 2) { r4[n] = CONV3_(pr_, 0); *(LAS f32x4*)(lw + 1024 + fr * 64 + c) = r4[n]; }
        kk4[n] = k4[n] * *(const f32x4*)(P.k_k + col);
        ss += (kk4[n].x * kk4[n].x + kk4[n].y * kk4[n].y) + (kk4[n].z * kk4[n].z + kk4[n].w * kk4[n].w); }
#undef CONV3_
    ss += shx(ss, 16, lane); ss += shx(ss, 32, lane);
    const float rs = __builtin_amdgcn_rsqf(ss + 1e-12f);
    f32x4 Dw[4], Da[4];
#pragma unroll
    for (int n = 0; n < 4; ++n) { Dw[n] = (f32x4){0.f, 0.f, 0.f, 0.f}; Da[n] = (f32x4){0.f, 0.f, 0.f, 0.f}; }
#pragma unroll
    for (int ks = 0; ks < 2; ++ks) {
        const v4u xw = xw_[ks]; const bf16x8 xa = xa_[ks];
        v4u tw;
#pragma unroll
        for (int e = 0; e < 4; ++e) tw[e] = pk2(tanhf_(bflo(xw[e])), tanhf_(bfhi(xw[e])));
        const bf16x8 twv = __builtin_bit_cast(bf16x8, tw);
#pragma unroll
        for (int n = 0; n < 4; ++n) { const size_t wo = (size_t)(h * 64 + 16 * n + fr) * 64 + ks * 32 + 8 * fq;
            Dw[n] = __builtin_amdgcn_mfma_f32_16x16x32_bf16(*(const bf16x8*)(P.upw + wo), twv, Dw[n], 0, 0, 0);
            Da[n] = __builtin_amdgcn_mfma_f32_16x16x32_bf16(*(const bf16x8*)(P.upa + wo), xa, Da[n], 0, 0, 0); }
    }
    float bp = 0.f;
#pragma unroll
    for (int n = 0; n < 4; ++n) { const int c = 16 * n + 4 * fq, col = h * 64 + c;
        const f32x4 w0 = *(const f32x4*)(P.w0 + col), a0 = *(const f32x4*)(P.a0 + col), ka = *(const f32x4*)(P.k_a + col);
        f32x4 wv, bv, kd, av;
#pragma unroll
        for (int i = 0; i < 4; ++i) { const float ic = sigmoidf_(Da[n][i] + a0[i]);
            wv[i] = __builtin_amdgcn_exp2f(-DECAY_SCALE * 1.4426950408889634f * sigmoidf_(Dw[n][i] + w0[i]));
            const float kk = kk4[n][i] * rs; av[i] = -kk; bv[i] = kk * ic; kd[i] = k4[n][i] * (1.0f + (ic - 1.0f) * ka[i]); }
        *(LAS f32x4*)(lw + fr * 64 + c) = av; *(LAS f32x4*)(lw + 3072 + fr * 64 + c) = wv; *(LAS f32x4*)(lw + (MODE == 3 ? 1024 : 4096) + fr * 64 + c) = bv;
        if (MODE != 1) *(f32x4*)(srow + 192 + c) = kd;
        { LAS float* xsel = (fr == (d ? 15 : 0)) ? lw + 2048 + c : lw + 2304 + lane * 4;
          if (MODE != 1) *(LAS f32x4*)(xsel + 128) = kd; }
        if (MODE == 2) { const f32x4 rk = *(const f32x4*)(P.r_k + col); const f32x4 t = r4[n] * kd * rk; bp += (t.x + t.y) + (t.z + t.w); }
        asm volatile("" ::: "memory");
    }
    if (MODE == 2) { bp += shx(bp, 16, lane); bp += shx(bp, 32, lane); if (fq == 0) bon[(size_t)m * 8 + h] = 0.5f * bp; }
}
template <int MODE>
__device__ __forceinline__ void scan_item(const CAS Args* A, int l, int item, float* slab0, LAS float* ldsw, int lane) {
    unsigned char* ws = A->ws;
    const bool isP = item < 2048; const int it2 = isP ? item : item - 2048;
    const int d = it2 & 1, h = (it2 >> 1) & 7, chunk = it2 >> 4, m0c = isP ? chunk * 128 : MP + chunk * 256, nsub = isP ? 8 : 16;
    const int seqbase = isP ? 0 : MP + (chunk >> 4) * TSAMP, T = isP ? MP : TSAMP;
    ScanP P; P.proj = (const bf16*)(ws + WS_PROJ); P.conv_w = A->in[9] + (size_t)l * 3 * 1536; P.w0 = A->in[10] + (size_t)(l * 2 + d) * 512; P.a0 = A->in[12] + (size_t)(l * 2 + d) * 512;
    P.k_k = A->in[15] + l * 512; P.k_a = A->in[16] + l * 512; P.r_k = A->in[17] + l * 512;
    P.upw = (const bf16*)(ws + WS_WSM) + (size_t)(l * 2 + d) * 512 * 64; P.upa = (const bf16*)(ws + WS_WSM) + 131072 + (size_t)(l * 2 + d) * 512 * 64;
    float* bon = (float*)(ws + WS_BON) + (size_t)d * MT * 8;
    bf16* yb = (bf16*)(ws + WS_XN) + (size_t)d * MT * 512;
    f2 S[32], Pm[32];
    if (MODE == 3) {
#pragma unroll
        for (int i = 0; i < 32; ++i) Pm[i] = (f2){lane == 2 * i ? 1.f : 0.f, lane == 2 * i + 1 ? 1.f : 0.f}; }
    if (MODE == 2) { const f32x4* q = (const f32x4*)((const float*)(ws + WS_QS) + ((size_t)item * 64 + lane) * 64);
#pragma unroll
        for (int i = 0; i < 16; ++i) { const f32x4 v = q[i]; S[2 * i] = (f2){v.x, v.y}; S[2 * i + 1] = (f2){v.z, v.w}; } }
    else {
#pragma unroll
        for (int i = 0; i < 32; ++i) S[i] = MODE == 1 ? (f2){lane == 2 * i ? 1.f : 0.f, lane == 2 * i + 1 ? 1.f : 0.f} : (f2){0.f, 0.f}; }
#pragma nounroll
    for (int sc = 0; sc < nsub; ++sc) {
        const int sub = d ? nsub - 1 - sc : sc, t0 = m0c + sub * 16;
        float* slab = slab0;
        { int lane_l = lane; asm volatile("" : "+v"(lane_l)); scan_prologue<MODE>(P, t0, seqbase, T, h, d, slab, ldsw, bon, lane_l);
#ifdef DUP_PRO
          asm volatile("" : "+v"(lane_l)); scan_prologue<MODE>(P, t0, seqbase, T, h, d, slab, ldsw, bon, lane_l);
#endif
        }
        asm volatile("" ::: "memory");
#define RL2(x, j) (f2){__builtin_bit_cast(float, __builtin_amdgcn_readlane(__builtin_bit_cast(int, x), 2 * (j))), __builtin_bit_cast(float, __builtin_amdgcn_readlane(__builtin_bit_cast(int, x), 2 * (j) + 1))}
        const GAS float* sl = (const GAS float*)slab + lane;
        LDS_WAIT();
        float nw[1], nb[1], nk[1], nv[1];
        { const LAS float* xl = ldsw + 2048 + lane; nw[0] = 0.f; nb[0] = 0.f; nk[0] = 0.f; nv[0] = 0.f; if (MODE != 1) { nk[0] = xl[128]; nv[0] = xl[192]; } }
#pragma nounroll
        for (int st = 0; st < 16; ++st) {
            const int s = d ? 15 - st : st;
            const float cw = nw[0], cb = nb[0], ck = nk[0], vv = nv[0];
            if (st < 15) { const GAS float* p = sl + (d ? s - 1 : s + 1) * 384;  if (MODE != 1) { nk[0] = p[192]; nv[0] = p[320]; } }
            const LAS f32x4* ua = (const LAS f32x4*)(ldsw + s * 64); const LAS f32x4* ur = (const LAS f32x4*)(ldsw + 1024 + s * 64); const LAS f32x4* uw = (const LAS f32x4*)(ldsw + 3072 + s * 64); const LAS f32x4* ub = (const LAS f32x4*)(ldsw + (MODE == 3 ? 1024 : 4096) + s * 64);
            f2 sa2 = (f2){0.f, 0.f}, sb2 = (f2){0.f, 0.f}, pa2 = (f2){0.f, 0.f}, pb2 = (f2){0.f, 0.f};
#pragma unroll
            for (int j = 0; j < 16; ++j) { const f32x4 aq = ua[j]; const f2 a0 = (f2){aq.x, aq.y}, a1 = (f2){aq.z, aq.w}; sa2 = S[2 * j] * a0 + sa2; sb2 = S[2 * j + 1] * a1 + sb2;
                if (MODE == 3) { pa2 = Pm[2 * j] * a0 + pa2; pb2 = Pm[2 * j + 1] * a1 + pb2; } }
            const float sa = (sa2.x + sa2.y) + (sb2.x + sb2.y), pa = (pa2.x + pa2.y) + (pb2.x + pb2.y); const f2 pas = (f2){pa, pa};
            const f2 sas = (f2){sa, sa}, vvs = (f2){vv, vv};
            f2 y2 = (f2){0.f, 0.f}, y3 = (f2){0.f, 0.f};
            f32x4 nwq[2], nbq[2], nrq[2];
            nwq[0] = uw[0]; nwq[1] = uw[1]; nbq[0] = ub[0]; nbq[1] = ub[1]; nrq[0] = (f32x4){0.f, 0.f, 0.f, 0.f}; nrq[1] = nrq[0];
            if (MODE == 2) { nrq[0] = ur[0]; nrq[1] = ur[1]; }
#pragma unroll
            for (int g = 0; g < 8; ++g) {
                const f32x4 cwq0 = nwq[0], cwq1 = nwq[1], cbq0 = nbq[0], cbq1 = nbq[1], crq0 = nrq[0], crq1 = nrq[1];
                if (g < 7) { nwq[0] = uw[2 * g + 2]; nwq[1] = uw[2 * g + 3]; nbq[0] = ub[2 * g + 2]; nbq[1] = ub[2 * g + 3];
                    if (MODE == 2) { nrq[0] = ur[2 * g + 2]; nrq[1] = ur[2 * g + 3]; } }
                f2 bb[4], ww[4], kq[4], rr[4];
                ww[0] = (f2){cwq0.x, cwq0.y}; ww[1] = (f2){cwq0.z, cwq0.w}; ww[2] = (f2){cwq1.x, cwq1.y}; ww[3] = (f2){cwq1.z, cwq1.w};
                bb[0] = (f2){cbq0.x, cbq0.y}; bb[1] = (f2){cbq0.z, cbq0.w}; bb[2] = (f2){cbq1.x, cbq1.y}; bb[3] = (f2){cbq1.z, cbq1.w};
                rr[0] = (f2){crq0.x, crq0.y}; rr[1] = (f2){crq0.z, crq0.w}; rr[2] = (f2){crq1.x, crq1.y}; rr[3] = (f2){crq1.z, crq1.w};
#pragma unroll
                for (int q = 0; q < 4; ++q) { const int j = g * 4 + q; if (MODE != 1) kq[q] = RL2(ck, j); }
                __builtin_amdgcn_sched_barrier(0);
#pragma unroll
                for (int q = 0; q < 4; ++q) { const int j = g * 4 + q;
                    f2 t = sas * bb[q];
                    if (MODE != 1) t = vvs * kq[q] + t;
                    S[j] = S[j] * ww[q] + t;
                    if (MODE == 3) Pm[j] = Pm[j] * ww[q] + pas * bb[q];
                    if (MODE == 2) { if (j & 1) y3 = S[j] * rr[q] + y3; else y2 = S[j] * rr[q] + y2; } }
            }
            if (MODE == 2) yb[(size_t)(t0 + s) * 512 + h * 64 + lane] = (bf16)f2bf((y2.x + y2.y) + (y3.x + y3.y));
        }
#undef RL2
    }
    if (MODE != 2) { f32x4* q = (f32x4*)((float*)(ws + (MODE == 1 ? WS_P : WS_QS)) + ((size_t)item * 64 + lane) * 64);
#pragma unroll
        for (int i = 0; i < 16; ++i) q[i] = (f32x4){S[2 * i].x, S[2 * i].y, S[2 * i + 1].x, S[2 * i + 1].y}; }
    if (MODE == 3) { f32x4* q = (f32x4*)((float*)(ws + WS_P) + ((size_t)item * 64 + lane) * 64);
#pragma unroll
        for (int i = 0; i < 16; ++i) q[i] = (f32x4){Pm[2 * i].x, Pm[2 * i].y, Pm[2 * i + 1].x, Pm[2 * i + 1].y}; }
}
template <bool PASS_C>
__device__ __forceinline__ void scan_phase(const CAS Args* A, LAS unsigned char* lds, int l, int wave, int lane, int G) {
    const int gw = bid_() * NWAVES + wave, NGW = G * NWAVES;
    float* slab0 = (float*)(A->ws + WS_SLAB) + (size_t)gw * 6144;
    LAS float* ldsw = (LAS float*)(lds + wave * 20480);
    if (PASS_C) { for (int item = gw; item < NITEM_SCAN; item += NGW) scan_item<2>(A, l, item, slab0, ldsw, lane); }
    else { for (int item = gw; item < NITEM_SCAN; item += NGW) { int ll = lane; asm volatile("" : "+v"(ll)); scan_item<3>(A, l, item, slab0, ldsw, ll); } }
}
#ifdef EXP_SLOAD
typedef const CAS f2* cf2p_;
__device__ __forceinline__ void probe_sload(const CAS Args* A, int wave, int lane, int G) {
    const int gw = bid_() * NWAVES + wave;
    float* pslab = (float*)(A->ws + WS_SLAB) + (size_t)gw * 12288;
    f2 acc = (f2){0.f, 0.f}, acc2 = (f2){0.f, 0.f};
#pragma nounroll
    for (int rep = 0; rep < EXP_SLOAD; ++rep) {
        float* ps = pslab + (rep & 1) * 6144;
#pragma unroll 4
        for (int i = 0; i < 96; ++i) ps[i * 64 + lane] = (float)(i + rep) * 0.001f;
        unsigned long long sp = (unsigned long long)(uintptr_t)ps;
        sp = __builtin_amdgcn_readfirstlane((unsigned)sp) | ((unsigned long long)__builtin_amdgcn_readfirstlane((unsigned)(sp >> 32)) << 32);
        asm volatile("s_waitcnt vmcnt(0) lgkmcnt(0)" : "+s"(sp) : : "memory");
        cf2p_ u = (cf2p_)sp;
#pragma nounroll
        for (int i = 0; i < 3072; i += 32) {
#pragma unroll
            for (int j = 0; j < 32; j += 2) { acc = acc * u[i + j] + acc; acc2 = acc2 * u[i + j + 1] + acc2; }
        }
    }
    if (acc.x + acc2.y == 12345.678f) pslab[lane] = acc.y + acc2.x;
}
#endif
__device__ __forceinline__ void scanB_phase(const CAS Args* A, LAS unsigned char* lds, int wave, int lane, int G) {
    unsigned char* ws = A->ws;
    LAS float* ex = (LAS float*)lds;
    LAS float* pl = (LAS float*)(lds + 32768);
    const int tid = wave * 64 + lane;
    for (int chain = bid_(); chain < NSEQ * 16; chain += G) {
        const int d = chain & 1, h = (chain >> 1) & 7, seq = chain >> 4;
        const int nc = seq == 0 ? 128 : 16, ibase = seq == 0 ? 0 : 2048 + (seq - 1) * 256;
        f2 S[32]; f2 cur[4];
#pragma unroll
        for (int i = 0; i < 32; ++i) S[i] = (f2){0.f, 0.f};
#pragma unroll
        for (int i = 0; i < 4; ++i) cur[i] = (f2){0.f, 0.f};
        { const int c0 = d ? nc - 1 : 0; const size_t it0 = (size_t)ibase + (size_t)(c0 * 8 + h) * 2 + d;
          const f32x4* ps = (const f32x4*)((const float*)(ws + WS_P) + it0 * 4096); ((LAS f32x4*)pl)[tid] = ps[tid]; ((LAS f32x4*)pl)[tid + 512] = ps[tid + 512]; }
        __syncthreads();
        for (int ci = 0; ci < nc; ++ci) {
            const int c = d ? nc - 1 - ci : ci; const size_t item = (size_t)ibase + (size_t)(c * 8 + h) * 2 + d;
            LAS float* pc = pl + (ci & 1) * 4096; LAS float* pn = pl + ((ci + 1) & 1) * 4096;
            f32x4 pf0 = (f32x4){0.f, 0.f, 0.f, 0.f}, pf1 = pf0;
            if (ci + 1 < nc) { const int cn = d ? nc - 2 - ci : ci + 1; const size_t itn = (size_t)ibase + (size_t)(cn * 8 + h) * 2 + d;
                const f32x4* ps = (const f32x4*)((const float*)(ws + WS_P) + itn * 4096); pf0 = ps[tid]; pf1 = ps[tid + 512]; }
            float* qrow = (float*)(ws + WS_QS) + (item * 64 + lane) * 64 + wave * 8;
            const f32x4 q0 = *(const f32x4*)qrow, q1 = *(const f32x4*)(qrow + 4);
            *(f32x4*)qrow = (f32x4){cur[0].x, cur[0].y, cur[1].x, cur[1].y}; *(f32x4*)(qrow + 4) = (f32x4){cur[2].x, cur[2].y, cur[3].x, cur[3].y};
            f2 n0 = (f2){0.f, 0.f}, n1 = n0, n2 = n0, n3 = n0;
#pragma unroll
            for (int kp = 0; kp < 32; ++kp) {
                const f2 sx = (f2){S[kp].x, S[kp].x}, sy = (f2){S[kp].y, S[kp].y};
                const LAS f32x4* r0 = (const LAS f32x4*)(pc + (2 * kp) * 64 + wave * 8); const LAS f32x4* r1 = (const LAS f32x4*)(pc + (2 * kp + 1) * 64 + wave * 8);
                const f32x4 a0 = r0[0], a1 = r0[1], b0 = r1[0], b1 = r1[1];
                n0 = sx * (f2){a0.x, a0.y} + n0; n1 = sx * (f2){a0.z, a0.w} + n1; n2 = sx * (f2){a1.x, a1.y} + n2; n3 = sx * (f2){a1.z, a1.w} + n3;
                n0 = sy * (f2){b0.x, b0.y} + n0; n1 = sy * (f2){b0.z, b0.w} + n1; n2 = sy * (f2){b1.x, b1.y} + n2; n3 = sy * (f2){b1.z, b1.w} + n3; }
            n0 += (f2){q0.x, q0.y}; n1 += (f2){q0.z, q0.w}; n2 += (f2){q1.x, q1.y}; n3 += (f2){q1.z, q1.w};
            cur[0] = n0; cur[1] = n1; cur[2] = n2; cur[3] = n3;
            LAS float* er = ex + lane * 68 + wave * 8;
            *(LAS f32x4*)er = (f32x4){n0.x, n0.y, n1.x, n1.y}; *(LAS f32x4*)(er + 4) = (f32x4){n2.x, n2.y, n3.x, n3.y};
            ((LAS f32x4*)pn)[tid] = pf0; ((LAS f32x4*)pn)[tid + 512] = pf1;
            __syncthreads();
#pragma unroll
            for (int i = 0; i < 16; ++i) { const f32x4 v = *(const LAS f32x4*)(ex + lane * 68 + 4 * i); S[2 * i] = (f2){v.x, v.y}; S[2 * i + 1] = (f2){v.z, v.w}; }
            __syncthreads();
        }
    }
}
__device__ __forceinline__ void post_phase(const CAS Args* A, int l, int wave, int lane, int G) {
    unsigned char* ws = A->ws;
    const int gw = bid_() * NWAVES + wave, NGW = G * NWAVES;
    const bf16* proj = (const bf16*)(ws + WS_PROJ); const float* cw = A->in[9] + (size_t)l * 3 * 1536;
    const bf16* y0 = (const bf16*)(ws + WS_XN); const bf16* y1 = y0 + (size_t)MT * 512;
    const float* b0 = (const float*)(ws + WS_BON); const float* b1 = b0 + (size_t)MT * 8;
    const bf16* gt = (const bf16*)(ws + WS_WSM) + 262144 + (size_t)l * 512 * 128;
    const float* lng = A->in[18] + l * 512; const float* lnb = A->in[19] + l * 512;
    bf16* mix = (bf16*)(ws + WS_MIX);
    const int h = gw & 7;
    bf16x8 gfrag[4][4];
    { const int fr0 = lane & 15, fq0 = lane >> 4;
#pragma unroll
      for (int ks = 0; ks < 4; ++ks)
#pragma unroll
        for (int n = 0; n < 4; ++n) gfrag[n][ks] = *(const bf16x8*)(gt + (size_t)(h * 64 + 16 * n + fr0) * 128 + ks * 32 + 8 * fq0);
    }
    f32x4 cwv[4][3], lg4[4], lb4[4];
    { const int fq0 = lane >> 4;
#pragma unroll
      for (int n = 0; n < 4; ++n) { const int col = h * 64 + 16 * n + 4 * fq0;
          cwv[n][0] = *(const f32x4*)(cw + 1024 + col); cwv[n][1] = *(const f32x4*)(cw + 1536 + 1024 + col); cwv[n][2] = *(const f32x4*)(cw + 3072 + 1024 + col);
          lg4[n] = *(const f32x4*)(lng + col); lb4[n] = *(const f32x4*)(lnb + col); } }
    for (int item = gw; item < (MT / 16) * 8; item += NGW) {
        int lane_l = lane; asm volatile("" : "+v"(lane_l)); const int fr = lane_l & 15, fq = lane_l >> 4;
        const int m = (item >> 3) * 16 + fr;
        const int seqbase = m < MP ? 0 : MP + ((m - MP) >> 12) * TSAMP, T = m < MP ? MP : TSAMP, pos = m - seqbase; const bool hp = pos > 0, hn = pos < T - 1;
        f32x4 y4[4]; float s = 0.f;
#pragma unroll
        for (int n = 0; n < 4; ++n) { const size_t o = (size_t)m * 512 + h * 64 + 16 * n + 4 * fq; y4[n] = ld4bf(y0 + o) + ld4bf(y1 + o); s += (y4[n].x + y4[n].y) + (y4[n].z + y4[n].w); }
        s += shx(s, 16, lane); s += shx(s, 32, lane);
        const float mu = s * (1.f / 64.f); float q = 0.f;
#pragma unroll
        for (int n = 0; n < 4; ++n) { y4[n] = y4[n] - mu; q += (y4[n].x * y4[n].x + y4[n].y * y4[n].y) + (y4[n].z * y4[n].z + y4[n].w * y4[n].w); }
        q += shx(q, 16, lane); q += shx(q, 32, lane);
        const float rstd = __builtin_amdgcn_rsqf(q * (1.f / 64.f) + GN_EPS);
        const float bon = b0[(size_t)m * 8 + h] + b1[(size_t)m * 8 + h];
        f32x4 Dg[4];
#pragma unroll
        for (int n = 0; n < 4; ++n) Dg[n] = (f32x4){0.f, 0.f, 0.f, 0.f};
#pragma unroll
        for (int ks = 0; ks < 4; ++ks) {
            const v4u xg = *(const v4u*)(proj + (size_t)m * PRP + 1792 + ks * 32 + 8 * fq); v4u sg;
#pragma unroll
            for (int e = 0; e < 4; ++e) sg[e] = pk2(sigmoidf_(bflo(xg[e])), sigmoidf_(bfhi(xg[e])));
            const bf16x8 sgv = __builtin_bit_cast(bf16x8, sg);
#pragma unroll
            for (int n = 0; n < 4; ++n) Dg[n] = __builtin_amdgcn_mfma_f32_16x16x32_bf16(gfrag[n][ks], sgv, Dg[n], 0, 0, 0);
        }
#pragma unroll
        for (int n = 0; n < 4; ++n) { const int col = h * 64 + 16 * n + 4 * fq;
            const bf16* pv = proj + (size_t)m * PRP + 1024 + col;
            f32x4 v4 = cwv[n][1] * ld4bf(pv);
            v4 += (cwv[n][0] * (hp ? 1.f : 0.f)) * ld4bf(pv - (hp ? PRP : 0));
            v4 += (cwv[n][2] * (hn ? 1.f : 0.f)) * ld4bf(pv + (hn ? PRP : 0));
            const f32x4 o = ((y4[n] * rstd) * lg4[n] + lb4[n] + bon * v4) * Dg[n];
            v2u w; w.x = pk2(o.x, o.y); w.y = pk2(o.z, o.w);
            *(v2u*)(mix + (size_t)m * 1024 + col) = w; }
    }
}
__device__ __forceinline__ void attn_phase(const CAS Args* A, char* lds, int G, int tid) {
    using attn_body::bf16;
    bf16* Q = (bf16*)(A->ws + WS_MIX) + 512; const bf16* K = (const bf16*)(A->ws + WS_KV); const bf16* V = K + 128;
#ifdef DUP_ATTNP
    for (int u = blockIdx.x; u < 512; u += G) { const int h = u & 7, qb = u >> 3;
        attn_body::attn_unit<8>(0, MP, h, qb, Q, K, V, (bf16*)(A->ws + 976 * MiB), lds, tid); }
#endif
    for (int u = blockIdx.x; u < 512; u += G) { const int h = u & 7, qb = u >> 3;
        attn_body::attn_unit<8>(0, MP, h, qb, Q, K, V, Q, lds, tid); }
    for (int u = blockIdx.x; u < 2048; u += G) { const int h = u & 7, qb = (u >> 3) & 15, sq = u >> 7;
        attn_body::attn_unit<8>((long)MP + (long)sq * TSAMP, TSAMP, h, qb, Q, K, V, Q, lds, tid); }
}

#define XB_TMO      128
#define XB_XCNT(j)  (256  + 64 * (j))
#define XB_XSUB(j)  (1280 + 64 * (j))
#define XB_XGEN(j)  (2304 + 64 * (j))
#define XB_TOP      3328
#define XB_TOPGEN   3392
#define XCD_BAR_WORDS 3456
#define XB_SPIN_CAP (1u << 18)

__device__ __forceinline__ unsigned xb_ld(unsigned* p)              { return __hip_atomic_load(p, __ATOMIC_RELAXED, __HIP_MEMORY_SCOPE_AGENT); }
__device__ __forceinline__ unsigned xb_add(unsigned* p, unsigned v) { return __hip_atomic_fetch_add(p, v, __ATOMIC_RELAXED, __HIP_MEMORY_SCOPE_AGENT); }
__device__ __forceinline__ unsigned xb_xcc_id() { return (unsigned)__builtin_amdgcn_s_getreg((3 << 11) | 20) & 0xFu; }
#define XB_SPIN(cond, bar) do { unsigned _sp = 0; while (cond) { __builtin_amdgcn_s_sleep(1); \
    if ((++_sp & 255u) == 0u) { if (xb_ld(&(bar)[XB_TMO])) break; if (_sp > XB_SPIN_CAP) { atomicAdd(&(bar)[XB_TMO], 1u); break; } } } } while (0)

struct XcdBarrier {
    unsigned* bar; unsigned x;
    volatile LAS unsigned* st;
};

__device__ __forceinline__ XcdBarrier xcd_barrier_post(unsigned* bar, volatile LAS unsigned* st, bool leader) {
    XcdBarrier b; b.bar = bar; b.x = xb_xcc_id(); b.st = st;
    if (leader) (void)xb_add(&bar[XB_XCNT(b.x)], 1u);
    return b;
}
__device__ __forceinline__ void xcd_barrier_complete(unsigned* bar, unsigned x, unsigned& nloc, unsigned& nx) {
    const unsigned G = gridDim.x * gridDim.y * gridDim.z;
    unsigned sum, cnt, mine, sp = 0u;
    for (;;) {
        sum = 0u; cnt = 0u; mine = 0u;
#pragma unroll
        for (unsigned j = 0; j < 16; ++j) { const unsigned c = xb_ld(&bar[XB_XCNT(j)]); sum += c; cnt += (c > 0u) ? 1u : 0u; mine = (j == x) ? c : mine; }
        if (sum == G) break;
        __builtin_amdgcn_s_sleep(1);
        if ((++sp & 255u) == 0u) { if (xb_ld(&bar[XB_TMO])) break; if (sp > XB_SPIN_CAP) { atomicAdd(&bar[XB_TMO], 1u); break; } }
    }
    nloc = mine > 0u ? mine : 1u; nx = cnt > 0u ? cnt : 1u;
}

__device__ __forceinline__ void xcd_barrier(const XcdBarrier& b, bool leader) {
    asm volatile("s_waitcnt vmcnt(0)" ::: "memory");
    __syncthreads();
    if (leader) {
        unsigned* bar = b.bar;
        __builtin_amdgcn_s_waitcnt(0);
        unsigned nloc = b.st[0], nx = b.st[1];
        if (nloc == 0u) { xcd_barrier_complete(bar, b.x, nloc, nx); b.st[0] = nloc; b.st[1] = nx; }
        const unsigned old = xb_add(&bar[XB_XSUB(b.x)], 1u);
        const unsigned gen = old / nloc;
        if (old + 1u == (gen + 1u) * nloc) {
            __builtin_amdgcn_fence(__ATOMIC_RELEASE, "agent");
            asm volatile("s_waitcnt vmcnt(0)" ::: "memory");
            const unsigned og = xb_add(&bar[XB_TOP], 1u);
            const unsigned tg = og / nx;
            if (og + 1u == (tg + 1u) * nx) xb_add(&bar[XB_TOPGEN], 1u);
            else XB_SPIN(xb_ld(&bar[XB_TOPGEN]) == tg, bar);
            __builtin_amdgcn_fence(__ATOMIC_ACQUIRE, "agent");
            xb_add(&bar[XB_XGEN(b.x)], 1u);
            asm volatile("s_waitcnt vmcnt(0)" ::: "memory");
        } else {
            XB_SPIN(xb_ld(&bar[XB_XGEN(b.x)]) == gen, bar);
            __builtin_amdgcn_fence(__ATOMIC_ACQUIRE, "agent");
            asm volatile("s_waitcnt vmcnt(0)" ::: "memory");
        }
    }
    __syncthreads();
}

__device__ __forceinline__ void attn_phase_dyn(const CAS Args* A, char* lds, unsigned* ctr, int tid, bool leader) {
    using attn_body::bf16;
    bf16* Q = (bf16*)(A->ws + WS_MIX) + 512; const bf16* K = (const bf16*)(A->ws + WS_KV); const bf16* V = K + 128;
    const int h0 = (int)(xb_xcc_id() & 7u);
    volatile LAS unsigned* slot = (volatile LAS unsigned*)((LAS unsigned char*)lds + 154368 + 64);
#pragma nounroll
    for (int qi = 0; qi < 8; ++qi) {
        const int h = (h0 + qi) & 7;
        for (;;) {
            if (leader) *slot = atomicAdd(ctr + h * 64, 1u);
            __syncthreads();
            const int k = (int)__builtin_amdgcn_readfirstlane((int)*slot);
            __syncthreads();
            if (k >= 320) break;
            if (k < 64) attn_body::attn_unit<8>(0, MP, h, k, Q, K, V, Q, lds, tid);
            else { const int ks = k - 64; attn_body::attn_unit<8>((long)MP + (long)(ks >> 4) * TSAMP, TSAMP, h, ks & 15, Q, K, V, Q, lds, tid); }
        }
    }
}
#ifndef STOP_AFTER
#define STOP_AFTER 99
#endif
__device__ __forceinline__ int fresh(int v) { asm volatile("" : "+s"(v)); return v; }
__device__ __forceinline__ int freshv(int v) { asm volatile("" : "+v"(v)); return v; }
__device__ __forceinline__ const CAS Args* get_args() { unsigned long long v = (unsigned long long)(uintptr_t)__builtin_amdgcn_kernarg_segment_ptr(); asm volatile("" : "+s"(v)); return (const CAS Args*)v; }
__global__ void __launch_bounds__(NWAVES * 64, 2) hymba_fwd(Args args_unused) {
    extern __shared__ __attribute__((aligned(16))) unsigned char lds[];
    cg::grid_group grid = cg::this_grid();
    const int wave = __builtin_amdgcn_readfirstlane((int)threadIdx.x >> 6), G = gridDim.x;
#define LANE_() ({ int z_ = 0; asm volatile("" : "+s"(z_)); (int)__builtin_amdgcn_mbcnt_hi(~0u, __builtin_amdgcn_mbcnt_lo(~0u, (unsigned)z_)); })
#define lane LANE_()
#define tid (wave * 64 + LANE_())
    LAS unsigned char* l3 = (LAS unsigned char*)lds;
    volatile LAS unsigned* xmisc = (volatile LAS unsigned*)(l3 + 154368);
    if (wave == 0 && LANE_() == 0) { xmisc[0] = 0u; xmisc[1] = 0u; }
    __syncthreads();
    (void)xcd_barrier_post((unsigned*)(get_args()->ws + WS_CTL), xmisc, wave == 0 && LANE_() == 0);
#ifdef USE_CG_SYNC
#define GSYNC() do { grid.sync(); } while (0)
#else
#define GSYNC() do { XcdBarrier b_; b_.bar = (unsigned*)(get_args()->ws + WS_CTL); b_.x = xb_xcc_id(); b_.st = (volatile LAS unsigned*)((LAS unsigned char*)lds + 154368); xcd_barrier(b_, fresh(wave) == 0 && LANE_() == 0); } while (0)
#endif
#ifdef EXP_READOUT
    { const CAS Args* a = get_args(); if (blockIdx.x == 0 && tid == 0) { const float v = a->out[EXP_READOUT]; if (v == 123.456f) ((float*)(a->ws + WS_MOD))[0] = v; } }
#ifdef EXP_READALL
    { const CAS Args* a = get_args(); float acc = 0.f; for (size_t i = (size_t)blockIdx.x * 512 + tid; i < (size_t)MT * D; i += (size_t)gridDim.x * 512) acc += a->out[i]; if (acc == 123.456f) ((float*)(a->ws + WS_MOD))[1] = acc; }
#endif
#endif
    { const CAS Args* a = get_args(); p0_mod(a, l3, tid); p0_prologue(a, l3, wave, freshv(lane), fresh(G)); }
#ifdef DUP_P0
    __syncthreads(); { const CAS Args* a = get_args(); p0_mod(a, l3, tid); p0_prologue(a, l3, wave, freshv(lane), fresh(G)); }
#endif
    GSYNC(); if (STOP_AFTER == 0) return;
#pragma nounroll
    for (int l0 = 0; l0 < DEPTH; ++l0) {
        int l = l0; asm volatile("" : "+s"(l));
        { const CAS Args* a = get_args(); unsigned char* ws = a->ws; float* out = a->out;
          const float* xp = l == 0 ? a->in[0] : out; const float* xs = l == 0 ? a->in[1] : out + (size_t)MP * D;
          norm_phase(xp, xs, a->in[6] + l * D, (const float*)(ws + WS_MOD) + (size_t)l * 6144, (bf16*)(ws + WS_XN), wave, freshv(lane), fresh(G));
#ifdef DUP_NORM
          norm_phase(xp, xs, a->in[6] + l * D, (const float*)(ws + WS_MOD) + (size_t)l * 6144, (bf16*)(ws + WS_XN), wave, freshv(lane), fresh(G));
#endif
        }
        GSYNC(); if (STOP_AFTER == 1) return;
        { const CAS Args* a = get_args(); unsigned char* ws = a->ws;
          pg8::Gemm g{(const bf16*)(ws + WS_XN), (const bf16*)(ws + WS_WIN) + (size_t)l * NINP * D, MT, NINP, D}; pg8::StaticOrder S; S.init(MT, NINP, fresh(G), fresh((int)blockIdx.x));
          pg8::EpiInProj E{(bf16*)(ws + WS_PROJ), (bf16*)(ws + WS_MIX), (bf16*)(ws + WS_KV)};
          pg8::gemm_phase<pg8::EpiInProj, pg8::StaticOrder, PG8_ALIGN, PG8_SP2>(l3, g, S, E, tid);
#ifdef DUP_GEMM
          __syncthreads(); pg8::gemm_phase<pg8::EpiInProj, pg8::StaticOrder, PG8_ALIGN, PG8_SP2>(l3, g, S, E, tid);
#endif
        }
        GSYNC(); if (STOP_AFTER == 2) return;
        { const CAS Args* a = get_args(); unsigned char* ws = a->ws;
          qk_prep_phase((bf16*)(ws + WS_MIX), (bf16*)(ws + WS_KV), a->in[20] + l * 64, a->in[21] + l * 64, wave, freshv(lane), fresh(G)); }
#ifndef NO_SCANA
        scan_phase<false>(get_args(), l3, l, wave, freshv(lane), fresh(G));
#endif
#ifdef DUP_SCANA
        scan_phase<false>(get_args(), l3, l, wave, freshv(lane), fresh(G));
#endif
        GSYNC(); if (STOP_AFTER == 3) return;
#ifndef NO_SCANB
        scanB_phase(get_args(), l3, wave, freshv(lane), fresh(G));
#endif
        __syncthreads();
        { const CAS Args* a = get_args(); attn_phase_dyn(a, (char*)lds, (unsigned*)(a->ws + WS_CTL) + 4096 + l * 1024, tid, fresh(wave) == 0 && LANE_() == 0); }
        GSYNC(); if (STOP_AFTER == 4) return;

#ifdef EXP_SLOAD
        probe_sload(get_args(), wave, freshv(lane), fresh(G));
#endif
#ifndef NO_SCANC
        scan_phase<true>(get_args(), l3, l, wave, freshv(lane), fresh(G));
#endif
#ifdef DUP_SCANC
        scan_phase<true>(get_args(), l3, l, wave, freshv(lane), fresh(G));
#endif
        GSYNC(); if (STOP_AFTER == 5) return;
#ifndef NO_POST
        post_phase(get_args(), l, wave, freshv(lane), fresh(G));
#endif
#ifdef DUP_POST
        post_phase(get_args(), l, wave, freshv(lane), fresh(G));
#endif
        GSYNC(); if (STOP_AFTER == 6) return;
#ifndef NO_P7
        { const CAS Args* a = get_args(); unsigned char* ws = a->ws; float* out = a->out;
          const float* xp = l == 0 ? a->in[0] : out; const float* xs = l == 0 ? a->in[1] : out + (size_t)MP * D;
          pg8::Gemm g{(const bf16*)(ws + WS_MIX), (const bf16*)(ws + WS_WOUT) + (size_t)l * D * D, MT, D, D}; pg8::StaticOrder S; S.init(MT, D, fresh(G), fresh((int)blockIdx.x));
          pg8::EpiResid E{xp, xs, out, (const float*)(ws + WS_MOD) + (size_t)l * 6144 + 2048};
          pg8::gemm_phase<pg8::EpiResid, pg8::StaticOrder, PG8_ALIGN, PG8_SP2>(l3, g, S, E, tid); }
#endif
        GSYNC(); if (STOP_AFTER == 7) return;
        { const CAS Args* a = get_args(); unsigned char* ws = a->ws; float* out = a->out;
          norm_phase(out, out + (size_t)MP * D, a->in[7] + l * D, (const float*)(ws + WS_MOD) + (size_t)l * 6144 + 3072, (bf16*)(ws + WS_XN), wave, freshv(lane), fresh(G)); }
        GSYNC(); if (STOP_AFTER == 8) return;
        { const CAS Args* a = get_args(); unsigned char* ws = a->ws;
          pg8::Gemm g{(const bf16*)(ws + WS_XN), (const bf16*)(ws + WS_WFFI) + (size_t)l * 2 * DFF * D, MT, 2 * DFF, D}; pg8::StaticOrder S; S.init(MT, 2 * DFF, fresh(G), fresh((int)blockIdx.x));
          pg8::EpiSwiGLU E{(bf16*)(ws + WS_ACT)};
          pg8::gemm_phase<pg8::EpiSwiGLU, pg8::StaticOrder, PG8_ALIGN, PG8_SP2>(l3, g, S, E, tid);
#ifdef DUP_GEMM
          __syncthreads(); pg8::gemm_phase<pg8::EpiSwiGLU, pg8::StaticOrder, PG8_ALIGN, PG8_SP2>(l3, g, S, E, tid);
#endif
        }
        GSYNC(); if (STOP_AFTER == 9) return;
        { const CAS Args* a = get_args(); unsigned char* ws = a->ws; float* out = a->out;
          pg8::Gemm g{(const bf16*)(ws + WS_ACT), (const bf16*)(ws + WS_WFFO) + (size_t)l * D * DFF, MT, D, DFF}; pg8::StaticOrder S; S.init(MT, D, fresh(G), fresh((int)blockIdx.x));
          pg8::EpiResid E{out, out + (size_t)MP * D, out, (const float*)(ws + WS_MOD) + (size_t)l * 6144 + 5120};
          pg8::gemm_phase<pg8::EpiResid, pg8::StaticOrder, PG8_ALIGN, PG8_SP2>(l3, g, S, E, tid); }
        if (l0 + 1 < DEPTH) GSYNC();
    }
}

extern "C" void kernel_launch(void* const* d_in, const int* in_sizes, int n_in, void* d_out, int out_size, void* d_ws, size_t ws_size, hipStream_t stream) {
    static int grid = 0;
    if (grid == 0) {
        if (n_in != 25 || ws_size < WS_END) { fprintf(stderr, "kernel_launch: unexpected n_in %d / ws %zu\n", n_in, ws_size); grid = -1; return; }
        int dev = 0, cus = 0, per_cu = 0;
        hipGetDevice(&dev); hipDeviceGetAttribute(&cus, hipDeviceAttributeMultiprocessorCount, dev);
        if (hipFuncSetAttribute((const void*)hymba_fwd, hipFuncAttributeMaxDynamicSharedMemorySize, LDS_BYTES) != hipSuccess) { fprintf(stderr, "kernel_launch: hipFuncSetAttribute failed\n"); grid = -1; return; }
        if (hipOccupancyMaxActiveBlocksPerMultiprocessor(&per_cu, (const void*)hymba_fwd, NWAVES * 64, LDS_BYTES) != hipSuccess || per_cu < 1) { fprintf(stderr, "kernel_launch: occupancy query says %d\n", per_cu); per_cu = 1; }
        (void)hipGetLastError();
        grid = cus * 1;
    }
    if (grid < 0) return;
    if (hipMemsetAsync((char*)d_ws + WS_CTL, 0, 32768, stream) != hipSuccess) { fprintf(stderr, "kernel_launch: memset failed\n"); return; }
    Args a{};
    for (int i = 0; i < 25; ++i) a.in[i] = (const float*)d_in[i];
    a.out = (float*)d_out; a.ws = (unsigned char*)d_ws;
    void* kargs[] = {&a};
    hipError_t e = hipLaunchCooperativeKernel((const void*)hymba_fwd, dim3(grid), dim3(NWAVES * 64), kargs, LDS_BYTES, stream);
    if (e != hipSuccess) fprintf(stderr, "cooperative launch failed: %s (grid %d)\n", hipGetErrorString(e), grid);
}
```
